# Optimizing an MI355X kernel written in HIP

```python
import jax, jax.numpy as jnp
from jax import lax
import numpy as np

D_MODEL = 1024
BATCH = 8
SEQ = 4096
DEPTH = 1
DEC_BATCH = 128
DEC_SEQ = 8
PAST_LEN = 16384
PAGE_SIZE = 128

N_HEADS = 8
N_KV_HEADS = 2
HEAD_DIM = 64
Q_GROUP = N_HEADS // N_KV_HEADS
WINDOW = 128
ATT_WIDTH = N_HEADS * HEAD_DIM
KV_WIDTH = N_KV_HEADS * HEAD_DIM
CHUNK = 128
SGU_WIDTH = D_MODEL // 2
SGU_GROUPS = 4
SGU_GROUP_DIM = SGU_WIDTH // SGU_GROUPS
N_BRANCH = 2
SPLITS = (ATT_WIDTH,
          ATT_WIDTH + KV_WIDTH,
          ATT_WIDTH + 2 * KV_WIDTH,
          ATT_WIDTH + 2 * KV_WIDTH + SGU_WIDTH,
          ATT_WIDTH + 2 * KV_WIDTH + 2 * SGU_WIDTH,
          ATT_WIDTH + 2 * KV_WIDTH + 2 * SGU_WIDTH + D_MODEL)
IN_WIDTH = ATT_WIDTH + 2 * KV_WIDTH + 2 * SGU_WIDTH + N_BRANCH * D_MODEL
PEER_HEADS = 8
PEER_N_KEYS = 128
PEER_N_EXPERTS = PEER_N_KEYS * PEER_N_KEYS
PEER_TOPK = 16
PEER_QDIM = 256
PEER_HALF = PEER_QDIM // 2
PEER_BLOCK = 256
PLE_DIM = 256
EPS = 1e-6
NEG_INF = -1e30

kernel_name = "hybrid_swa_sgu_peer_decoder_step"


def _rms_norm(x, g):
    x32 = x.astype(jnp.float32)
    y = x32 * lax.rsqrt(jnp.mean(x32 * x32, axis=-1, keepdims=True) + EPS)
    return (y * g.astype(jnp.float32)).astype(x.dtype)


def _layer_norm(x, g, b):
    x32 = x.astype(jnp.float32)
    mu = jnp.mean(x32, axis=-1, keepdims=True)
    xc = x32 - mu
    y = xc * lax.rsqrt(jnp.mean(xc * xc, axis=-1, keepdims=True) + EPS)
    return (y * g.astype(jnp.float32) + b.astype(jnp.float32)).astype(x.dtype)


def _alibi_slopes():
    h = jnp.arange(1, N_HEADS + 1, dtype=jnp.float32)
    return jnp.exp2(-8.0 * h / N_HEADS)


def _sink_attend(q, k, v, dist, valid, sinks):
    scores = jnp.einsum('...qkgd,...skd->...kgqs', q, k).astype(jnp.float32) * (HEAD_DIM ** -0.5)
    slopes = _alibi_slopes().reshape(N_KV_HEADS, Q_GROUP, 1, 1)
    scores = scores - slopes * dist.astype(jnp.float32)
    scores = jnp.where(valid, scores, NEG_INF)
    sink = jnp.broadcast_to(sinks.astype(jnp.float32).reshape(N_KV_HEADS, Q_GROUP, 1, 1),
                            scores.shape[:-1] + (1,))
    probs = jax.nn.softmax(jnp.concatenate([scores, sink], axis=-1), axis=-1)[..., :-1]
    return jnp.einsum('...kgqs,...skd->...qkgd', probs.astype(v.dtype), v)


def _window_attention_prompt(q, k, v, sinks):
    B, S = q.shape[:2]
    nb = S // WINDOW
    qb = q.reshape(B, nb, WINDOW, N_KV_HEADS, Q_GROUP, HEAD_DIM)
    kb = k.reshape(B, nb, WINDOW, N_KV_HEADS, HEAD_DIM)
    vb = v.reshape(B, nb, WINDOW, N_KV_HEADS, HEAD_DIM)
    pad = ((0, 0), (1, 0), (0, 0), (0, 0), (0, 0))
    kk = jnp.concatenate([jnp.pad(kb[:, :-1], pad), kb], axis=2)
    vv = jnp.concatenate([jnp.pad(vb[:, :-1], pad), vb], axis=2)
    i = jnp.arange(WINDOW)[:, None]
    r = jnp.arange(2 * WINDOW)[None, :]
    dist = i - r + WINDOW
    has_prev = (jnp.arange(nb) > 0)[:, None, None]
    valid = (dist >= 0) & (dist < WINDOW) & (has_prev | (r >= WINDOW))
    out = _sink_attend(qb, kk, vv, dist, valid[:, None, None], sinks)
    return out.reshape(B, S, ATT_WIDTH)


def _window_attention_sample(q, k_new, v_new, k_past, v_past, sinks):
    Bd, L = q.shape[:2]
    W = k_past.shape[1]
    kk = jnp.concatenate([k_past.astype(k_new.dtype), k_new], axis=1)
    vv = jnp.concatenate([v_past.astype(v_new.dtype), v_new], axis=1)
    key_off = jnp.concatenate([jnp.arange(W) - W, jnp.arange(L)])
    dist = jnp.arange(L)[:, None] - key_off[None, :]
    valid = (dist >= 0) & (dist < WINDOW)
    out = _sink_attend(q, kk, vv, dist, valid, sinks)
    return out.reshape(Bd, L, ATT_WIDTH)


def _sgu_prompt(v, w_s, b_s):
    B, S = v.shape[:2]
    nc = S // CHUNK
    vb = v.reshape(B, nc, CHUNK, SGU_GROUPS, SGU_GROUP_DIM)
    wm = w_s * jnp.tril(jnp.ones((CHUNK, CHUNK), w_s.dtype))
    s = jnp.einsum('gts,bnsgd->bntgd', wm, vb) + b_s.T[:, :, None]
    return s.reshape(B, S, SGU_WIDTH)


def _sgu_sample(v, w_s, b_s):
    Bd, L = v.shape[:2]
    vb = v.reshape(Bd, L, SGU_GROUPS, SGU_GROUP_DIM)
    wm = w_s[:, :L, :L] * jnp.tril(jnp.ones((L, L), w_s.dtype))
    s = jnp.einsum('gts,bsgd->btgd', wm, vb) + b_s[:, :L].T[:, :, None]
    return s.reshape(Bd, L, SGU_WIDTH)


def _peer(xn, w_q, sub_keys, expert_u, expert_v):
    shape = xn.shape
    t = xn.reshape(-1, D_MODEL)
    n = t.shape[0]
    blk = min(PEER_BLOCK, n)
    nb = -(-n // blk)
    t = jnp.pad(t, ((0, nb * blk - n), (0, 0)))

    def one_block(xb):
        q = (xb @ w_q).reshape(blk, PEER_HEADS, 2, PEER_HALF)
        sc = jnp.einsum('thcd,hcnd->thcn', q, sub_keys).astype(jnp.float32)
        s_top, i_top = lax.top_k(sc, PEER_TOPK)
        cand = (s_top[:, :, 0, :, None] + s_top[:, :, 1, None, :]).reshape(blk, PEER_HEADS, -1)
        cand_idx = (i_top[:, :, 0, :, None] * PEER_N_KEYS + i_top[:, :, 1, None, :]).reshape(blk, PEER_HEADS, -1)
        best, pos = lax.top_k(cand, PEER_TOPK)
        idx = jnp.take_along_axis(cand_idx, pos, axis=-1)
        gate = jax.nn.softmax(best, axis=-1)
        u = expert_u[idx]
        act = jax.nn.gelu(jnp.einsum('thkd,td->thk', u, xb).astype(jnp.float32))
        w = (gate * act).astype(xb.dtype)
        return jnp.einsum('thk,thkd->td', w, expert_v[idx])

    out = lax.map(one_block, t.reshape(nb, blk, D_MODEL))
    return out.reshape(-1, D_MODEL)[:n].reshape(shape)


def _layer(x, p_i, lp, past_k, past_v):
    prompt = past_k is None
    B, S = x.shape[:2]
    xn = _rms_norm(x, lp['attn_norm_g'])
    z = xn @ lp['w_in']
    q, k, v, su, sv, g_a, g_b = jnp.split(z, SPLITS, axis=-1)
    q = _rms_norm(q.reshape(B, S, N_HEADS, HEAD_DIM), lp['q_norm_g'])
    q = q.reshape(B, S, N_KV_HEADS, Q_GROUP, HEAD_DIM)
    k = _rms_norm(k.reshape(B, S, N_KV_HEADS, HEAD_DIM), lp['k_norm_g'])
    v = v.reshape(B, S, N_KV_HEADS, HEAD_DIM)
    if prompt:
        a = _window_attention_prompt(q, k, v, lp['attn_sinks'])
    else:
        a = _window_attention_sample(q, k, v, past_k, past_v, lp['attn_sinks'])
    u = jax.nn.gelu(su)
    vn = _layer_norm(jax.nn.gelu(sv), lp['sgu_norm_g'], lp['sgu_norm_b'])
    if prompt:
        s = _sgu_prompt(vn, lp['sgu_w'], lp['sgu_b'])
    else:
        s = _sgu_sample(vn, lp['sgu_w'], lp['sgu_b'])
    m = u * s
    h = jax.nn.sigmoid(g_a) * (a @ lp['w_branch_a']) + jax.nn.sigmoid(g_b) * (m @ lp['w_branch_b'])
    x1 = x + h @ lp['w_out']
    x2 = x1 + _peer(_rms_norm(x1, lp['ffn_norm_g']), lp['peer_w_q'], lp['peer_sub_keys'],
                    lp['peer_u'], lp['peer_v'])
    gate = jax.nn.sigmoid(_rms_norm(x2, lp['ple_norm_g']) @ lp['w_ple_gate'])
    x3 = x2 + gate * (p_i @ lp['w_ple'])
    if prompt:
        wp = min(WINDOW, S)
        return x3, k[:, S - wp:], v[:, S - wp:], vn[:, S - CHUNK:]
    return x3, k, v, vn


def setup_inputs(seed: int = 0) -> dict:
    key = jax.random.key(seed)
    ks = jax.random.split(key, 32)
    f32 = jnp.float32

    def nrm(k, shape, scale):
        return jax.random.normal(k, shape, f32) * scale

    w_buf = min(WINDOW, PAST_LEN)
    return {
        'x_prompt': nrm(ks[0], (BATCH, SEQ, D_MODEL), 1.0),
        'x_sample': nrm(ks[1], (DEC_BATCH, DEC_SEQ, D_MODEL), 1.0),
        'cache_k': nrm(ks[2], (DEPTH, DEC_BATCH, w_buf, N_KV_HEADS, HEAD_DIM), 1.0),
        'cache_v': nrm(ks[3], (DEPTH, DEC_BATCH, w_buf, N_KV_HEADS, HEAD_DIM), 1.0),
        'p_prompt': nrm(ks[4], (DEPTH, BATCH, SEQ, PLE_DIM), 1.0),
        'p_sample': nrm(ks[5], (DEPTH, DEC_BATCH, DEC_SEQ, PLE_DIM), 1.0),
        'attn_norm_g': 1.0 + nrm(ks[6], (DEPTH, D_MODEL), 0.02),
        'w_in': nrm(ks[7], (DEPTH, D_MODEL, IN_WIDTH), D_MODEL ** -0.5),
        'q_norm_g': 1.0 + nrm(ks[8], (DEPTH, HEAD_DIM), 0.02),
        'k_norm_g': 1.0 + nrm(ks[9], (DEPTH, HEAD_DIM), 0.02),
        'attn_sinks': nrm(ks[10], (DEPTH, N_HEADS), 0.5),
        'sgu_norm_g': 1.0 + nrm(ks[11], (DEPTH, SGU_WIDTH), 0.02),
        'sgu_norm_b': nrm(ks[12], (DEPTH, SGU_WIDTH), 0.02),
        'sgu_w': nrm(ks[13], (DEPTH, SGU_GROUPS, CHUNK, CHUNK), CHUNK ** -0.5),
        'sgu_b': 1.0 + nrm(ks[14], (DEPTH, SGU_GROUPS, CHUNK), 0.02),
        'w_branch_a': nrm(ks[15], (DEPTH, ATT_WIDTH, D_MODEL), ATT_WIDTH ** -0.5),
        'w_branch_b': nrm(ks[16], (DEPTH, SGU_WIDTH, D_MODEL), SGU_WIDTH ** -0.5),
        'w_out': nrm(ks[17], (DEPTH, D_MODEL, D_MODEL), D_MODEL ** -0.5),
        'ffn_norm_g': 1.0 + nrm(ks[18], (DEPTH, D_MODEL), 0.02),
        'peer_w_q': nrm(ks[19], (DEPTH, D_MODEL, PEER_HEADS * PEER_QDIM), D_MODEL ** -0.5),
        'peer_sub_keys': nrm(ks[20], (DEPTH, PEER_HEADS, 2, PEER_N_KEYS, PEER_HALF), PEER_HALF ** -0.5),
        'peer_u': nrm(ks[21], (DEPTH, PEER_N_EXPERTS, D_MODEL), D_MODEL ** -0.5),
        'peer_v': nrm(ks[22], (DEPTH, PEER_N_EXPERTS, D_MODEL), (PEER_HEADS * PEER_TOPK) ** -0.5),
        'ple_norm_g': 1.0 + nrm(ks[23], (DEPTH, D_MODEL), 0.02),
        'w_ple': nrm(ks[24], (DEPTH, PLE_DIM, D_MODEL), PLE_DIM ** -0.5),
        'w_ple_gate': nrm(ks[25], (DEPTH, D_MODEL, D_MODEL), D_MODEL ** -0.5),
    }


def reference(x_prompt, x_sample, cache_k, cache_v, p_prompt, p_sample,
              attn_norm_g, w_in, q_norm_g, k_norm_g, attn_sinks,
              sgu_norm_g, sgu_norm_b, sgu_w, sgu_b,
              w_branch_a, w_branch_b, w_out,
              ffn_norm_g, peer_w_q, peer_sub_keys, peer_u, peer_v,
              ple_norm_g, w_ple, w_ple_gate):
    hp, hs = x_prompt, x_sample
    nkp, nvp, nks, nvs, nsp, nss = [], [], [], [], [], []
    for i in range(DEPTH):
        lp = dict(attn_norm_g=attn_norm_g[i], w_in=w_in[i], q_norm_g=q_norm_g[i],
                  k_norm_g=k_norm_g[i], attn_sinks=attn_sinks[i],
                  sgu_norm_g=sgu_norm_g[i], sgu_norm_b=sgu_norm_b[i], sgu_w=sgu_w[i], sgu_b=sgu_b[i],
                  w_branch_a=w_branch_a[i], w_branch_b=w_branch_b[i], w_out=w_out[i],
                  ffn_norm_g=ffn_norm_g[i], peer_w_q=peer_w_q[i], peer_sub_keys=peer_sub_keys[i],
                  peer_u=peer_u[i], peer_v=peer_v[i],
                  ple_norm_g=ple_norm_g[i], w_ple=w_ple[i], w_ple_gate=w_ple_gate[i])
        hp, kp, vp, sp = _layer(hp, p_prompt[i], lp, None, None)
        hs, ks_, vs_, ss = _layer(hs, p_sample[i], lp, cache_k[i], cache_v[i])
        nkp.append(kp); nvp.append(vp); nsp.append(sp)
        nks.append(ks_); nvs.append(vs_); nss.append(ss)
    new_k_prompt = jnp.stack(nkp)
    new_v_prompt = jnp.stack(nvp)
    new_k_sample = jnp.stack(nks)
    new_v_sample = jnp.stack(nvs)
    new_sgu_v_prompt = jnp.stack(nsp)
    new_sgu_v_sample = jnp.stack(nss)
    return (hp, hs, new_k_prompt, new_v_prompt, new_k_sample, new_v_sample, new_sgu_v_prompt, new_sgu_v_sample)
```

```cpp
#include <hip/hip_runtime.h>
#include <hip/hip_cooperative_groups.h>
#include <cstdio>
#include <cstdint>
namespace cg = cooperative_groups;
namespace pg8 {
#define PG8_LAS __attribute__((address_space(3)))
typedef unsigned short bf16_t;
typedef short bf16x8 __attribute__((ext_vector_type(8)));
typedef float f32x4 __attribute__((ext_vector_type(4)));
typedef unsigned u32x4 __attribute__((ext_vector_type(4)));
constexpr int BM = 256, BK = 64, HALF = 128, HTB = HALF * BK * 2  , STAGE_BYTES = 8 * HTB, NXCD = 8, WGM = 8;

__host__ __device__ __forceinline__ int lds_byte(int r, int c) { const int st = (r >> 4) * 2 + (c >> 5), rr = r & 15, cc = c & 31, ob = rr * 64 + cc * 2; return st * 1024 + (ob ^ (((ob >> 9) & 1) << 5)); }
__host__ __device__ __forceinline__ void stage_rc(int b, int& R, int& C) { const int st = b / 1024, sb = b % 1024, swz = sb ^ (((sb >> 9) & 1) << 5); R = (st >> 1) * 16 + swz / 64; C = (st & 1) * 32 + (swz % 64) / 2; }
__host__ __device__ __forceinline__ int perm32(int rho) { const int n = rho >> 4, i = rho & 15; return 8 * (i >> 2) + 4 * n + (i & 3); }

struct Unit { int pm, pn; };
struct Gemm { const bf16_t* A; const bf16_t* Bt; int M, N, K; };

struct StaticOrder {
    int nM, nN, nwg, G, c;
    __host__ __device__ void init(int M, int N, int G_, int c_) { nM = M / BM; nN = N / BM; nwg = nM * nN; G = G_; c = c_; }
    __host__ __device__ bool next(int i, Unit& u) const {
        const long L = (long)i * G + c; if (L >= nwg) return false;
        int wgid = (int)L; { const int q = nwg / NXCD, r = nwg % NXCD, xcd = wgid % NXCD, off = wgid / NXCD; wgid = (xcd < r ? xcd * (q + 1) : r * (q + 1) + (xcd - r) * q) + off; }
        const int nig = WGM * nN, gid = wgid / nig, fm = gid * WGM, gsz = (nM - fm) < WGM ? (nM - fm) : WGM;
        u.pm = fm + ((wgid % nig) % gsz); u.pn = (wgid % nig) / gsz; return true;
    }
    __device__ __forceinline__ void a_ready(const Unit&) const {}
    __device__ __forceinline__ void done(const Unit&) const {}
};

__device__ __forceinline__ unsigned cvt_pk_bf16(float lo, float hi) { unsigned r; asm volatile("v_cvt_pk_bf16_f32 %0, %1, %2" : "=v"(r) : "v"(lo), "v"(hi)); return r; }
template <class Epi, class Sched, bool ALIGN_EPI = false, bool SP2 = false>
__device__ __forceinline__ void gemm_phase(PG8_LAS unsigned char* lds, const Gemm g, const Sched& S, const Epi& E, const int wave_in) {
    int lane_l; asm volatile("v_mbcnt_lo_u32_b32 %0, -1, 0\n\tv_mbcnt_hi_u32_b32 %0, -1, %0" : "=v"(lane_l));
    const int wid = wave_in, lane = lane_l, tid = wid * 64 + lane, wr = wid >> 2, wc = wid & 3, fr = lane & 15, fq = lane >> 4;
    const int K = g.K, nt = K / BK;
    unsigned voffA[2], voffB[2];
#pragma unroll
    for (int i = 0; i < 2; ++i) { int R, C; stage_rc(tid * 16 + i * 8192, R, C); const int Rb = Epi::PERM ? ((R & ~31) + perm32(R & 31)) : R;
        voffA[i] = (unsigned)(R * K + C) * 2u; voffB[i] = (unsigned)(Rb * K + C) * 2u; }
    const size_t kstep = (size_t)(BK * 2);
    const size_t hstep = (size_t)HALF * K * 2;
    const size_t tstep = 2 * hstep;
    const unsigned ldsw = (unsigned)wid * 1024u;
    const int aoff = lds_byte(wr * 64 + fr, fq * 8), boff = lds_byte(wc * 32 + fr, fq * 8);
#define PG8_SA(b, h) (((b) * 2 + (h)) * HTB)
#define PG8_SB(b, h) ((4 + (b) * 2 + (h)) * HTB)
#define PG8_STAGE(bufoff, gbase, voff) do { _Pragma("unroll") for (int _i = 0; _i < 2; ++_i) \
        __builtin_amdgcn_global_load_lds((const unsigned*)((const char*)(gbase) + (voff)[_i]), (PG8_LAS unsigned*)(lds + (bufoff) + ldsw + _i * 8192), 16, 0, 0); } while (0)
#define PG8_LDA(dst, b, h) do { _Pragma("unroll") for (int m = 0; m < 4; ++m) _Pragma("unroll") for (int k = 0; k < 2; ++k) dst[m][k] = *(const PG8_LAS bf16x8*)(lds + PG8_SA(b, h) + aoff + m * 2048 + k * 1024); } while (0)
#define PG8_LDB(dst, b, h) do { _Pragma("unroll") for (int n = 0; n < 2; ++n) _Pragma("unroll") for (int k = 0; k < 2; ++k) dst[n][k] = *(const PG8_LAS bf16x8*)(lds + PG8_SB(b, h) + boff + n * 2048 + k * 1024); } while (0)
#define PG8_MMA(ai, bj, At, Bt) do { __builtin_amdgcn_s_setprio(1); _Pragma("unroll") for (int m = 0; m < 4; ++m) _Pragma("unroll") for (int n = 0; n < 2; ++n) _Pragma("unroll") for (int k = 0; k < 2; ++k) \
        acc[ai][bj][m][n] = __builtin_amdgcn_mfma_f32_16x16x32_bf16(Bt[n][k], At[m][k], acc[ai][bj][m][n], 0, 0, 0); __builtin_amdgcn_s_setprio(0); } while (0)
#define PG8_WAIT_V(n) asm volatile("s_waitcnt vmcnt(" #n ")" ::: "memory")
#define PG8_WAIT_L(n) asm volatile("s_waitcnt lgkmcnt(" #n ")" ::: "memory")
#define PG8_BAR __builtin_amdgcn_s_barrier()
#define PG8_SCHED __builtin_amdgcn_sched_barrier(0)
    Unit cur, nxt; int ui = 0;
    if (!S.next(0, cur)) return;
    f32x4 acc[2][2][4][2];
#pragma unroll
    for (int a = 0; a < 2; ++a)
#pragma unroll
        for (int b = 0; b < 2; ++b)
#pragma unroll
            for (int m = 0; m < 4; ++m)
#pragma unroll
                for (int n = 0; n < 2; ++n) acc[a][b][m][n] = (f32x4){0.f, 0.f, 0.f, 0.f};
    bf16x8 At[4][2], B0[2][2], B1[2][2];
    const char* cA = (const char*)g.A + (size_t)cur.pm * tstep; const char* cB = (const char*)g.Bt + (size_t)cur.pn * tstep;
    S.a_ready(cur);
    if constexpr (SP2) {
        PG8_STAGE(PG8_SB(0, 0), cB, voffB); PG8_STAGE(PG8_SB(0, 1), cB + hstep, voffB); PG8_STAGE(PG8_SA(0, 0), cA, voffA); PG8_STAGE(PG8_SA(0, 1), cA + hstep, voffA);
        if (wr == 1) PG8_BAR;
        PG8_WAIT_V(2); PG8_BAR;
        PG8_STAGE(PG8_SB(1, 0), cB + kstep, voffB); PG8_STAGE(PG8_SA(1, 0), cA + kstep, voffA); PG8_STAGE(PG8_SB(1, 1), cB + hstep + kstep, voffB);
        PG8_WAIT_V(6); PG8_BAR;
    } else {
        PG8_STAGE(PG8_SB(0, 0), cB, voffB); PG8_STAGE(PG8_SA(0, 0), cA, voffA); PG8_STAGE(PG8_SB(0, 1), cB + hstep, voffB); PG8_STAGE(PG8_SA(0, 1), cA + hstep, voffA);
        if (wr == 1) PG8_BAR;
        PG8_WAIT_V(4); PG8_BAR;
        PG8_STAGE(PG8_SB(1, 0), cB + kstep, voffB); PG8_STAGE(PG8_SA(1, 0), cA + kstep, voffA); PG8_STAGE(PG8_SB(1, 1), cB + hstep + kstep, voffB);
        PG8_WAIT_V(6); PG8_BAR;
    }
    for (;;) {
        const bool has_next = S.next(ui + 1, nxt);
        const char* nA = has_next ? (const char*)g.A + (size_t)nxt.pm * tstep : cA; const char* nB = has_next ? (const char*)g.Bt + (size_t)nxt.pn * tstep : cB;
        for (int t = 0; t < nt; t += 2) {
            const bool last = (t == nt - 2);
            const char* a1 = cA + (size_t)(t + 1) * kstep;
            const char* a2 = last ? nA : cA + (size_t)(t + 2) * kstep; const char* b2 = last ? nB : cB + (size_t)(t + 2) * kstep;
            const char* a3 = a2 + kstep; const char* b3 = b2 + kstep;
            if (last && has_next) S.a_ready(nxt);
            if constexpr (SP2) {
            PG8_LDB(B0, 0, 0); PG8_LDB(B1, 0, 1); PG8_SCHED; PG8_LDA(At, 0, 0); PG8_STAGE(PG8_SA(1, 1), a1 + hstep, voffA);
            PG8_WAIT_V(8); PG8_WAIT_L(0); PG8_BAR; PG8_MMA(0, 0, At, B0); PG8_MMA(0, 1, At, B1); PG8_BAR; PG8_SCHED;
            PG8_LDA(At, 0, 1); PG8_STAGE(PG8_SB(0, 0), b2, voffB); PG8_STAGE(PG8_SB(0, 1), b2 + hstep, voffB); PG8_STAGE(PG8_SA(0, 0), a2, voffA);
            PG8_WAIT_V(8); PG8_WAIT_L(0); PG8_BAR; PG8_MMA(1, 0, At, B0); PG8_MMA(1, 1, At, B1); PG8_BAR; PG8_SCHED;
            PG8_LDB(B0, 1, 0); PG8_LDB(B1, 1, 1); PG8_SCHED; PG8_LDA(At, 1, 0); PG8_STAGE(PG8_SA(0, 1), a2 + hstep, voffA);
            PG8_WAIT_V(8); PG8_WAIT_L(0); PG8_BAR; PG8_MMA(0, 0, At, B0); PG8_MMA(0, 1, At, B1); PG8_BAR; PG8_SCHED;
            PG8_LDA(At, 1, 1); PG8_STAGE(PG8_SB(1, 0), b3, voffB); PG8_STAGE(PG8_SB(1, 1), b3 + hstep, voffB); PG8_STAGE(PG8_SA(1, 0), a3, voffA);
            PG8_WAIT_V(8); PG8_WAIT_L(0); PG8_BAR; PG8_MMA(1, 0, At, B0); PG8_MMA(1, 1, At, B1); PG8_BAR; PG8_SCHED;
            } else {
            PG8_LDB(B0, 0, 0); PG8_SCHED; PG8_LDA(At, 0, 0); PG8_STAGE(PG8_SA(1, 1), a1 + hstep, voffA);
            PG8_WAIT_L(8); PG8_BAR; PG8_WAIT_L(0); PG8_MMA(0, 0, At, B0); PG8_BAR; PG8_SCHED;
            PG8_LDB(B1, 0, 1); PG8_STAGE(PG8_SB(0, 0), b2, voffB);
            PG8_BAR; PG8_WAIT_L(0); PG8_MMA(0, 1, At, B1); PG8_BAR;
            PG8_LDA(At, 0, 1); PG8_STAGE(PG8_SA(0, 0), a2, voffA);
            PG8_BAR; PG8_WAIT_L(0); PG8_MMA(1, 0, At, B0); PG8_BAR; PG8_SCHED;
            PG8_STAGE(PG8_SB(0, 1), b2 + hstep, voffB);
            PG8_WAIT_V(6); PG8_BAR; PG8_MMA(1, 1, At, B1); PG8_BAR;
            PG8_LDB(B0, 1, 0); PG8_SCHED; PG8_LDA(At, 1, 0); PG8_STAGE(PG8_SA(0, 1), a2 + hstep, voffA);
            PG8_WAIT_L(8); PG8_BAR; PG8_WAIT_L(0); PG8_MMA(0, 0, At, B0); PG8_BAR; PG8_SCHED;
            PG8_LDB(B1, 1, 1); PG8_STAGE(PG8_SB(1, 0), b3, voffB);
            PG8_BAR; PG8_WAIT_L(0); PG8_MMA(0, 1, At, B1); PG8_BAR;
            PG8_LDA(At, 1, 1); PG8_STAGE(PG8_SA(1, 0), a3, voffA);
            PG8_BAR; PG8_WAIT_L(0); PG8_MMA(1, 0, At, B0); PG8_BAR; PG8_SCHED;
            PG8_STAGE(PG8_SB(1, 1), b3 + hstep, voffB);
            PG8_WAIT_V(6); PG8_BAR; PG8_MMA(1, 1, At, B1); PG8_BAR;
            }
        }
        if constexpr (ALIGN_EPI) { if (wr == 0) PG8_BAR; }
        if constexpr (!Epi::AFTER_DRAIN) { E(acc, cur, wr, wc, fr, fq); S.done(cur); }
        if (!has_next) break;
#pragma unroll
        for (int a = 0; a < 2; ++a)
#pragma unroll
            for (int b = 0; b < 2; ++b)
#pragma unroll
                for (int m = 0; m < 4; ++m)
#pragma unroll
                    for (int n = 0; n < 2; ++n) acc[a][b][m][n] = (f32x4){0.f, 0.f, 0.f, 0.f};
        cur = nxt; cA = nA; cB = nB; ++ui;
        if constexpr (ALIGN_EPI) { if (wr == 1) PG8_BAR; }
    }
    PG8_WAIT_V(0);
    if constexpr (!ALIGN_EPI) { if (wr == 0) PG8_BAR; }
    PG8_BAR;
    if constexpr (Epi::AFTER_DRAIN) { E.fused(acc, cur, wr, wc, fr, fq, lds, wid, lane); S.done(cur); }
#undef PG8_SA
#undef PG8_SB
#undef PG8_STAGE
#undef PG8_LDA
#undef PG8_LDB
#undef PG8_MMA
#undef PG8_WAIT_V
#undef PG8_WAIT_L
#undef PG8_BAR
#undef PG8_SCHED
}
}

#define LAS __attribute__((address_space(3)))
#define DEV __device__ __forceinline__
typedef unsigned short bf16_t;
typedef float f32x4 __attribute__((ext_vector_type(4)));
typedef short bf16x8 __attribute__((ext_vector_type(8)));
typedef unsigned u32x4 __attribute__((ext_vector_type(4)));
typedef unsigned u32x2 __attribute__((ext_vector_type(2)));
typedef __bf16 bf2_t __attribute__((ext_vector_type(2)));

constexpr int TP = 32768, TS = 1024, T = TP + TS;
constexpr float EPS = 1e-6f;
constexpr size_t O_NKP = 34603008, O_NVP = O_NKP + 131072, O_NKS = O_NVP + 131072, O_NVS = O_NKS + 131072,
                 O_SVP = O_NVS + 131072, O_SVS = O_SVP + 524288, O_END = O_SVS + 524288;
static_assert(O_END == 36175872, "output size");
constexpr size_t KiB = 1024, MiB = 1048576;
constexpr size_t WS_RSTD1 = 0, WS_LNSTAT = 256 * KiB, WS_SSQ2 = 768 * KiB, WS_RSTD3 = 1024 * KiB, WS_BAR = 1536 * KiB;
constexpr size_t WS_WIN = 2 * MiB, WS_WA = WS_WIN + 7680 * KiB, WS_WB = WS_WA + MiB, WS_WOUT = WS_WB + MiB, WS_WQ = WS_WOUT + 2 * MiB,
                 WS_SK = WS_WQ + 4 * MiB, WS_WPLE = WS_SK + 512 * KiB, WS_WG = WS_WPLE + 512 * KiB, WS_SGUW = WS_WG + 2 * MiB,
                 WS_CK = 21 * MiB, WS_CVT = 25 * MiB, WS_PU = 29 * MiB, WS_PV = 61 * MiB, WS_PB = 93 * MiB,
                 WS_S1 = 110 * MiB, WS_S2 = 242 * MiB, WS_S3 = 308 * MiB, WS_S4 = 374 * MiB, WS_S5 = 440 * MiB, WS_END = 482 * MiB;
static_assert(WS_SGUW + 128 * KiB <= WS_CK, "ws map");
constexpr int LDS_BYTES = 143360 + 64;

struct KArgs { const float* in[26]; float* out; unsigned char* ws; };

DEV unsigned pk2(float lo, float hi) { unsigned r; asm("v_cvt_pk_bf16_f32 %0, %1, %2" : "=v"(r) : "v"(lo), "v"(hi)); return r; }
DEV unsigned f2bf(float f) { return pk2(f, f) & 0xffffu; }
DEV float bflo(unsigned w) { return __builtin_bit_cast(float, w << 16); }
DEV float bfhi(unsigned w) { return __builtin_bit_cast(float, w & 0xffff0000u); }
DEV float bf1(bf16_t h) { return __builtin_bit_cast(float, (unsigned)h << 16); }
DEV float gelu_t(float x) { const float u = 1.5957691216f * (x + 0.044715f * x * x * x); return x * __builtin_amdgcn_rcpf(1.f + __expf(-u)); }
DEV float sigm(float x) { return __builtin_amdgcn_rcpf(1.f + __expf(-x)); }
DEV void st8bf(bf16_t* p, const float (&v)[8]) { u32x4 w; w.x = pk2(v[0], v[1]); w.y = pk2(v[2], v[3]); w.z = pk2(v[4], v[5]); w.w = pk2(v[6], v[7]); *(u32x4*)p = w; }
DEV void ld8bf(const bf16_t* p, float (&v)[8]) { const u32x4 w = *(const u32x4*)p; v[0] = bflo(w.x); v[1] = bfhi(w.x); v[2] = bflo(w.y); v[3] = bfhi(w.y); v[4] = bflo(w.z); v[5] = bfhi(w.z); v[6] = bflo(w.w); v[7] = bfhi(w.w); }
DEV void st8f(float* p, const float (&v)[8]) { *(f32x4*)p = (f32x4){v[0], v[1], v[2], v[3]}; *(f32x4*)(p + 4) = (f32x4){v[4], v[5], v[6], v[7]}; }
DEV void ld8f(const float* p, float (&v)[8]) { const f32x4 a = *(const f32x4*)p, b = *(const f32x4*)(p + 4); v[0] = a.x; v[1] = a.y; v[2] = a.z; v[3] = a.w; v[4] = b.x; v[5] = b.y; v[6] = b.z; v[7] = b.w; }
DEV float wave_sum(float v) {
#pragma unroll
    for (int o = 1; o < 64; o <<= 1) v += __shfl_xor(v, o);
    return v;
}
DEV float rowmax16(float v) { v = fmaxf(v, __shfl_xor(v, 1)); v = fmaxf(v, __shfl_xor(v, 2)); v = fmaxf(v, __shfl_xor(v, 4)); v = fmaxf(v, __shfl_xor(v, 8)); return v; }
DEV float rowsum16(float v) { v += __shfl_xor(v, 1); v += __shfl_xor(v, 2); v += __shfl_xor(v, 4); v += __shfl_xor(v, 8); return v; }
DEV int rowmax16i(int v) { v = max(v, __shfl_xor(v, 1)); v = max(v, __shfl_xor(v, 2)); v = max(v, __shfl_xor(v, 4)); v = max(v, __shfl_xor(v, 8)); return v; }
template <int CTRL> DEV float dppf(float v) { return __builtin_bit_cast(float, __builtin_amdgcn_update_dpp(0, __builtin_bit_cast(int, v), CTRL, 0xf, 0xf, false)); }
DEV float vmax(float a, float b) { float r; asm("v_max_f32_e32 %0, %1, %2" : "=v"(r) : "v"(a), "v"(b)); return r; }
DEV float vmin(float a, float b) { float r; asm("v_min_f32_e32 %0, %1, %2" : "=v"(r) : "v"(a), "v"(b)); return r; }
#define ROR_MAX(N) DEV float vmax_ror##N(float v) { float r; asm("s_nop 1\n\tv_max_f32_dpp %0, %1, %1 row_ror:" #N " row_mask:0xf bank_mask:0xf" : "=v"(r) : "v"(v)); return r; }
ROR_MAX(8) ROR_MAX(4) ROR_MAX(2) ROR_MAX(1)
DEV float rowmax16d(float v) { v = vmax_ror8(v); v = vmax_ror4(v); v = vmax_ror2(v); v = vmax_ror1(v); return v; }
DEV float rowsum16d(float v) { v += dppf<0x128>(v); v += dppf<0x124>(v); v += dppf<0x122>(v); v += dppf<0x121>(v); return v; }
DEV f32x4 mfma16(bf16x8 a, bf16x8 b, f32x4 c) { return __builtin_amdgcn_mfma_f32_16x16x32_bf16(a, b, c, 0, 0, 0); }
DEV const float* xrow(const KArgs& A, int row) { return row < TP ? A.in[0] + (size_t)row * 1024 : A.in[1] + (size_t)(row - TP) * 1024; }

template <int mode> struct Epi {
    static constexpr bool PERM = true, AFTER_DRAIN = false;
    const float* xp; const float* xs; float* out; unsigned char* ws;
    DEV void operator()(const f32x4 (&acc)[2][2][4][2], const pg8::Unit& u, int wr, int wc, int fr, int fq) const {
        rowop<0, 0>(acc, u, wr, wc, fr, fq); rowop<0, 1>(acc, u, wr, wc, fr, fq); rowop<0, 2>(acc, u, wr, wc, fr, fq); rowop<0, 3>(acc, u, wr, wc, fr, fq);
        rowop<1, 0>(acc, u, wr, wc, fr, fq); rowop<1, 1>(acc, u, wr, wc, fr, fq); rowop<1, 2>(acc, u, wr, wc, fr, fq); rowop<1, 3>(acc, u, wr, wc, fr, fq);
    }
    template <int ai, int m>
    DEV void rowop(const f32x4 (&acc)[2][2][4][2], const pg8::Unit& u, int wr, int wc, int fr, int fq) const {
        const int pn = u.pn;
            {
                const int row = u.pm * 256 + ai * 128 + wr * 64 + m * 16 + fr;
                float rs = 1.f, s1 = 0.f, s2 = 0.f;
                if (mode == 1) rs = ((const float*)(ws + WS_RSTD1))[row];
                else if (mode == 5) rs = rsqrtf(((const float*)(ws + WS_SSQ2))[row] * (1.f / 1024.f) + EPS);
                else if (mode == 7) rs = ((const float*)(ws + WS_RSTD3))[row];
#pragma unroll
                for (int bj = 0; bj < 2; ++bj) {
                    const int col0 = pn * 256 + bj * 128 + wc * 32 + 8 * fq;
                    float v[8];
#pragma unroll
                    for (int i = 0; i < 4; ++i) { v[i] = acc[ai][bj][m][0][i] * rs; v[4 + i] = acc[ai][bj][m][1][i] * rs; }
                    if (mode == 1) {
                        if (pn < 2 || (pn == 2 && bj == 0)) {
                            st8bf((bf16_t*)(ws + WS_S3) + (size_t)row * 640 + col0, v);
                        } else if (pn == 2) {
                            const int c = col0 - 640, chunk = row >> 7, tok = row & 127;
                            bf16_t* vt = (bf16_t*)(ws + WS_S3) + (size_t)T * 640 + (size_t)chunk * 16384 + c * 128 + tok;
#pragma unroll
                            for (int i = 0; i < 8; ++i) vt[i * 128] = (bf16_t)f2bf(v[i]);
                            if (row >= TP) st8f(out + O_NVS + (size_t)(row - TP) * 128 + c, v);
                            else if ((row & 4095) >= 3968) st8f(out + O_NVP + (size_t)((row >> 12) * 128 + (row & 4095) - 3968) * 128 + c, v);
                        } else if (pn < 5) {
#pragma unroll
                            for (int i = 0; i < 8; ++i) v[i] = gelu_t(v[i]);
                            st8bf((bf16_t*)(ws + WS_S4) + (size_t)row * 512 + (col0 - 768), v);
                        } else if (pn < 7) {
                            const int c = col0 - 1280, chunk = row >> 7, tok = row & 127;
                            bf16_t* gt = (bf16_t*)(ws + WS_S4) + (size_t)T * 512 + (size_t)chunk * 65536 + c * 128 + tok;
#pragma unroll
                            for (int i = 0; i < 8; ++i) { const unsigned hb = f2bf(gelu_t(v[i])); gt[i * 128] = (bf16_t)hb; const float gr = bf1((bf16_t)hb); s1 += gr; s2 += gr * gr; }
                        } else {
#pragma unroll
                            for (int i = 0; i < 8; ++i) v[i] = sigm(v[i]);
                            st8bf((bf16_t*)(ws + WS_S1) + (size_t)row * 2048 + (col0 - 1792), v);
                        }
                    } else if (mode == 2) {
                        float g[8]; ld8bf((const bf16_t*)(ws + WS_S1) + (size_t)row * 2048 + col0, g);
#pragma unroll
                        for (int i = 0; i < 8; ++i) v[i] *= g[i];
                        st8bf((bf16_t*)(ws + WS_S3) + (size_t)row * 1024 + col0, v);
                    } else if (mode == 3) {
                        float g[8], t[8]; ld8bf((const bf16_t*)(ws + WS_S1) + (size_t)row * 2048 + 1024 + col0, g); ld8bf((const bf16_t*)(ws + WS_S3) + (size_t)row * 1024 + col0, t);
#pragma unroll
                        for (int i = 0; i < 8; ++i) v[i] = t[i] + g[i] * v[i];
                        st8bf((bf16_t*)(ws + WS_S4) + (size_t)row * 1024 + col0, v);
                    } else if (mode == 4) {
                        float xv[8]; ld8bf((const bf16_t*)out + (size_t)row * 1024 + col0, xv);
#pragma unroll
                        for (int i = 0; i < 8; ++i) { v[i] += xv[i]; s1 += v[i] * v[i]; }
                        st8bf((bf16_t*)(ws + WS_S3) + (size_t)row * 1024 + col0, v);
                    } else if (mode == 5) {
                        st8bf((bf16_t*)(ws + WS_S1) + (size_t)row * 2048 + col0, v);
                    } else if (mode == 6) {
                        st8bf((bf16_t*)(ws + WS_S4) + (size_t)row * 1024 + col0, v);
                    } else {
                        float x2[8], pe[8]; ld8bf((const bf16_t*)(ws + WS_S2) + (size_t)row * 1024 + col0, x2); ld8bf((const bf16_t*)(ws + WS_S4) + (size_t)row * 1024 + col0, pe);
#pragma unroll
                        for (int i = 0; i < 8; ++i) v[i] = x2[i] + sigm(v[i]) * pe[i];
                        st8f(out + (size_t)row * 1024 + col0, v);
                    }
                }
                if ((mode == 1 && (pn == 5 || pn == 6)) || mode == 4) {
                    s1 += __shfl_xor(s1, 16); s1 += __shfl_xor(s1, 32); s2 += __shfl_xor(s2, 16); s2 += __shfl_xor(s2, 32);
                    if (fq == 0) {
                        if (mode == 1) { float* ls = (float*)(ws + WS_LNSTAT) + (size_t)row * 2; atomicAdd(ls, s1); atomicAdd(ls + 1, s2); }
                        else atomicAdd((float*)(ws + WS_SSQ2) + row, s1);
                    }
                }
            }
    }
};

DEV void tr_item(const float* W, const float* ksc, int K, int N, bf16_t* WT, LAS float* scr, int item, int lane) {
    const int nblk = N / 32, kb = item / nblk, nb = item % nblk, k0 = 64 * kb, n0 = 32 * nb;
    const int r = lane >> 3, c4 = (lane & 7) * 4;
    f32x4 w[8];
#pragma unroll
    for (int i = 0; i < 8; ++i) w[i] = *(const f32x4*)(W + (size_t)(k0 + 8 * i + r) * N + n0 + c4);
#pragma unroll
    for (int i = 0; i < 8; ++i) { const int kk = 8 * i + r; const float sc = ksc ? ksc[k0 + kk] : 1.f; LAS float* d = scr + kk * 33 + c4;
        d[0] = w[i].x * sc; d[1] = w[i].y * sc; d[2] = w[i].z * sc; d[3] = w[i].w * sc; }
    asm volatile("s_waitcnt lgkmcnt(0)" ::: "memory");
    const int c = lane & 7;
#pragma unroll
    for (int j = 0; j < 4; ++j) { const int n = (lane >> 3) + 8 * j; const LAS float* s = scr + (8 * c) * 33 + n;
        u32x4 o; o.x = pk2(s[0 * 33], s[1 * 33]); o.y = pk2(s[2 * 33], s[3 * 33]); o.z = pk2(s[4 * 33], s[5 * 33]); o.w = pk2(s[6 * 33], s[7 * 33]);
        *(u32x4*)(WT + (size_t)(n0 + n) * K + k0 + 8 * c) = o; }
    asm volatile("s_waitcnt lgkmcnt(0)" ::: "memory");
}
DEV void cvt_flat(const float* src, bf16_t* dst, int ngroups, int gtid, int NT) {
    for (int i = gtid; i < ngroups / 4; i += NT) {
        float v[4][8];
#pragma unroll
        for (int u = 0; u < 4; ++u) ld8f(src + ((size_t)u * (ngroups / 4) + i) * 8, v[u]);
#pragma unroll
        for (int u = 0; u < 4; ++u) st8bf(dst + ((size_t)u * (ngroups / 4) + i) * 8, v[u]);
    }
}
constexpr float PEER_SU = 64.f, PEER_SV = 24.f;
DEV unsigned pk8_fp4(const float (&v)[8], float sc) {
    unsigned p = 0;
    p = __builtin_amdgcn_cvt_scalef32_pk_fp4_f32(p, v[0] * sc, v[1] * sc, 1.0f, 0); p = __builtin_amdgcn_cvt_scalef32_pk_fp4_f32(p, v[2] * sc, v[3] * sc, 1.0f, 1);
    p = __builtin_amdgcn_cvt_scalef32_pk_fp4_f32(p, v[4] * sc, v[5] * sc, 1.0f, 2); p = __builtin_amdgcn_cvt_scalef32_pk_fp4_f32(p, v[6] * sc, v[7] * sc, 1.0f, 3);
    return p;
}
DEV void cvt_fp4(const float* src, unsigned char* dst, int ngroups  , float sc, int gtid, int NT) {
    for (int i = gtid; i < ngroups / 4; i += NT) {
        float v[4][8];
#pragma unroll
        for (int u = 0; u < 4; ++u) ld8f(src + ((size_t)u * (ngroups / 4) + i) * 8, v[u]);
#pragma unroll
        for (int u = 0; u < 4; ++u) ((unsigned*)dst)[(size_t)u * (ngroups / 4) + i] = pk8_fp4(v[u], sc);
    }
}
DEV void p0_phase(const KArgs& A, LAS unsigned char* lds, int lane, int wave, int gw, int NGW, int gtid, int NT, const int part) {
    unsigned char* ws = A.ws;
    if (part == 0) { float* ls = (float*)(ws + WS_LNSTAT); for (int i = gtid; i < T * 2; i += NT) ls[i] = 0.f;
      float* sq = (float*)(ws + WS_SSQ2); for (int i = gtid; i < T; i += NT) sq[i] = 0.f; }
    LAS float* scr = (LAS float*)(lds + wave * 8704);
    constexpr int I_IN = 16 * 120, I_A = 8 * 32, I_B = 8 * 32, I_O = 16 * 32, I_Q = 16 * 64, I_P = 4 * 32, I_G = 16 * 32, NIT = I_IN + I_A + I_B + I_O + I_Q + I_P + I_G;
    constexpr int I_MID = I_IN + I_A + I_B + I_O;
    for (int it = (part == 0 ? gw : (part == 1 ? I_IN + gw : I_MID + gw)); it < (part == 0 ? I_IN : (part == 1 ? I_MID : (part == 3 ? NIT : 0))); it += NGW) {
        int r = it; const float* W; const float* sc = nullptr; int K, N; bf16_t* WT;
        if (r < I_IN) { W = A.in[7]; sc = A.in[6]; K = 1024; N = 3840; WT = (bf16_t*)(ws + WS_WIN); }
        else if ((r -= I_IN) < I_A) { W = A.in[15]; K = 512; N = 1024; WT = (bf16_t*)(ws + WS_WA); }
        else if ((r -= I_A) < I_B) { W = A.in[16]; K = 512; N = 1024; WT = (bf16_t*)(ws + WS_WB); }
        else if ((r -= I_B) < I_O) { W = A.in[17]; K = 1024; N = 1024; WT = (bf16_t*)(ws + WS_WOUT); }
        else if ((r -= I_O) < I_Q) { W = A.in[19]; sc = A.in[18]; K = 1024; N = 2048; WT = (bf16_t*)(ws + WS_WQ); }
        else if ((r -= I_Q) < I_P) { W = A.in[24]; K = 256; N = 1024; WT = (bf16_t*)(ws + WS_WPLE); }
        else { r -= I_P; W = A.in[25]; sc = A.in[23]; K = 1024; N = 1024; WT = (bf16_t*)(ws + WS_WG); }
        tr_item(W, sc, K, N, WT, scr, r, lane);
    }
    if (part == 2) {
    cvt_flat(A.in[4], (bf16_t*)(ws + WS_PB), 1048576, gtid, NT);
    cvt_flat(A.in[5], (bf16_t*)(ws + WS_PB) + (size_t)TP * 256, 32768, gtid, NT);
    }
    if (part == 1) {
    cvt_flat(A.in[20], (bf16_t*)(ws + WS_SK), 32768, gtid, NT);
    cvt_flat(A.in[2], (bf16_t*)(ws + WS_CK), 262144, gtid, NT);
    for (int i = gtid; i < 8192; i += NT) {
        const int t = (i >> 4) & 127, s0 = (i & 15) * 8; float v[8]; ld8f(A.in[13] + (size_t)i * 8, v);
#pragma unroll
        for (int e = 0; e < 8; ++e) if (s0 + e > t) v[e] = 0.f;
        st8bf((bf16_t*)(ws + WS_SGUW) + (size_t)i * 8, v);
    }
    for (int i = gtid; i < 262144; i += NT) {
        const int d = i & 63, kg = (i >> 6) & 15, kvh = (i >> 10) & 1, seq = i >> 11; float v[8];
#pragma unroll
        for (int e = 0; e < 8; ++e) v[e] = A.in[3][((size_t)(seq * 128 + kg * 8 + e) * 2 + kvh) * 64 + d];
        st8bf((bf16_t*)(ws + WS_CVT) + ((size_t)(seq * 2 + kvh) * 64 + d) * 128 + kg * 8, v);
    }
    }
    if (part == 0)
    for (int row0 = gw * 2; row0 < T; row0 += NGW * 2) {
        f32x4 v[2][4]; float s[2];
#pragma unroll
        for (int r = 0; r < 2; ++r) { const f32x4* xr = (const f32x4*)xrow(A, row0 + r) + lane;
#pragma unroll
            for (int j = 0; j < 4; ++j) v[r][j] = xr[64 * j]; }
#pragma unroll
        for (int r = 0; r < 2; ++r) { s[r] = 0.f;
#pragma unroll
            for (int j = 0; j < 4; ++j) s[r] += (v[r][j].x * v[r][j].x + v[r][j].y * v[r][j].y) + (v[r][j].z * v[r][j].z + v[r][j].w * v[r][j].w);
            s[r] = wave_sum(s[r]);
            if (lane == 0) ((float*)(ws + WS_RSTD1))[row0 + r] = rsqrtf(s[r] * (1.f / 1024.f) + EPS);
            u32x2* o = (u32x2*)((bf16_t*)A.out + (size_t)(row0 + r) * 1024) + lane;
#pragma unroll
            for (int j = 0; j < 4; ++j) { u32x2 w; w.x = pk2(v[r][j].x, v[r][j].y); w.y = pk2(v[r][j].z, v[r][j].w); o[64 * j] = w; } }
    }
}

DEV void p2_item(const KArgs& A, const bf16_t* zqk, bf16_t* qn, bf16_t* kn, int i, float (&v)[8]) {
    const int row = i / 80, g = i - row * 80;
    float ss = 0.f;
#pragma unroll
    for (int e = 0; e < 8; ++e) ss += v[e] * v[e];
    ss += __shfl_xor(ss, 1); ss += __shfl_xor(ss, 2); ss += __shfl_xor(ss, 4);
    const float r = rsqrtf(ss * (1.f / 64.f) + EPS);
    const int d0 = (g & 7) * 8;
    if (g < 64) {
        float gg[8]; ld8f(A.in[8] + d0, gg);
#pragma unroll
        for (int e = 0; e < 8; ++e) v[e] = v[e] * r * gg[e] * 0.125f;
        st8bf(qn + (size_t)row * 512 + g * 8, v);
    } else {
        float gg[8]; ld8f(A.in[9] + d0, gg);
#pragma unroll
        for (int e = 0; e < 8; ++e) v[e] = v[e] * r * gg[e];
        const int c = (g - 64) * 8;
        st8bf(kn + (size_t)row * 128 + c, v);
        if (row >= TP) st8f(A.out + O_NKS + (size_t)(row - TP) * 128 + c, v);
        else if ((row & 4095) >= 3968) st8f(A.out + O_NKP + (size_t)((row >> 12) * 128 + (row & 4095) - 3968) * 128 + c, v);
    }
}
DEV void p2_phase(const KArgs& A, int gtid, int NT) {
    unsigned char* ws = A.ws;
    const bf16_t* zqk = (const bf16_t*)(ws + WS_S3);
    bf16_t* qn = (bf16_t*)(ws + WS_S5); bf16_t* kn = qn + (size_t)T * 512;
    constexpr int NI = T * 80, Q4 = NI / 4;
    static_assert(NI % 4 == 0 && Q4 % 64 == 0, "p2 split");
    for (int i = gtid; i < Q4; i += NT) {
        float v[4][8];
#pragma unroll
        for (int u = 0; u < 4; ++u) { const int ii = u * Q4 + i; const int row = ii / 80, g = ii - row * 80; ld8bf(zqk + (size_t)row * 640 + g * 8, v[u]); }
#pragma unroll
        for (int u = 0; u < 4; ++u) p2_item(A, zqk, qn, kn, u * Q4 + i, v[u]);
    }
}

template <bool SAMPLE>
DEV void attn_task(const KArgs& A, int task, LAS bf16_t* P, int lane) {
    unsigned char* ws = A.ws;
    const bf16_t* qn = (const bf16_t*)(ws + WS_S5);
    const bf16_t* kn = qn + (size_t)T * 512;
    const bf16_t* VT = (const bf16_t*)(ws + WS_S3) + (size_t)T * 640;
    const bf16_t* ck = (const bf16_t*)(ws + WS_CK);
    const bf16_t* cvT = (const bf16_t*)(ws + WS_CVT);
    bf16_t* ab = (bf16_t*)(ws + WS_S2);
    const int fr = lane & 15, quad = lane >> 4;
    int kvh, st = 0, cj = 0, j = 0, prevc = 0, seq = 0, i0 = 0, hq_u = 0, p2 = 0;
    if (!SAMPLE) { const int unit = task >> 5, sub = task & 31, w = sub >> 2, a = (w & 1) * 4 + (sub & 3); kvh = unit & 1; cj = unit >> 1; j = cj & 31; prevc = j > 0 ? cj - 1 : cj; i0 = 16 * a; st = a < 6 ? a : 6; hq_u = kvh * 4 + (w >> 1); }
    else { seq = task >> 2; kvh = (task >> 1) & 1; p2 = task & 1; }
    size_t qoff;
    if (!SAMPLE) qoff = (size_t)(cj * 128 + i0 + fr) * 512 + hq_u * 64;
    else qoff = (size_t)(TP + seq * 8 + (fr & 7)) * 512 + (kvh * 4 + 2 * p2 + (fr >> 3)) * 64;
    const bf16x8 qa0 = *(const bf16x8*)(qn + qoff + quad * 8), qa1 = *(const bf16x8*)(qn + qoff + 32 + quad * 8);
    f32x4 S[10];
#pragma unroll
    for (int t = 0; t < 10; ++t) {
        const int r = (st + t) * 16 + fr; const bf16_t* kp;
        if (!SAMPLE) { const int tk = (r < 128) ? prevc * 128 + r : cj * 128 + r - 128; kp = kn + (size_t)tk * 128 + kvh * 64; }
        else { if (r < 128) kp = ck + ((size_t)(seq * 128 + r) * 2 + kvh) * 64; else { int l2 = r - 128; l2 = l2 > 7 ? 7 : l2; kp = kn + (size_t)(TP + seq * 8 + l2) * 128 + kvh * 64; } }
        const bf16x8 kb0 = *(const bf16x8*)(kp + quad * 8), kb1 = *(const bf16x8*)(kp + 32 + quad * 8);
        f32x4 z = {0.f, 0.f, 0.f, 0.f}; z = mfma16(qa0, kb0, z); z = mfma16(qa1, kb1, z); S[t] = z;
    }
    bf16x8 vbf[5][4];
#pragma unroll
    for (int ks = 0; ks < 5; ++ks) {
        const int k0 = st * 16 + ks * 32 + quad * 8;
#pragma unroll
        for (int nt = 0; nt < 4; ++nt) {
            const int d = nt * 16 + fr; const bf16_t* vp;
            if (!SAMPLE) vp = (k0 < 128) ? VT + (size_t)prevc * 16384 + (kvh * 64 + d) * 128 + k0 : VT + (size_t)cj * 16384 + (kvh * 64 + d) * 128 + (k0 - 128);
            else vp = (k0 < 128) ? cvT + ((size_t)(seq * 2 + kvh) * 64 + d) * 128 + k0 : VT + (size_t)(256 + (seq >> 4)) * 16384 + (kvh * 64 + d) * 128 + (seq & 15) * 8;
            vbf[ks][nt] = *(const bf16x8*)vp;
        }
    }
    const int hq_c = SAMPLE ? (kvh * 4 + 2 * p2 + (quad >> 1)) : hq_u;
    const float slope = exp2f(-(float)(hq_c + 1)), sink = A.in[10][hq_c];
    float inv_l[4];
#pragma unroll
    for (int reg = 0; reg < 4; ++reg) {
        const int irow = SAMPLE ? ((quad & 1) * 4 + reg) : (i0 + quad * 4 + reg);
        float mx = sink, sv[10];
#pragma unroll
        for (int t = 0; t < 10; ++t) {
            const int r = (st + t) * 16 + fr, dist = irow - r + 128;
            const bool valid = dist >= 0 && dist < 128 && (SAMPLE ? (r < 136) : (j > 0 || r >= 128));
            const float s = valid ? S[t][reg] - slope * (float)dist : -1e30f; sv[t] = s; mx = vmax(mx, s);
        }
        mx = rowmax16d(mx);
        float l = 0.f;
#pragma unroll
        for (int t = 0; t < 10; ++t) { const float p = __expf(sv[t] - mx); l += p; P[(quad * 4 + reg) * 168 + t * 16 + fr] = (bf16_t)f2bf(p); }
        l = rowsum16d(l) + __expf(sink - mx);
        inv_l[reg] = __builtin_amdgcn_rcpf(l);
    }
    if (fr == 0) { LAS float* Li = (LAS float*)(P + 16 * 168);
#pragma unroll
        for (int reg = 0; reg < 4; ++reg) Li[quad * 4 + reg] = inv_l[reg]; }
    asm volatile("s_waitcnt lgkmcnt(0)" ::: "memory");
    f32x4 O[4];
#pragma unroll
    for (int nt = 0; nt < 4; ++nt) O[nt] = (f32x4){0.f, 0.f, 0.f, 0.f};
#pragma unroll
    for (int ks = 0; ks < 5; ++ks) {
        const bf16x8 pa = *(const LAS bf16x8*)(P + fr * 168 + ks * 32 + quad * 8);
#pragma unroll
        for (int nt = 0; nt < 4; ++nt) O[nt] = mfma16(vbf[ks][nt], pa, O[nt]);
    }
    {
        const float il = ((const LAS float*)(P + 16 * 168))[fr]; size_t ooff;
        if (!SAMPLE) ooff = (size_t)(cj * 128 + i0 + fr) * 512 + hq_u * 64;
        else ooff = (size_t)(TP + seq * 8 + (fr & 7)) * 512 + (kvh * 4 + 2 * p2 + (fr >> 3)) * 64;
#pragma unroll
        for (int nt = 0; nt < 4; ++nt) { const f32x4 ov = O[nt]; u32x2 w; w.x = pk2(ov[0] * il, ov[1] * il); w.y = pk2(ov[2] * il, ov[3] * il); *(u32x2*)(ab + ooff + nt * 16 + quad * 4) = w; }
    }
    asm volatile("s_waitcnt lgkmcnt(0)" ::: "memory");
}

DEV void ln_stats8(const float* st, float (&mean)[8], float (&rstd)[8]) {
#pragma unroll
    for (int e2 = 0; e2 < 4; ++e2) {
        const f32x4 q = ((const f32x4*)st)[e2];
        const float m0 = q.x * (1.f / 512.f), m1 = q.z * (1.f / 512.f);
        mean[2 * e2] = m0; mean[2 * e2 + 1] = m1;
        rstd[2 * e2] = rsqrtf(fmaxf(q.y * (1.f / 512.f) - m0 * m0, 0.f) + EPS); rstd[2 * e2 + 1] = rsqrtf(fmaxf(q.w * (1.f / 512.f) - m1 * m1, 0.f) + EPS);
    }
}

DEV void sgu_task(const KArgs& A, int task, int lane) {
    unsigned char* ws = A.ws;
    const int fr = lane & 15, quad = lane >> 4;
    const int cj = task >> 5, g = (task >> 3) & 3, rb = task & 7, kk = (task >> 11) & 3, rb4 = (rb + 4) & 7;
    const int rt = kk == 0 ? rb : (kk == 1 ? 7 - rb : (kk == 2 ? rb4 : 7 - rb4)), nks = (rt >> 1) + 1;
    const bf16_t* W = (const bf16_t*)(ws + WS_SGUW) + (size_t)(g * 128 + rt * 16 + fr) * 128;
    const bf16_t* gv = (const bf16_t*)(ws + WS_S4) + (size_t)T * 512 + (size_t)cj * 65536 + (size_t)(g * 128 + fr) * 128;
    const float* st = (const float*)(ws + WS_LNSTAT) + (size_t)cj * 256;
    const bf16_t* ub = (const bf16_t*)(ws + WS_S4);
    bf16_t* mb = (bf16_t*)(ws + WS_S2) + (size_t)T * 512;
    f32x4 acc[8];
#pragma unroll
    for (int nt = 0; nt < 8; ++nt) acc[nt] = (f32x4){0.f, 0.f, 0.f, 0.f};
    for (int ks = 0; ks < nks; ++ks) {
        const bf16x8 wa = *(const bf16x8*)(W + ks * 32 + quad * 8);
        float mean[8], rstd[8]; ln_stats8(st + (ks * 32 + quad * 8) * 2, mean, rstd);
#pragma unroll
        for (int nt = 0; nt < 8; ++nt) {
            const int c = g * 128 + nt * 16 + fr; float x[8]; ld8bf(gv + nt * 2048 + ks * 32 + quad * 8, x);
            const float lg = A.in[11][c], lb = A.in[12][c];
#pragma unroll
            for (int e = 0; e < 8; ++e) x[e] = (x[e] - mean[e]) * rstd[e] * lg + lb;
            u32x4 w; w.x = pk2(x[0], x[1]); w.y = pk2(x[2], x[3]); w.z = pk2(x[4], x[5]); w.w = pk2(x[6], x[7]);
            acc[nt] = mfma16(__builtin_bit_cast(bf16x8, w), wa, acc[nt]);
        }
    }
    {
        const int t = rt * 16 + fr; const size_t tok = (size_t)cj * 128 + t; const float bb = A.in[14][g * 128 + t];
#pragma unroll
        for (int nt = 0; nt < 8; ++nt) {
            const int c = g * 128 + nt * 16 + quad * 4;
            const u32x2 uu = *(const u32x2*)(ub + tok * 512 + c); const f32x4 av = acc[nt];
            u32x2 o; o.x = pk2(bflo(uu.x) * (av[0] + bb), bfhi(uu.x) * (av[1] + bb)); o.y = pk2(bflo(uu.y) * (av[2] + bb), bfhi(uu.y) * (av[3] + bb));
            *(u32x2*)(mb + tok * 512 + c) = o;
        }
    }
}

DEV void sgu_small(const KArgs& A, int gtid, int NT) {
    unsigned char* ws = A.ws;
    const bf16_t* gvT = (const bf16_t*)(ws + WS_S4) + (size_t)T * 512;
    const bf16_t* ub = (const bf16_t*)(ws + WS_S4);
    bf16_t* mb = (bf16_t*)(ws + WS_S2) + (size_t)T * 512;
    for (int i = gtid; i < 131072; i += NT) {
        const bool samp = i < 65536; const int ii = samp ? i : i - 65536, c = ii & 511, grp = ii >> 9;
        const int tokbase = samp ? TP + grp * 8 : ((grp >> 4) * 4096 + 3968 + (grp & 15) * 8);
        const int chunk = tokbase >> 7, tok0 = tokbase & 127;
        float x[8], mean[8], rstd[8]; ld8bf(gvT + (size_t)chunk * 65536 + c * 128 + tok0, x);
        ln_stats8((const float*)(ws + WS_LNSTAT) + (size_t)tokbase * 2, mean, rstd);
        const float lg = A.in[11][c], lb = A.in[12][c];
        float* o = samp ? A.out + O_SVS + (size_t)(grp * 8) * 512 + c : A.out + O_SVP + (size_t)((grp >> 4) * 128 + (grp & 15) * 8) * 512 + c;
#pragma unroll
        for (int e = 0; e < 8; ++e) { x[e] = (x[e] - mean[e]) * rstd[e] * lg + lb; o[e * 512] = x[e]; }
        if (samp) {
            const int g = c >> 7;
#pragma unroll
            for (int t = 0; t < 8; ++t) {
                float s = A.in[14][g * 128 + t];
#pragma unroll
                for (int e = 0; e <= t; ++e) s += A.in[13][(size_t)(g * 128 + t) * 128 + e] * x[e];
                const size_t tk = (size_t)tokbase + t; mb[tk * 512 + c] = (bf16_t)f2bf(bf1(ub[tk * 512 + c]) * s);
            }
        }
    }
}

DEV void topk_task(const KArgs& A, int task, LAS float* L  , int lane) {
    unsigned char* ws = A.ws;
    const int fr = lane & 15, quad = lane >> 4;
    const int tok0 = (task >> 3) * 16, h = task & 7;
    const bf16_t* pq = (const bf16_t*)(ws + WS_S1) + (size_t)(tok0 + fr) * 2048 + h * 256 + quad * 8;
    const bf16_t* SK = (const bf16_t*)(ws + WS_SK) + (size_t)(h * 2) * 16384 + (size_t)fr * 128 + quad * 8;
    int* pidx = (int*)(ws + WS_S5); float* pgate = (float*)(ws + WS_S5 + (size_t)T * 512);
    const float NINF = -__builtin_inff();
#pragma unroll
    for (int c = 0; c < 2; ++c) {
        bf16x8 qa[4];
#pragma unroll
        for (int ks = 0; ks < 4; ++ks) qa[ks] = *(const bf16x8*)(pq + c * 128 + ks * 32);
#pragma unroll
        for (int nt = 0; nt < 8; ++nt) {
            f32x4 z = {0.f, 0.f, 0.f, 0.f};
#pragma unroll
            for (int ks = 0; ks < 4; ++ks) z = mfma16(qa[ks], *(const bf16x8*)(SK + (size_t)c * 16384 + nt * 2048 + ks * 32), z);
#pragma unroll
            for (int reg = 0; reg < 4; ++reg)
            { const float zr = z[reg]; L[(c * 16 + quad * 4 + reg) * 128 + nt * 16 + fr] = __builtin_bit_cast(float, (__builtin_bit_cast(unsigned, zr) & ~0x7Fu) | (unsigned)(127 - (nt * 16 + fr))); }
        }
    }
    asm volatile("s_waitcnt lgkmcnt(0)" ::: "memory");
#pragma nounroll
    for (int it = 0; it < 4; ++it) {
        const int row = quad * 4 + it;
        float v[8], top0[16], t1 = 0.f;
#pragma unroll
        for (int nt = 0; nt < 8; ++nt) v[nt] = L[row * 128 + nt * 16 + fr];
#pragma unroll
        for (int rd = 0; rd < 16; ++rd) {
            float m = v[0];
#pragma unroll
            for (int nt = 1; nt < 8; ++nt) m = fmaxf(m, v[nt]);
            const float gm = rowmax16(m); top0[rd] = gm;
#pragma unroll
            for (int nt = 0; nt < 8; ++nt) if (v[nt] == gm) v[nt] = NINF;
        }
#pragma unroll
        for (int nt = 0; nt < 8; ++nt) v[nt] = L[(16 + row) * 128 + nt * 16 + fr];
#pragma unroll
        for (int rd = 0; rd < 16; ++rd) {
            float m = v[0];
#pragma unroll
            for (int nt = 1; nt < 8; ++nt) m = fmaxf(m, v[nt]);
            const float gm = rowmax16(m); if (fr == rd) t1 = gm;
#pragma unroll
            for (int nt = 0; nt < 8; ++nt) if (v[nt] == gm) v[nt] = NINF;
        }
        float cand[16];
#pragma unroll
        for (int i = 0; i < 16; ++i) cand[i] = __builtin_bit_cast(float, (__builtin_bit_cast(unsigned, top0[i] + t1) & ~0xFFu) | (unsigned)(255 - (i * 16 + fr)));
        const int i1 = 127 - (int)(__builtin_bit_cast(unsigned, t1) & 0x7Fu);
        float best = 0.f; int bidx = 0;
#pragma unroll
        for (int rd = 0; rd < 16; ++rd) {
            float m = cand[0];
#pragma unroll
            for (int i = 1; i < 16; ++i) m = fmaxf(m, cand[i]);
            const float gm = rowmax16(m);
            int mine = -1;
#pragma unroll
            for (int i = 0; i < 16; ++i) if (cand[i] == gm) { cand[i] = NINF; mine = (127 - (int)(__builtin_bit_cast(unsigned, top0[i]) & 0x7Fu)) * 128 + i1; }
            const int gi = rowmax16i(mine);
            if (fr == rd) { best = gm; bidx = gi; }
        }
        const float mx = rowmax16(best), e = __expf(best - mx), ssum = rowsum16(e);
        const size_t o = ((size_t)(tok0 + row) * 8 + h) * 16 + fr;
        pidx[o] = bidx; pgate[o] = e / ssum;
    }
    asm volatile("s_waitcnt lgkmcnt(0)" ::: "memory");
}

#define TK_CE(a, b) { const float hi_ = vmax(a, b), lo_ = vmin(a, b); a = hi_; b = lo_; }
DEV float select16(float (&s)[8], int fr) {
    TK_CE(s[0], s[1]) TK_CE(s[2], s[3]) TK_CE(s[4], s[5]) TK_CE(s[6], s[7])
    TK_CE(s[0], s[2]) TK_CE(s[1], s[3]) TK_CE(s[4], s[6]) TK_CE(s[5], s[7])
    TK_CE(s[1], s[2]) TK_CE(s[5], s[6])
    TK_CE(s[0], s[4]) TK_CE(s[1], s[5]) TK_CE(s[2], s[6]) TK_CE(s[3], s[7])
    TK_CE(s[2], s[4]) TK_CE(s[3], s[5])
    TK_CE(s[1], s[2]) TK_CE(s[3], s[4]) TK_CE(s[5], s[6])
    const float NINF = -__builtin_inff(); float mine = 0.f;
#pragma unroll
    for (int rd = 0; rd < 16; ++rd) {
        const float gm = rowmax16d(s[0]); const bool own = (s[0] == gm);
        mine = (fr == rd) ? gm : mine;
#pragma unroll
        for (int k = 0; k < 7; ++k) s[k] = own ? s[k + 1] : s[k];
        s[7] = own ? NINF : s[7];
    }
    return mine;
}
DEV void topk2_task(const KArgs& A, int task, LAS float* L  , int lane) {
    unsigned char* ws = A.ws;
    const int fr = lane & 15, quad = lane >> 4;
    const int tok0 = (task >> 3) * 16, h = task & 7;
    const bf16_t* pq = (const bf16_t*)(ws + WS_S1) + (size_t)(tok0 + fr) * 2048 + h * 256 + quad * 8;
    const bf16_t* SK = (const bf16_t*)(ws + WS_SK) + (size_t)(h * 2) * 16384 + (size_t)fr * 128 + quad * 8;
    int* pidx = (int*)(ws + WS_S5); float* pgate = (float*)(ws + WS_S5 + (size_t)T * 512);
    const float NINF = -__builtin_inff();
#pragma unroll
    for (int c = 0; c < 2; ++c) {
        bf16x8 qa[4];
#pragma unroll
        for (int ks = 0; ks < 4; ++ks) qa[ks] = *(const bf16x8*)(pq + c * 128 + ks * 32);
#pragma unroll
        for (int nt = 0; nt < 8; ++nt) {
            f32x4 z = {0.f, 0.f, 0.f, 0.f};
#pragma unroll
            for (int ks = 0; ks < 4; ++ks) z = mfma16(qa[ks], *(const bf16x8*)(SK + (size_t)c * 16384 + nt * 2048 + ks * 32), z);
#pragma unroll
            for (int reg = 0; reg < 4; ++reg)
            { const float zr = z[reg]; L[(c * 16 + quad * 4 + reg) * 128 + nt * 16 + fr] = __builtin_bit_cast(float, (__builtin_bit_cast(unsigned, zr) & ~0x7Fu) | (unsigned)(127 - (nt * 16 + fr))); }
        }
    }
    asm volatile("s_waitcnt lgkmcnt(0)" ::: "memory");
    const unsigned long long TI1 = 0xFEDCBA9811111111ull, TJ0 = 0xFEDCBA9876543210ull, TJ1 = 0x0000000076543210ull,
                             TI2 = 0x6655444333322222ull, TJ2 = 0x1010210321043210ull;
    const int sh = 4 * fr, rb = lane & 48;
    const int i_s[4] = {0, (int)(TI1 >> sh) & 15, (int)(TI2 >> sh) & 15, 7};
    const int j_s[4] = {(int)(TJ0 >> sh) & 15, (int)(TJ1 >> sh) & 15, (int)(TJ2 >> sh) & 15, fr & 1};
#pragma nounroll
    for (int it = 0; it < 4; ++it) {
        const int row = quad * 4 + it;
        float v[8];
#pragma unroll
        for (int nt = 0; nt < 8; ++nt) v[nt] = L[row * 128 + nt * 16 + fr];
        const float t0 = select16(v, fr);
#pragma unroll
        for (int nt = 0; nt < 8; ++nt) v[nt] = L[(16 + row) * 128 + nt * 16 + fr];
        const float t1 = select16(v, fr);
        float val[4], cur[4]; int idx[4], rec[4];
#pragma unroll
        for (int s4 = 0; s4 < 4; ++s4) {
            const float a = __builtin_bit_cast(float, __builtin_amdgcn_ds_bpermute((rb + i_s[s4]) * 4, __builtin_bit_cast(int, t0)));
            const float b = __builtin_bit_cast(float, __builtin_amdgcn_ds_bpermute((rb + j_s[s4]) * 4, __builtin_bit_cast(int, t1)));
            float sm = __builtin_bit_cast(float, (__builtin_bit_cast(unsigned, a + b) & ~0x3Fu) | (unsigned)(63 - (s4 * 16 + fr)));
            if (s4 == 3 && fr >= 2) sm = NINF;
            val[s4] = sm; cur[s4] = sm; rec[s4] = -1;
            idx[s4] = (127 - (int)(__builtin_bit_cast(unsigned, a) & 0x7Fu)) * 128 + (127 - (int)(__builtin_bit_cast(unsigned, b) & 0x7Fu));
        }
        float gmax = 0.f, ssum = 0.f;
#pragma unroll
        for (int rd = 0; rd < 16; ++rd) {
            const float gm = rowmax16d(vmax(vmax(cur[0], cur[1]), vmax(cur[2], cur[3])));
            if (rd == 0) gmax = gm;
            ssum += __expf(gm - gmax);
#pragma unroll
            for (int s4 = 0; s4 < 4; ++s4) { const bool own = (cur[s4] == gm); cur[s4] = own ? NINF : cur[s4]; rec[s4] = own ? rd : rec[s4]; }
        }
        const float inv = 1.f / ssum; const size_t ob = ((size_t)(tok0 + row) * 8 + h) * 16;
#pragma unroll
        for (int s4 = 0; s4 < 4; ++s4) if (rec[s4] >= 0) { pidx[ob + rec[s4]] = idx[s4]; pgate[ob + rec[s4]] = __expf(val[s4] - gmax) * inv; }
    }
    asm volatile("s_waitcnt lgkmcnt(0)" ::: "memory");
}

constexpr int TK_SKROW = 272, TK_SK_BYTES = 256 * TK_SKROW, TK_L_OFF = TK_SK_BYTES, TK_LT_OFF = TK_L_OFF + 8 * 8192, TK_LDS_END = TK_LT_OFF + 8 * 1024;
DEV void topk3_phase(const KArgs& A, LAS unsigned char* lds, int lane, int wave, int G) {
    unsigned char* ws = A.ws;
    const int fr = lane & 15, quad = lane >> 4, tid = wave * 64 + lane;
    const int h = blockIdx.x & 7, grp = blockIdx.x >> 3, ngrp = G >> 3;
    {
        const unsigned char* src = ws + WS_SK + (size_t)h * 65536;
#pragma unroll
        for (int i = 0; i < 8; ++i) { const int q = tid + 512 * i, row = q >> 4, c16 = q & 15; *(LAS u32x4*)(lds + row * TK_SKROW + c16 * 16) = *(const u32x4*)(src + (size_t)q * 16); }
        asm volatile("s_waitcnt vmcnt(0) lgkmcnt(0)" ::: "memory");
        __builtin_amdgcn_s_barrier();
        asm volatile("" ::: "memory");
    }
    LAS float* L = (LAS float*)(lds + TK_L_OFF + wave * 8192);
    LAS float* Lt = (LAS float*)(lds + TK_LT_OFF + wave * 1024);
    const LAS unsigned char* skb = lds + fr * TK_SKROW + quad * 16;
    int* pidx = (int*)(ws + WS_S5); float* pgate = (float*)(ws + WS_S5 + (size_t)T * 512);
    const float NINF = -__builtin_inff();
    const unsigned long long TI1 = 0xFEDCBA9811111111ull, TJ0 = 0xFEDCBA9876543210ull, TJ1 = 0x0000000076543210ull,
                             TI2 = 0x6655444333322222ull, TJ2 = 0x1010210321043210ull;
    const int sh = 4 * fr, rb = lane & 48;
    const int i_s[4] = {0, (int)(TI1 >> sh) & 15, (int)(TI2 >> sh) & 15, 7};
    const int j_s[4] = {(int)(TJ0 >> sh) & 15, (int)(TJ1 >> sh) & 15, (int)(TJ2 >> sh) & 15, fr & 1};
#pragma nounroll
    for (int tt = grp + ngrp * wave; tt < T / 16; tt += ngrp * 8) {
        const int tok0 = tt * 16;
        const bf16_t* pq = (const bf16_t*)(ws + WS_S1) + (size_t)(tok0 + fr) * 2048 + h * 256 + quad * 8;
        bf16x8 qa[2][4];
#pragma unroll
        for (int c = 0; c < 2; ++c)
#pragma unroll
            for (int ks = 0; ks < 4; ++ks) qa[c][ks] = *(const bf16x8*)(pq + c * 128 + ks * 32);
#pragma unroll
        for (int c = 0; c < 2; ++c) {
#pragma unroll
            for (int nt = 0; nt < 8; ++nt) {
                f32x4 z = {0.f, 0.f, 0.f, 0.f};
#pragma unroll
                for (int ks = 0; ks < 4; ++ks) z = mfma16(qa[c][ks], *(const LAS bf16x8*)(skb + (c * 128 + nt * 16) * TK_SKROW + ks * 64), z);
#pragma unroll
                for (int reg = 0; reg < 4; ++reg)
                { const float zr = z[reg]; L[(quad * 4 + reg) * 128 + nt * 16 + fr] = __builtin_bit_cast(float, (__builtin_bit_cast(unsigned, zr) & ~0x7Fu) | (unsigned)(127 - (nt * 16 + fr))); }
            }
            asm volatile("s_waitcnt lgkmcnt(0)" ::: "memory");
#pragma nounroll
            for (int it = 0; it < 4; ++it) {
                const int row = quad * 4 + it;
                float v[8];
#pragma unroll
                for (int nt = 0; nt < 8; ++nt) v[nt] = L[row * 128 + nt * 16 + fr];
                const float tc = select16(v, fr);
                if (c == 0) { Lt[row * 16 + fr] = tc; }
                else {
                    const float t1 = tc, t0 = Lt[row * 16 + fr];
                    float val[4], cur[4]; int idx[4], rec[4];
#pragma unroll
                    for (int s4 = 0; s4 < 4; ++s4) {
                        const float a = __builtin_bit_cast(float, __builtin_amdgcn_ds_bpermute((rb + i_s[s4]) * 4, __builtin_bit_cast(int, t0)));
                        const float b = __builtin_bit_cast(float, __builtin_amdgcn_ds_bpermute((rb + j_s[s4]) * 4, __builtin_bit_cast(int, t1)));
                        float sm = __builtin_bit_cast(float, (__builtin_bit_cast(unsigned, a + b) & ~0x3Fu) | (unsigned)(63 - (s4 * 16 + fr)));
                        if (s4 == 3 && fr >= 2) sm = NINF;
                        val[s4] = sm; cur[s4] = sm; rec[s4] = -1;
                        idx[s4] = (127 - (int)(__builtin_bit_cast(unsigned, a) & 0x7Fu)) * 128 + (127 - (int)(__builtin_bit_cast(unsigned, b) & 0x7Fu));
                    }
                    float gmax = 0.f, ssum = 0.f;
#pragma unroll
                    for (int rd = 0; rd < 16; ++rd) {
                        const float gm = rowmax16d(vmax(vmax(cur[0], cur[1]), vmax(cur[2], cur[3])));
                        if (rd == 0) gmax = gm;
                        ssum += __expf(gm - gmax);
#pragma unroll
                        for (int s4 = 0; s4 < 4; ++s4) { const bool own = (cur[s4] == gm); cur[s4] = own ? NINF : cur[s4]; rec[s4] = own ? rd : rec[s4]; }
                    }
                    const float inv = __builtin_amdgcn_rcpf(ssum); const size_t ob = ((size_t)(tok0 + row) * 8 + h) * 16;
#pragma unroll
                    for (int s4 = 0; s4 < 4; ++s4) if (rec[s4] >= 0) { pidx[ob + rec[s4]] = idx[s4]; pgate[ob + rec[s4]] = __expf(val[s4] - gmax) * inv; }
                }
            }
            asm volatile("s_waitcnt lgkmcnt(0)" ::: "memory");
        }
    }
}

DEV float wave_max(float v) {
#pragma unroll
    for (int o = 1; o < 64; o <<= 1) v = fmaxf(v, __shfl_xor(v, o));
    return v;
}
DEV void topk_ref_task(const KArgs& A, int task, LAS float* L  , int lane) {
    unsigned char* ws = A.ws;
    const int tok = task >> 3, h = task & 7;
    const bf16_t* pq = (const bf16_t*)(ws + WS_S1) + (size_t)tok * 2048 + h * 256;
    const bf16_t* SK = (const bf16_t*)(ws + WS_SK) + (size_t)(h * 2) * 16384;
    int* pidx = (int*)(ws + WS_S5); float* pgate = (float*)(ws + WS_S5 + (size_t)T * 512);
    const float NINF = -__builtin_inff();
    LAS float* qf = L;
    LAS float* tv = L + 256;
    LAS int* ti = (LAS int*)(L + 288);
    LAS float* bv = L + 320;
    LAS int* bi = (LAS int*)(L + 336);
    { const unsigned long long w = *(const unsigned long long*)(pq + lane * 4); const unsigned lo = (unsigned)w, hi = (unsigned)(w >> 32);
      qf[lane * 4] = bflo(lo); qf[lane * 4 + 1] = bfhi(lo); qf[lane * 4 + 2] = bflo(hi); qf[lane * 4 + 3] = bfhi(hi); }
    asm volatile("s_waitcnt lgkmcnt(0)" ::: "memory");
    float sc[4];
#pragma unroll
    for (int e = 0; e < 4; ++e) {
        const int p = lane + 64 * e, c = p >> 7, n = p & 127; const bf16_t* kr = SK + (size_t)(c * 128 + n) * 128; float s = 0.f;
#pragma nounroll
        for (int d = 0; d < 128; d += 8) { float kv[8]; ld8bf(kr + d, kv);
#pragma unroll
            for (int j = 0; j < 8; ++j) s += qf[c * 128 + d + j] * kv[j]; }
        sc[e] = s;
    }
#pragma unroll
    for (int c = 0; c < 2; ++c)
#pragma nounroll
        for (int rd = 0; rd < 16; ++rd) {
            const float m = wave_max(fmaxf(sc[2 * c], sc[2 * c + 1]));
            if (sc[2 * c] == m) { sc[2 * c] = NINF; tv[c * 16 + rd] = m; ti[c * 16 + rd] = (lane + 128 * c) & 127; }
            else if (sc[2 * c + 1] == m) { sc[2 * c + 1] = NINF; tv[c * 16 + rd] = m; ti[c * 16 + rd] = (lane + 64 + 128 * c) & 127; }
        }
    asm volatile("s_waitcnt lgkmcnt(0)" ::: "memory");
    float cd[4];
#pragma unroll
    for (int e = 0; e < 4; ++e) { const int p = lane * 4 + e; cd[e] = tv[p >> 4] + tv[16 + (p & 15)]; }
#pragma nounroll
    for (int rd = 0; rd < 16; ++rd) {
        const float m = wave_max(fmaxf(fmaxf(cd[0], cd[1]), fmaxf(cd[2], cd[3])));
        int pe = -1;
#pragma unroll
        for (int e = 3; e >= 0; --e) if (cd[e] == m) pe = e;
        if (pe >= 0) {
#pragma unroll
            for (int e = 0; e < 4; ++e) if (e == pe) cd[e] = NINF;
            const int p = lane * 4 + pe; bv[rd] = m; bi[rd] = ti[p >> 4] * 128 + ti[16 + (p & 15)];
        }
    }
    asm volatile("s_waitcnt lgkmcnt(0)" ::: "memory");
    if (lane < 16) {
        const float b = bv[lane], mx = bv[0]; const float e = __expf(b - mx); float ssum = rowsum16(e);
        const size_t o = ((size_t)tok * 8 + h) * 16 + lane; pidx[o] = bi[lane]; pgate[o] = e / ssum;
    }
    asm volatile("s_waitcnt lgkmcnt(0)" ::: "memory");
}

typedef float f32x2 __attribute__((ext_vector_type(2)));
DEV void cvt16(const u32x4 q, f32x2 (&f)[8]) {
    const int q0 = (int)q.x, q1 = (int)q.y, q2 = (int)q.z, q3 = (int)q.w;
    f[0] = __builtin_amdgcn_cvt_pk_f32_fp8(q0, false); f[1] = __builtin_amdgcn_cvt_pk_f32_fp8(q0, true);
    f[2] = __builtin_amdgcn_cvt_pk_f32_fp8(q1, false); f[3] = __builtin_amdgcn_cvt_pk_f32_fp8(q1, true);
    f[4] = __builtin_amdgcn_cvt_pk_f32_fp8(q2, false); f[5] = __builtin_amdgcn_cvt_pk_f32_fp8(q2, true);
    f[6] = __builtin_amdgcn_cvt_pk_f32_fp8(q3, false); f[7] = __builtin_amdgcn_cvt_pk_f32_fp8(q3, true);
}
DEV void peer_token(const KArgs& A, int tok, int lane) {
    unsigned char* ws = A.ws;
    float* x1 = A.out + (size_t)tok * 1024 + lane * 16;
    const unsigned char* PU = ws + WS_PU + lane * 16; const unsigned char* PV = ws + WS_PV + lane * 16;
    const int* pidx = (const int*)(ws + WS_S5); const float* pgate = (const float*)(ws + WS_S5 + (size_t)T * 512);
    const float rs = rsqrtf(((const float*)(ws + WS_SSQ2))[tok] * (1.f / 1024.f) + EPS);
    f32x2 xs[8];
    { float a[8], b[8], ga[8], gb[8]; ld8f(x1, a); ld8f(x1 + 8, b); ld8f(A.in[18] + lane * 16, ga); ld8f(A.in[18] + lane * 16 + 8, gb);
#pragma unroll
      for (int i = 0; i < 4; ++i) { xs[i] = (f32x2){a[2 * i] * rs * ga[2 * i], a[2 * i + 1] * rs * ga[2 * i + 1]}; xs[4 + i] = (f32x2){b[2 * i] * rs * gb[2 * i], b[2 * i + 1] * rs * gb[2 * i + 1]}; } }
    f32x2 o[8];
#pragma unroll
    for (int i = 0; i < 8; ++i) o[i] = (f32x2){0.f, 0.f};
    const int* pi = pidx + (size_t)tok * 128 + (lane >> 2); const float* pg = pgate + (size_t)tok * 128 + (lane >> 2);
    int eidx = pi[0];
    u32x4 uq[16];
#pragma unroll
    for (int k = 0; k < 16; ++k) { const int row = __builtin_amdgcn_readlane(eidx, 4 * k); uq[k] = *(const u32x4*)(PU + (size_t)row * 1024); }
#pragma nounroll
    for (int h = 0; h < 8; ++h) {
        const float gt = pg[h * 16];
        const int enext = pi[(h < 7 ? h + 1 : 7) * 16];
        u32x4 vq[16];
#pragma unroll
        for (int k = 0; k < 16; ++k) { const int row = __builtin_amdgcn_readlane(eidx, 4 * k); vq[k] = *(const u32x4*)(PV + (size_t)row * 1024); }
        float part[16];
#pragma unroll
        for (int k = 0; k < 16; ++k) { f32x2 f[8]; cvt16(uq[k], f); f32x2 acc = f[0] * xs[0];
#pragma unroll
            for (int i = 1; i < 8; ++i) acc += f[i] * xs[i];
            part[k] = acc.x + acc.y; }
        eidx = enext;
#pragma unroll
        for (int k = 0; k < 16; ++k) { const int row = __builtin_amdgcn_readlane(eidx, 4 * k); uq[k] = *(const u32x4*)(PU + (size_t)row * 1024); }
        float r8[8], r4[4], r2[2];
        const bool b5 = lane & 32, b4 = lane & 16, b3 = lane & 8, b2 = lane & 4;
#pragma unroll
        for (int i = 0; i < 8; ++i) { const float keep = b5 ? part[i + 8] : part[i], send = b5 ? part[i] : part[i + 8]; r8[i] = keep + __shfl_xor(send, 32); }
#pragma unroll
        for (int i = 0; i < 4; ++i) { const float keep = b4 ? r8[i + 4] : r8[i], send = b4 ? r8[i] : r8[i + 4]; r4[i] = keep + __shfl_xor(send, 16); }
#pragma unroll
        for (int i = 0; i < 2; ++i) { const float keep = b3 ? r4[i + 2] : r4[i], send = b3 ? r4[i] : r4[i + 2]; r2[i] = keep + __shfl_xor(send, 8); }
        float act = (b2 ? r2[1] : r2[0]) + __shfl_xor(b2 ? r2[0] : r2[1], 4);
        act += __shfl_xor(act, 2); act += __shfl_xor(act, 1);
        const float w = gt * gelu_t(act * (1.f / 256.f)) * (1.f / 64.f);
#pragma unroll
        for (int k = 0; k < 16; ++k) { const float wk = __builtin_bit_cast(float, __builtin_amdgcn_readlane(__builtin_bit_cast(int, w), 4 * k)); const f32x2 w2 = {wk, wk}; f32x2 f[8]; cvt16(vq[k], f);
#pragma unroll
            for (int i = 0; i < 8; ++i) o[i] += w2 * f[i]; }
    }
    float a[8], b[8]; ld8f(x1, a); ld8f(x1 + 8, b);
    float ss = 0.f;
#pragma unroll
    for (int i = 0; i < 4; ++i) { a[2 * i] += o[i].x; a[2 * i + 1] += o[i].y; b[2 * i] += o[4 + i].x; b[2 * i + 1] += o[4 + i].y; }
#pragma unroll
    for (int i = 0; i < 8; ++i) ss += a[i] * a[i] + b[i] * b[i];
    st8f(x1, a); st8f(x1 + 8, b);
    bf16_t* x2b = (bf16_t*)(ws + WS_S2) + (size_t)tok * 1024 + lane * 16;
    st8bf(x2b, a); st8bf(x2b + 8, b);
    ss = wave_sum(ss);
    if (lane == 0) ((float*)(ws + WS_RSTD3))[tok] = rsqrtf(ss * (1.f / 1024.f) + EPS);
}

DEV void cvt32(const u32x4 q, f32x2 (&f)[16]) {
    const unsigned q0 = q.x, q1 = q.y, q2 = q.z, q3 = q.w;
    f[0] = __builtin_amdgcn_cvt_scalef32_pk_f32_fp4(q0, 1.0f, 0); f[1] = __builtin_amdgcn_cvt_scalef32_pk_f32_fp4(q0, 1.0f, 1); f[2] = __builtin_amdgcn_cvt_scalef32_pk_f32_fp4(q0, 1.0f, 2); f[3] = __builtin_amdgcn_cvt_scalef32_pk_f32_fp4(q0, 1.0f, 3);
    f[4] = __builtin_amdgcn_cvt_scalef32_pk_f32_fp4(q1, 1.0f, 0); f[5] = __builtin_amdgcn_cvt_scalef32_pk_f32_fp4(q1, 1.0f, 1); f[6] = __builtin_amdgcn_cvt_scalef32_pk_f32_fp4(q1, 1.0f, 2); f[7] = __builtin_amdgcn_cvt_scalef32_pk_f32_fp4(q1, 1.0f, 3);
    f[8] = __builtin_amdgcn_cvt_scalef32_pk_f32_fp4(q2, 1.0f, 0); f[9] = __builtin_amdgcn_cvt_scalef32_pk_f32_fp4(q2, 1.0f, 1); f[10] = __builtin_amdgcn_cvt_scalef32_pk_f32_fp4(q2, 1.0f, 2); f[11] = __builtin_amdgcn_cvt_scalef32_pk_f32_fp4(q2, 1.0f, 3);
    f[12] = __builtin_amdgcn_cvt_scalef32_pk_f32_fp4(q3, 1.0f, 0); f[13] = __builtin_amdgcn_cvt_scalef32_pk_f32_fp4(q3, 1.0f, 1); f[14] = __builtin_amdgcn_cvt_scalef32_pk_f32_fp4(q3, 1.0f, 2); f[15] = __builtin_amdgcn_cvt_scalef32_pk_f32_fp4(q3, 1.0f, 3);
}
DEV void peer_token4(const KArgs& A, int tok, int lane) {
    unsigned char* ws = A.ws;
    const int half = lane >> 5, sub = lane & 31;
    const bf16_t* x1 = (const bf16_t*)(ws + WS_S3) + (size_t)tok * 1024 + sub * 32;
    const unsigned char* PU = ws + WS_PU + sub * 16; const unsigned char* PV = ws + WS_PV + sub * 16;
    const int e_l = (half << 3) | ((lane >> 2) & 7);
    const int* pi = (const int*)(ws + WS_S5) + (size_t)tok * 128 + e_l; const float* pg = (const float*)(ws + WS_S5 + (size_t)T * 512) + (size_t)tok * 128 + e_l;
    const float rs = rsqrtf(((const float*)(ws + WS_SSQ2))[tok] * (1.f / 1024.f) + EPS);
    f32x2 xs[16];
#pragma unroll
    for (int j = 0; j < 4; ++j) { float a[8], g[8]; ld8bf(x1 + 8 * j, a); ld8f(A.in[18] + sub * 32 + 8 * j, g);
#pragma unroll
        for (int i = 0; i < 4; ++i) xs[4 * j + i] = (f32x2){a[2 * i] * rs * g[2 * i], a[2 * i + 1] * rs * g[2 * i + 1]}; }
    f32x2 o[16];
#pragma unroll
    for (int i = 0; i < 16; ++i) o[i] = (f32x2){0.f, 0.f};
    const bool b4 = lane & 16, b3 = lane & 8, b2 = lane & 4;
#pragma nounroll
    for (int h = 0; h < 8; ++h) {
        const int eidx = pi[h * 16]; const float gt = pg[h * 16];
        float part[8];
        {
            u32x4 uq[8];
#pragma unroll
            for (int k = 0; k < 8; ++k) { const int r0 = __builtin_amdgcn_readlane(eidx, 4 * k), r1 = __builtin_amdgcn_readlane(eidx, 32 + 4 * k); uq[k] = *(const u32x4*)(PU + (size_t)(half ? r1 : r0) * 512); }
#pragma unroll
            for (int k = 0; k < 8; ++k) { f32x2 f[16]; cvt32(uq[k], f); f32x2 acc = f[0] * xs[0];
#pragma unroll
                for (int i = 1; i < 16; ++i) acc += f[i] * xs[i];
                part[k] = acc.x + acc.y; }
        }
        float r4[4], r2[2];
#pragma unroll
        for (int i = 0; i < 4; ++i) { const float keep = b4 ? part[i + 4] : part[i], send = b4 ? part[i] : part[i + 4]; r4[i] = keep + __shfl_xor(send, 16); }
#pragma unroll
        for (int i = 0; i < 2; ++i) { const float keep = b3 ? r4[i + 2] : r4[i], send = b3 ? r4[i] : r4[i + 2]; r2[i] = keep + __shfl_xor(send, 8); }
        float act = (b2 ? r2[1] : r2[0]) + __shfl_xor(b2 ? r2[0] : r2[1], 4);
        act += __shfl_xor(act, 2); act += __shfl_xor(act, 1);
        const float w = gt * gelu_t(act * (1.f / PEER_SU)) * (1.f / PEER_SV);
        {
            u32x4 vq[8];
#pragma unroll
            for (int k = 0; k < 8; ++k) { const int r0 = __builtin_amdgcn_readlane(eidx, 4 * k), r1 = __builtin_amdgcn_readlane(eidx, 32 + 4 * k); vq[k] = *(const u32x4*)(PV + (size_t)(half ? r1 : r0) * 512); }
#pragma unroll
            for (int k = 0; k < 8; ++k) {
                const float w0 = __builtin_bit_cast(float, __builtin_amdgcn_readlane(__builtin_bit_cast(int, w), 4 * k)), w1 = __builtin_bit_cast(float, __builtin_amdgcn_readlane(__builtin_bit_cast(int, w), 32 + 4 * k));
                const float wk = half ? w1 : w0; const f32x2 w2 = {wk, wk}; f32x2 f[16]; cvt32(vq[k], f);
#pragma unroll
                for (int i = 0; i < 16; ++i) o[i] += w2 * f[i]; }
        }
    }
    float a[8], b[8];
#pragma unroll
    for (int i = 0; i < 8; ++i) {
        const float lo0 = o[i].x + __shfl_xor(o[i].x, 32), lo1 = o[i].y + __shfl_xor(o[i].y, 32), hi0 = o[8 + i].x + __shfl_xor(o[8 + i].x, 32), hi1 = o[8 + i].y + __shfl_xor(o[8 + i].y, 32);
        const float e0 = half ? hi0 : lo0, e1 = half ? hi1 : lo1;
        if (i < 4) { a[2 * i] = e0; a[2 * i + 1] = e1; } else { b[2 * (i - 4)] = e0; b[2 * (i - 4) + 1] = e1; }
    }
    float xa[8], xb[8]; ld8bf(x1 + half * 16, xa); ld8bf(x1 + half * 16 + 8, xb);
    float ss = 0.f;
#pragma unroll
    for (int i = 0; i < 8; ++i) { a[i] += xa[i]; b[i] += xb[i]; ss += a[i] * a[i] + b[i] * b[i]; }
    bf16_t* x2b = (bf16_t*)(ws + WS_S2) + (size_t)tok * 1024 + sub * 32 + half * 16;
    st8bf(x2b, a); st8bf(x2b + 8, b);
    ss = wave_sum(ss);
    if (lane == 0) ((float*)(ws + WS_RSTD3))[tok] = rsqrtf(ss * (1.f / 1024.f) + EPS);
}

typedef int v8i_t __attribute__((ext_vector_type(8)));
DEV unsigned pk4_e4m3(float a, float b, float c, float d) { int p = __builtin_amdgcn_cvt_pk_fp8_f32(a, b, 0, false); p = __builtin_amdgcn_cvt_pk_fp8_f32(c, d, p, true); return (unsigned)p; }
DEV void peer_token5(const KArgs& A, int tok, int lane, LAS unsigned char* xq  , const int h0, const int h1, LAS float* xsend, const LAS float* xrecv, const bool do_bar) {
    unsigned char* ws = A.ws;
    const int fr = lane & 15, quad = lane >> 4, half = lane >> 5, sub = lane & 31;
    const bf16_t* x1 = (const bf16_t*)(ws + WS_S3) + (size_t)tok * 1024;
    const unsigned char* PU = ws + WS_PU + quad * 16; const unsigned char* PV = ws + WS_PV + sub * 16;
    const int* pi = (const int*)(ws + WS_S5) + (size_t)tok * 128 + fr; const float* pg = (const float*)(ws + WS_S5 + (size_t)T * 512) + (size_t)tok * 128 + quad * 4;
    const float rs = rsqrtf(((const float*)(ws + WS_SSQ2))[tok] * (1.f / 1024.f) + EPS);
    {
        float a[8], b[8], ga[8], gb[8]; ld8bf(x1 + lane * 16, a); ld8bf(x1 + lane * 16 + 8, b); ld8f(A.in[18] + lane * 16, ga); ld8f(A.in[18] + lane * 16 + 8, gb);
#pragma unroll
        for (int i = 0; i < 8; ++i) { a[i] *= rs * ga[i]; b[i] *= rs * gb[i]; }
        const unsigned h0 = pk8_fp4(a, 1.f), h1 = pk8_fp4(b, 1.f);
        float ra[8], rb[8];
#define XRES(i) { const f32x2 d0 = __builtin_amdgcn_cvt_scalef32_pk_f32_fp4(h0, 1.0f, i), d1 = __builtin_amdgcn_cvt_scalef32_pk_f32_fp4(h1, 1.0f, i); \
            ra[2 * i] = a[2 * i] - d0.x; ra[2 * i + 1] = a[2 * i + 1] - d0.y; rb[2 * i] = b[2 * i] - d1.x; rb[2 * i + 1] = b[2 * i + 1] - d1.y; }
        XRES(0) XRES(1) XRES(2) XRES(3)
#undef XRES
        const unsigned l0 = pk8_fp4(ra, 8.f), l1 = pk8_fp4(rb, 8.f);
        *(LAS u32x2*)(xq + lane * 8) = (u32x2){h0, h1};
        *(LAS u32x2*)(xq + 512 + lane * 8) = (u32x2){l0, l1};
    }
    asm volatile("s_waitcnt lgkmcnt(0)" ::: "memory");
    u32x4 xh[8], xl[8];
#pragma unroll
    for (int ks = 0; ks < 8; ++ks) { xh[ks] = *(const LAS u32x4*)(xq + ks * 64 + quad * 16); xl[ks] = *(const LAS u32x4*)(xq + 512 + ks * 64 + quad * 16); }
    f32x2 o[16];
#pragma unroll
    for (int i = 0; i < 16; ++i) o[i] = (f32x2){0.f, 0.f};
    int idx_l = pi[h0 * 16]; f32x4 gt4 = *(const f32x4*)(pg + h0 * 16);
    u32x4 ua[8];
#pragma unroll
    for (int ks = 0; ks < 8; ++ks) ua[ks] = *(const u32x4*)(PU + (size_t)idx_l * 512 + ks * 64);
#pragma nounroll
    for (int h = h0; h < h1; ++h) {
        const int hn = h < h1 - 1 ? h + 1 : h1 - 1;
        const int idx_n = pi[hn * 16]; const f32x4 gt_n = *(const f32x4*)(pg + hn * 16);
        u32x4 vq[8];
#pragma unroll
        for (int k = 0; k < 8; ++k) { const int r0 = __builtin_amdgcn_readlane(idx_l, k), r1 = __builtin_amdgcn_readlane(idx_l, k + 8); vq[k] = *(const u32x4*)(PV + (size_t)(half ? r1 : r0) * 512); }
        f32x4 c = {0.f, 0.f, 0.f, 0.f};
#pragma unroll
        for (int ks = 0; ks < 8; ++ks) { const u32x4 u = ua[ks], bh = xh[ks], bl = xl[ks];
            const v8i_t av = {(int)u.x, (int)u.y, (int)u.z, (int)u.w, 0, 0, 0, 0}, bhv = {(int)bh.x, (int)bh.y, (int)bh.z, (int)bh.w, 0, 0, 0, 0}, blv = {(int)bl.x, (int)bl.y, (int)bl.z, (int)bl.w, 0, 0, 0, 0};
            c = __builtin_amdgcn_mfma_scale_f32_16x16x128_f8f6f4(av, bhv, c, 4, 4, 0, 0x7F7F7F7F, 0, 0x7F7F7F7F);
            c = __builtin_amdgcn_mfma_scale_f32_16x16x128_f8f6f4(av, blv, c, 4, 4, 0, 0x7F7F7F7F, 0, 0x7C7C7C7C); }
#pragma unroll
        for (int ks = 0; ks < 8; ++ks) ua[ks] = *(const u32x4*)(PU + (size_t)idx_n * 512 + ks * 64);
        float w[4];
        { const float c0 = c[0], c1 = c[1], c2 = c[2], c3 = c[3], g0 = gt4[0], g1 = gt4[1], g2 = gt4[2], g3 = gt4[3];
          w[0] = g0 * gelu_t(c0 * (1.f / PEER_SU)) * (1.f / PEER_SV); w[1] = g1 * gelu_t(c1 * (1.f / PEER_SU)) * (1.f / PEER_SV);
          w[2] = g2 * gelu_t(c2 * (1.f / PEER_SU)) * (1.f / PEER_SV); w[3] = g3 * gelu_t(c3 * (1.f / PEER_SU)) * (1.f / PEER_SV); }
#pragma unroll
        for (int k = 0; k < 8; ++k) {
            const float w0 = __builtin_bit_cast(float, __builtin_amdgcn_readlane(__builtin_bit_cast(int, w[k & 3]), 16 * (k >> 2))), w1 = __builtin_bit_cast(float, __builtin_amdgcn_readlane(__builtin_bit_cast(int, w[k & 3]), 16 * ((k + 8) >> 2)));
            const float wk = half ? w1 : w0; const f32x2 w2 = {wk, wk}; f32x2 f[16]; cvt32(vq[k], f);
#pragma unroll
            for (int i = 0; i < 16; ++i) o[i] += w2 * f[i]; }
        idx_l = idx_n; gt4 = gt_n;
    }
    float a[8], b[8];
#pragma unroll
    for (int i = 0; i < 8; ++i) {
        const float lo0 = o[i].x + __shfl_xor(o[i].x, 32), lo1 = o[i].y + __shfl_xor(o[i].y, 32), hi0 = o[8 + i].x + __shfl_xor(o[8 + i].x, 32), hi1 = o[8 + i].y + __shfl_xor(o[8 + i].y, 32);
        const float e0 = half ? hi0 : lo0, e1 = half ? hi1 : lo1;
        if (i < 4) { a[2 * i] = e0; a[2 * i + 1] = e1; } else { b[2 * (i - 4)] = e0; b[2 * (i - 4) + 1] = e1; }
    }
    if (xsend) { *(LAS f32x4*)(xsend + lane * 16) = (f32x4){a[0], a[1], a[2], a[3]}; *(LAS f32x4*)(xsend + lane * 16 + 4) = (f32x4){a[4], a[5], a[6], a[7]};
                 *(LAS f32x4*)(xsend + lane * 16 + 8) = (f32x4){b[0], b[1], b[2], b[3]}; *(LAS f32x4*)(xsend + lane * 16 + 12) = (f32x4){b[4], b[5], b[6], b[7]}; }
    if (do_bar) { asm volatile("s_waitcnt lgkmcnt(0)" ::: "memory"); __builtin_amdgcn_s_barrier(); asm volatile("" ::: "memory"); }
    if (xsend) return;
    if (xrecv) { const f32x4 r0 = *(const LAS f32x4*)(xrecv + lane * 16), r1 = *(const LAS f32x4*)(xrecv + lane * 16 + 4), r2 = *(const LAS f32x4*)(xrecv + lane * 16 + 8), r3 = *(const LAS f32x4*)(xrecv + lane * 16 + 12);
        a[0] += r0.x; a[1] += r0.y; a[2] += r0.z; a[3] += r0.w; a[4] += r1.x; a[5] += r1.y; a[6] += r1.z; a[7] += r1.w;
        b[0] += r2.x; b[1] += r2.y; b[2] += r2.z; b[3] += r2.w; b[4] += r3.x; b[5] += r3.y; b[6] += r3.z; b[7] += r3.w; }
    float xa[8], xb[8]; ld8bf(x1 + sub * 32 + half * 16, xa); ld8bf(x1 + sub * 32 + half * 16 + 8, xb);
    float ss = 0.f;
#pragma unroll
    for (int i = 0; i < 8; ++i) { a[i] += xa[i]; b[i] += xb[i]; ss += a[i] * a[i] + b[i] * b[i]; }
    bf16_t* x2b = (bf16_t*)(ws + WS_S2) + (size_t)tok * 1024 + sub * 32 + half * 16;
    st8bf(x2b, a); st8bf(x2b + 8, b);
    ss = wave_sum(ss);
    if (lane == 0) ((float*)(ws + WS_RSTD3))[tok] = rsqrtf(ss * (1.f / 1024.f) + EPS);
}

DEV int lane_id_asm() { int l; asm volatile("v_mbcnt_lo_u32_b32 %0, -1, 0\n\tv_mbcnt_hi_u32_b32 %0, -1, %0" : "=v"(l)); return l; }
DEV void grid_bar(unsigned* ctr, unsigned target, bool leader) {
    asm volatile("s_waitcnt vmcnt(0) lgkmcnt(0)" ::: "memory");
    __builtin_amdgcn_s_barrier();
    if (leader) {
        __builtin_amdgcn_fence(__ATOMIC_RELEASE, "agent");
        asm volatile("s_waitcnt vmcnt(0)" ::: "memory");
        (void)__hip_atomic_fetch_add(ctr, 1u, __ATOMIC_RELAXED, __HIP_MEMORY_SCOPE_AGENT);
        while (__hip_atomic_load(ctr, __ATOMIC_RELAXED, __HIP_MEMORY_SCOPE_AGENT) < target) __builtin_amdgcn_s_sleep(2);
        __builtin_amdgcn_fence(__ATOMIC_ACQUIRE, "agent");
        asm volatile("s_waitcnt vmcnt(0)" ::: "memory");
    }
    __builtin_amdgcn_s_barrier();
}
#define XB_TMO      128
#define XB_XCNT(j)  (256  + 64 * (j))
#define XB_XSUB(j)  (1280 + 64 * (j))
#define XB_XGEN(j)  (2304 + 64 * (j))
#define XB_TOP      3328
#define XB_TOPGEN   3392
#define XCD_BAR_WORDS 3456
#define XB_SPIN_CAP (1u << 20)
DEV unsigned xb_ld(unsigned* p)              { return __hip_atomic_load(p, __ATOMIC_RELAXED, __HIP_MEMORY_SCOPE_AGENT); }
DEV unsigned xb_add(unsigned* p, unsigned v) { return __hip_atomic_fetch_add(p, v, __ATOMIC_RELAXED, __HIP_MEMORY_SCOPE_AGENT); }
DEV unsigned xb_xcc_id() { return (unsigned)__builtin_amdgcn_s_getreg((3 << 11) | 20) & 0xFu; }
#define XB_SPIN(cond, bar) do { unsigned _sp = 0; while (cond) { __builtin_amdgcn_s_sleep(1); \
    if ((++_sp & 255u) == 0u) { if (xb_ld(&(bar)[XB_TMO])) break; if (_sp > XB_SPIN_CAP) { (void)xb_add(&(bar)[XB_TMO], 1u); break; } } } } while (0)
DEV void xcd_bar(unsigned* bar, volatile LAS unsigned* st, bool leader, unsigned G) {
    asm volatile("s_waitcnt vmcnt(0) lgkmcnt(0)" ::: "memory");
    __builtin_amdgcn_s_barrier();
    if (leader) {
        const unsigned x = xb_xcc_id();
        unsigned nloc = st[0], nx = st[1];
        if (nloc == 0u) {
            unsigned sum = 0u, cnt = 0u, mine = 0u, sp = 0u;
            for (;;) { sum = 0u; cnt = 0u; mine = 0u;
#pragma unroll
                for (unsigned j = 0; j < 16; ++j) { const unsigned c = xb_ld(&bar[XB_XCNT(j)]); sum += c; cnt += (c > 0u) ? 1u : 0u; mine = (j == x) ? c : mine; }
                if (sum == G) break;
                __builtin_amdgcn_s_sleep(1);
                if ((++sp & 255u) == 0u) { if (xb_ld(&bar[XB_TMO])) break; if (sp > XB_SPIN_CAP) { (void)xb_add(&bar[XB_TMO], 1u); break; } } }
            nloc = mine > 0u ? mine : 1u; nx = cnt > 0u ? cnt : 1u; st[0] = nloc; st[1] = nx;
        }
        const unsigned old = xb_add(&bar[XB_XSUB(x)], 1u), gen = old / nloc;
        if (old + 1u == (gen + 1u) * nloc) {
            __builtin_amdgcn_fence(__ATOMIC_RELEASE, "agent");
            asm volatile("s_waitcnt vmcnt(0)" ::: "memory");
            const unsigned og = xb_add(&bar[XB_TOP], 1u), tg = og / nx;
            if (og + 1u == (tg + 1u) * nx) (void)xb_add(&bar[XB_TOPGEN], 1u);
            else XB_SPIN(xb_ld(&bar[XB_TOPGEN]) == tg, bar);
            __builtin_amdgcn_fence(__ATOMIC_ACQUIRE, "agent");
            (void)xb_add(&bar[XB_XGEN(x)], 1u);
            asm volatile("s_waitcnt vmcnt(0)" ::: "memory");
        } else {
            XB_SPIN(xb_ld(&bar[XB_XGEN(x)]) == gen, bar);
            __builtin_amdgcn_fence(__ATOMIC_ACQUIRE, "agent");
            asm volatile("s_waitcnt vmcnt(0)" ::: "memory");
        }
    }
    __builtin_amdgcn_s_barrier();
    asm volatile("" ::: "memory");
}
typedef const KArgs __attribute__((address_space(4))) CKArgs;
DEV KArgs fresh_args() {
#if defined(__HIP_DEVICE_COMPILE__)
    CKArgs* p = (CKArgs*)__builtin_amdgcn_kernarg_segment_ptr(); asm volatile("" : "+s"(p)); KArgs r;
#pragma unroll
    for (int i = 0; i < 26; ++i) r.in[i] = p->in[i];
    r.out = p->out; r.ws = p->ws; return r;
#else
    return KArgs{};
#endif
}
__global__ void __launch_bounds__(512, 2) mega(KArgs Akern) {
    extern __shared__ __attribute__((aligned(16))) unsigned char lds_raw[];
    LAS unsigned char* lds = (LAS unsigned char*)lds_raw;
    cg::grid_group grid = cg::this_grid();
    (void)Akern;
    const int G = gridDim.x;
    const int wave_s = __builtin_amdgcn_readfirstlane((int)threadIdx.x >> 6);
    unsigned* bar_ctr;
    volatile LAS unsigned* bar_st = (volatile LAS unsigned*)(lds + LDS_BYTES - 64);
    { const KArgs A0 = fresh_args(); bar_ctr = (unsigned*)(A0.ws + WS_BAR);
      if (blockIdx.x == 0) for (int i = threadIdx.x; i < XCD_BAR_WORDS; i += 512) __hip_atomic_store(bar_ctr + i, 0u, __ATOMIC_RELAXED, __HIP_MEMORY_SCOPE_AGENT);
      if (threadIdx.x == 0) { bar_st[0] = 0u; bar_st[1] = 0u; } }
    grid.sync();
    if (threadIdx.x == 0) (void)xb_add(&bar_ctr[XB_XCNT(xb_xcc_id())], 1u);
#define GRID_SYNC() xcd_bar(bar_ctr, bar_st, wave_s == 0 && lane_id_asm() == 0, (unsigned)G)
#define FRESH_IDS const int lane = lane_id_asm(), wave = wave_s, tid_ = wave * 64 + lane, \
        gw = blockIdx.x * 8 + wave, NGW = G * 8, gtid = blockIdx.x * 512 + tid_, NT = G * 512; const KArgs A = fresh_args(); (void)lane; (void)wave; (void)gw; (void)NGW; (void)gtid; (void)NT
#ifndef GEMM_STAGGER_N
#define GEMM_STAGGER_N 0
#endif
#define GEMM_STAGGER() do { if (GEMM_STAGGER_N > 0 && (blockIdx.x & 1)) { for (int s_ = 0; s_ < GEMM_STAGGER_N; ++s_) __builtin_amdgcn_s_sleep(127); } } while (0)
#ifndef GEMM_ALIGN_EPI
#define GEMM_ALIGN_EPI true
#endif
#define RUN_GEMM(MODE, APTR, BPTR, NN, KK) RUN_GEMM_ON(MODE, APTR, BPTR, NN, KK, G, (int)blockIdx.x)
#define RUN_GEMM_ON(MODE, APTR, BPTR, NN, KK, SG, SC) do { const KArgs A = fresh_args(); unsigned char* ws = A.ws; pg8::Gemm g; g.A = (const bf16_t*)(APTR); g.Bt = (const bf16_t*)(BPTR); g.M = T; g.N = NN; { int kk_ = KK; asm volatile("" : "+s"(kk_)); g.K = kk_; } \
        Epi<MODE> E; E.xp = A.in[0]; E.xs = A.in[1]; E.out = A.out; E.ws = ws; pg8::StaticOrder S; S.init(T, NN, SG, SC); \
        GEMM_STAGGER(); pg8::gemm_phase<Epi<MODE>, pg8::StaticOrder, GEMM_ALIGN_EPI, true>(lds, g, S, E, wave_s); } while (0)
#ifndef SKIP_P0
#ifndef REP_P0
#define REP_P0 1
#endif
#pragma nounroll
    for (int rep = 0; rep < REP_P0; ++rep) { FRESH_IDS; p0_phase(A, lds, lane, wave, gw, NGW, gtid, NT, 0); }
#endif
#ifdef XBAR
    for (int xb = 0; xb < XBAR; ++xb) GRID_SYNC();
#endif
    GRID_SYNC();
#ifndef SKIP_G1
    RUN_GEMM(1, A.out, ws + WS_WIN, 3840, 1024);
#endif
    if (G > 188 && (int)blockIdx.x >= 188) { FRESH_IDS; p0_phase(A, lds, lane, wave, gw - 188 * 8, NGW - 188 * 8, gtid - 188 * 512, NT - 188 * 512, 1); }
    else if (G <= 188) { FRESH_IDS; p0_phase(A, lds, lane, wave, gw, NGW, gtid, NT, 1); }
    GRID_SYNC();
#ifndef SKIP_P2
#ifndef REP_P2
#define REP_P2 1
#endif
#pragma nounroll
    for (int rep = 0; rep < REP_P2; ++rep) { FRESH_IDS; p2_phase(A, gtid, NT); }
#endif
    GRID_SYNC();
#ifndef REP_P3
#define REP_P3 1
#endif
#pragma nounroll
    for (int rep = 0; rep < REP_P3; ++rep) {
        FRESH_IDS;
        LAS bf16_t* P = (LAS bf16_t*)(lds + wave * 5440);
#ifndef SKIP_ATT
        const int vb = ((G & 7) == 0) ? ((int)blockIdx.x & 7) * (G >> 3) + ((int)blockIdx.x >> 3) : (int)blockIdx.x, gwv = vb * 8 + wave;
        for (int t = gwv; t < 16384; t += NGW) attn_task<false>(A, t, P, lane);
        for (int t = gwv; t < 512; t += NGW) attn_task<true>(A, t, P, lane);
#endif
#ifndef SKIP_SGU
        for (int t = gwv; t < 8192; t += NGW) sgu_task(A, t, lane);
        sgu_small(A, gtid, NT);
#endif
    }
    GRID_SYNC();
#ifndef REP_G4
#define REP_G4 1
#endif
#pragma nounroll
    for (int rep4 = 0; rep4 < REP_G4; ++rep4) {
#ifndef SKIP_G2
    RUN_GEMM(2, ws + WS_S2, ws + WS_WA, 1024, 512);
#endif
#ifndef SKIP_G3
    RUN_GEMM(3, ws + WS_S2 + (size_t)T * 1024, ws + WS_WB, 1024, 512);
#endif
    }
    if (G > 16 && (int)blockIdx.x >= 16) { FRESH_IDS; cvt_fp4(A.in[21], A.ws + WS_PU, 2097152, PEER_SU, gtid - 16 * 512, NT - 16 * 512); p0_phase(A, lds, lane, wave, gw - 16 * 8, NGW - 16 * 8, gtid - 16 * 512, NT - 16 * 512, 2); }
    else if (G <= 16) { FRESH_IDS; cvt_fp4(A.in[21], A.ws + WS_PU, 2097152, PEER_SU, gtid, NT); p0_phase(A, lds, lane, wave, gw, NGW, gtid, NT, 2); }
    GRID_SYNC();
#ifndef SKIP_G4
    RUN_GEMM(4, ws + WS_S4, ws + WS_WOUT, 1024, 1024);
#endif
    if (G > 16 && (int)blockIdx.x >= 16) { FRESH_IDS; cvt_fp4(A.in[22], A.ws + WS_PV, 2097152, PEER_SV, gtid - 16 * 512, NT - 16 * 512); p0_phase(A, lds, lane, wave, gw - 16 * 8, NGW - 16 * 8, gtid - 16 * 512, NT - 16 * 512, 3); }
    else if (G <= 16) { FRESH_IDS; cvt_fp4(A.in[22], A.ws + WS_PV, 2097152, PEER_SV, gtid, NT); p0_phase(A, lds, lane, wave, gw, NGW, gtid, NT, 3); }
    GRID_SYNC();
#ifndef SKIP_G5
#ifndef REP_G6
#define REP_G6 1
#endif
#pragma nounroll
    for (int rep = 0; rep < REP_G6; ++rep) {
    RUN_GEMM(5, ws + WS_S3, ws + WS_WQ, 2048, 1024);
    }
    if (G > 64 && (int)blockIdx.x >= 32) { RUN_GEMM_ON(6, ws + WS_PB, ws + WS_WPLE, 1024, 256, G - 32, (int)blockIdx.x - 32); }
    else if (G <= 64) { RUN_GEMM(6, ws + WS_PB, ws + WS_WPLE, 1024, 256); }
#endif
    GRID_SYNC();
#ifndef SKIP_TOPK
#ifndef REP_P7
#define REP_P7 1
#endif
#pragma nounroll
    for (int rep = 0; rep < REP_P7; ++rep) { FRESH_IDS; LAS float* L = (LAS float*)(lds + wave * 16384);
#ifdef TOPK_REF
      for (int t = gw; t < T * 8; t += NGW) topk_ref_task(A, t, L, lane);
#else
#ifdef TOPK_V1
      for (int t = gw; t < (T / 16) * 8; t += NGW) topk_task(A, t, L, lane);
#else
      if ((G & 7) == 0) topk3_phase(A, lds, lane, wave, G);
      else for (int t = gw; t < (T / 16) * 8; t += NGW) topk2_task(A, t, L, lane);
#endif
#endif
    }
#endif
    GRID_SYNC();
#ifndef SKIP_PEER
#ifndef REP_P8
#define REP_P8 1
#endif
#pragma nounroll
    for (int rep = 0; rep < REP_P8; ++rep) { FRESH_IDS;
#ifdef PEER_V4
      for (int t = gw; t < T; t += NGW) peer_token4(A, t, lane);
#else
      if (NGW == 2048) {
          for (int k = 0; k < 16; ++k) peer_token5(A, gw + k * 2048, lane, lds + wave * 1024, 0, 8, nullptr, nullptr, false);
          const int tl = 32768 + (int)blockIdx.x * 4 + (wave & 3); LAS float* xch = (LAS float*)(lds + 8192 + (wave & 3) * 4096);
          if (wave < 4) peer_token5(A, tl, lane, lds + wave * 1024, 0, 4, nullptr, xch, true);
          else          peer_token5(A, tl, lane, lds + wave * 1024, 4, 8, xch, nullptr, true);
      } else
      for (int t = gw; t < T; t += NGW) peer_token5(A, t, lane, lds + wave * 1024, 0, 8, nullptr, nullptr, false);
#endif
    }
#endif
    GRID_SYNC();
#ifndef REP_G9
#define REP_G9 1
#endif
#pragma nounroll
    for (int rep9 = 0; rep9 < REP_G9; ++rep9) {
#ifndef SKIP_G7
    RUN_GEMM(7, ws + WS_S2, ws + WS_WG, 1024, 1024);
#endif
    }
}

extern "C" void kernel_launch(void* const* d_in, const int* in_sizes, int n_in, void* d_out, int out_size, void* d_ws, size_t ws_size, hipStream_t stream) {
    static int grid = 0;
    if (grid == 0) {
        if (n_in != 26 || (size_t)out_size != O_END || ws_size < WS_END) { fprintf(stderr, "kernel_launch: unexpected shapes: n_in %d out %d ws %zu (need %zu)\n", n_in, out_size, ws_size, (size_t)WS_END); grid = -1; return; }
        int dev = 0, cus = 0, per_cu = 0;
        if (hipGetDevice(&dev) != hipSuccess || hipDeviceGetAttribute(&cus, hipDeviceAttributeMultiprocessorCount, dev) != hipSuccess) { grid = -1; return; }
        if (hipFuncSetAttribute((const void*)mega, hipFuncAttributeMaxDynamicSharedMemorySize, LDS_BYTES) != hipSuccess) { fprintf(stderr, "kernel_launch: hipFuncSetAttribute failed\n"); grid = -1; return; }
        if (hipOccupancyMaxActiveBlocksPerMultiprocessor(&per_cu, (const void*)mega, 512, LDS_BYTES) != hipSuccess || per_cu < 1) { fprintf(stderr, "kernel_launch: occupancy query says %d blocks/CU\n", per_cu); grid = -1; return; }
        grid = cus;
    }
    if (grid < 0) return;
    KArgs a{};
    for (int i = 0; i < 26; ++i) a.in[i] = (const float*)d_in[i];
    a.out = (float*)d_out; a.ws = (unsigned char*)d_ws;
    void* args[] = {&a};
    const hipError_t e = hipLaunchCooperativeKernel((const void*)mega, dim3(grid), dim3(512), args, LDS_BYTES, stream);
    if (e != hipSuccess) fprintf(stderr, "kernel_launch: cooperative launch failed: %s (grid %d)\n", hipGetErrorString(e), grid);
}
```

```cpp
#include <hip/hip_runtime.h>
#include <hip/hip_cooperative_groups.h>
#include <cstdio>
#include <cstdint>
namespace cg = cooperative_groups;
namespace pg8 {
#define PG8_LAS __attribute__((address_space(3)))
typedef unsigned short bf16_t;
typedef short bf16x8 __attribute__((ext_vector_type(8)));
typedef float f32x4 __attribute__((ext_vector_type(4)));
typedef unsigned u32x4 __attribute__((ext_vector_type(4)));
constexpr int BM = 256, BK = 64, HALF = 128, HTB = HALF * BK * 2  , STAGE_BYTES = 8 * HTB, NXCD = 8, WGM = 8;

__host__ __device__ __forceinline__ int lds_byte(int r, int c) { const int st = (r >> 4) * 2 + (c >> 5), rr = r & 15, cc = c & 31, ob = rr * 64 + cc * 2; return st * 1024 + (ob ^ (((ob >> 9) & 1) << 5)); }
__host__ __device__ __forceinline__ void stage_rc(int b, int& R, int& C) { const int st = b / 1024, sb = b % 1024, swz = sb ^ (((sb >> 9) & 1) << 5); R = (st >> 1) * 16 + swz / 64; C = (st & 1) * 32 + (swz % 64) / 2; }
__host__ __device__ __forceinline__ int perm32(int rho) { const int n = rho >> 4, i = rho & 15; return 8 * (i >> 2) + 4 * n + (i & 3); }

struct Unit { int pm, pn; };
struct Gemm { const bf16_t* A; const bf16_t* Bt; int M, N, K; };

struct StaticOrder {
    int nM, nN, nwg, G, c;
    __host__ __device__ void init(int M, int N, int G_, int c_) { nM = M / BM; nN = N / BM; nwg = nM * nN; G = G_; c = c_; }
    __host__ __device__ bool next(int i, Unit& u) const {
        const long L = (long)i * G + c; if (L >= nwg) return false;
        int wgid = (int)L; { const int q = nwg / NXCD, r = nwg % NXCD, xcd = wgid % NXCD, off = wgid / NXCD; wgid = (xcd < r ? xcd * (q + 1) : r * (q + 1) + (xcd - r) * q) + off; }
        const int nig = WGM * nN, gid = wgid / nig, fm = gid * WGM, gsz = (nM - fm) < WGM ? (nM - fm) : WGM;
        u.pm = fm + ((wgid % nig) % gsz); u.pn = (wgid % nig) / gsz; return true;
    }
    __device__ __forceinline__ void a_ready(const Unit&) const {}
    __device__ __forceinline__ void done(const Unit&) const {}
};

__device__ __forceinline__ unsigned cvt_pk_bf16(float lo, float hi) { unsigned r; asm volatile("v_cvt_pk_bf16_f32 %0, %1, %2" : "=v"(r) : "v"(lo), "v"(hi)); return r; }
template <class Epi, class Sched, bool ALIGN_EPI = false, bool SP2 = false>
__device__ __forceinline__ void gemm_phase(PG8_LAS unsigned char* lds, const Gemm g, const Sched& S, const Epi& E, const int wave_in) {
    int lane_l; asm volatile("v_mbcnt_lo_u32_b32 %0, -1, 0\n\tv_mbcnt_hi_u32_b32 %0, -1, %0" : "=v"(lane_l));
    const int wid = wave_in, lane = lane_l, tid = wid * 64 + lane, wr = wid >> 2, wc = wid & 3, fr = lane & 15, fq = lane >> 4;
    const int K = g.K, nt = K / BK;
    unsigned voffA[2], voffB[2];
#pragma unroll
    for (int i = 0; i < 2; ++i) { int R, C; stage_rc(tid * 16 + i * 8192, R, C); const int Rb = Epi::PERM ? ((R & ~31) + perm32(R & 31)) : R;
        voffA[i] = (unsigned)(R * K + C) * 2u; voffB[i] = (unsigned)(Rb * K + C) * 2u; }
    const size_t kstep = (size_t)(BK * 2);
    const size_t hstep = (size_t)HALF * K * 2;
    const size_t tstep = 2 * hstep;
    const unsigned ldsw = (unsigned)wid * 1024u;
    const int aoff = lds_byte(wr * 64 + fr, fq * 8), boff = lds_byte(wc * 32 + fr, fq * 8);
#define PG8_SA(b, h) (((b) * 2 + (h)) * HTB)
#define PG8_SB(b, h) ((4 + (b) * 2 + (h)) * HTB)
#define PG8_STAGE(bufoff, gbase, voff) do { _Pragma("unroll") for (int _i = 0; _i < 2; ++_i) \
        __builtin_amdgcn_global_load_lds((const unsigned*)((const char*)(gbase) + (voff)[_i]), (PG8_LAS unsigned*)(lds + (bufoff) + ldsw + _i * 8192), 16, 0, 0); } while (0)
#define PG8_LDA(dst, b, h) do { _Pragma("unroll") for (int m = 0; m < 4; ++m) _Pragma("unroll") for (int k = 0; k < 2; ++k) dst[m][k] = *(const PG8_LAS bf16x8*)(lds + PG8_SA(b, h) + aoff + m * 2048 + k * 1024); } while (0)
#define PG8_LDB(dst, b, h) do { _Pragma("unroll") for (int n = 0; n < 2; ++n) _Pragma("unroll") for (int k = 0; k < 2; ++k) dst[n][k] = *(const PG8_LAS bf16x8*)(lds + PG8_SB(b, h) + boff + n * 2048 + k * 1024); } while (0)
#define PG8_MMA(ai, bj, At, Bt) do { __builtin_amdgcn_s_setprio(1); _Pragma("unroll") for (int m = 0; m < 4; ++m) _Pragma("unroll") for (int n = 0; n < 2; ++n) _Pragma("unroll") for (int k = 0; k < 2; ++k) \
        acc[ai][bj][m][n] = __builtin_amdgcn_mfma_f32_16x16x32_bf16(Bt[n][k], At[m][k], acc[ai][bj][m][n], 0, 0, 0); __builtin_amdgcn_s_setprio(0); } while (0)
#define PG8_WAIT_V(n) asm volatile("s_waitcnt vmcnt(" #n ")" ::: "memory")
#define PG8_WAIT_L(n) asm volatile("s_waitcnt lgkmcnt(" #n ")" ::: "memory")
#define PG8_BAR __builtin_amdgcn_s_barrier()
#define PG8_SCHED __builtin_amdgcn_sched_barrier(0)
    Unit cur, nxt; int ui = 0;
    if (!S.next(0, cur)) return;
    f32x4 acc[2][2][4][2];
#pragma unroll
    for (int a = 0; a < 2; ++a)
#pragma unroll
        for (int b = 0; b < 2; ++b)
#pragma unroll
            for (int m = 0; m < 4; ++m)
#pragma unroll
                for (int n = 0; n < 2; ++n) acc[a][b][m][n] = (f32x4){0.f, 0.f, 0.f, 0.f};
    bf16x8 At[4][2], B0[2][2], B1[2][2];
    const char* cA = (const char*)g.A + (size_t)cur.pm * tstep; const char* cB = (const char*)g.Bt + (size_t)cur.pn * tstep;
    S.a_ready(cur);
    if constexpr (SP2) {
        PG8_STAGE(PG8_SB(0, 0), cB, voffB); PG8_STAGE(PG8_SB(0, 1), cB + hstep, voffB); PG8_STAGE(PG8_SA(0, 0), cA, voffA); PG8_STAGE(PG8_SA(0, 1), cA + hstep, voffA);
        if (wr == 1) PG8_BAR;
        PG8_WAIT_V(2); PG8_BAR;
        PG8_STAGE(PG8_SB(1, 0), cB + kstep, voffB); PG8_STAGE(PG8_SA(1, 0), cA + kstep, voffA); PG8_STAGE(PG8_SB(1, 1), cB + hstep + kstep, voffB);
        PG8_WAIT_V(6); PG8_BAR;
    } else {
        PG8_STAGE(PG8_SB(0, 0), cB, voffB); PG8_STAGE(PG8_SA(0, 0), cA, voffA); PG8_STAGE(PG8_SB(0, 1), cB + hstep, voffB); PG8_STAGE(PG8_SA(0, 1), cA + hstep, voffA);
        if (wr == 1) PG8_BAR;
        PG8_WAIT_V(4); PG8_BAR;
        PG8_STAGE(PG8_SB(1, 0), cB + kstep, voffB); PG8_STAGE(PG8_SA(1, 0), cA + kstep, voffA); PG8_STAGE(PG8_SB(1, 1), cB + hstep + kstep, voffB);
        PG8_WAIT_V(6); PG8_BAR;
    }
    for (;;) {
        const bool has_next = S.next(ui + 1, nxt);
        const char* nA = has_next ? (const char*)g.A + (size_t)nxt.pm * tstep : cA; const char* nB = has_next ? (const char*)g.Bt + (size_t)nxt.pn * tstep : cB;
        for (int t = 0; t < nt; t += 2) {
            const bool last = (t == nt - 2);
            const char* a1 = cA + (size_t)(t + 1) * kstep;
            const char* a2 = last ? nA : cA + (size_t)(t + 2) * kstep; const char* b2 = last ? nB : cB + (size_t)(t + 2) * kstep;
            const char* a3 = a2 + kstep; const char* b3 = b2 + kstep;
            if (last && has_next) S.a_ready(nxt);
            if constexpr (SP2) {
            PG8_LDB(B0, 0, 0); PG8_LDB(B1, 0, 1); PG8_SCHED; PG8_LDA(At, 0, 0); PG8_STAGE(PG8_SA(1, 1), a1 + hstep, voffA);
            PG8_WAIT_V(8); PG8_WAIT_L(0); PG8_BAR; PG8_MMA(0, 0, At, B0); PG8_MMA(0, 1, At, B1); PG8_BAR; PG8_SCHED;
            PG8_LDA(At, 0, 1); PG8_STAGE(PG8_SB(0, 0), b2, voffB); PG8_STAGE(PG8_SB(0, 1), b2 + hstep, voffB); PG8_STAGE(PG8_SA(0, 0), a2, voffA);
            PG8_WAIT_V(8); PG8_WAIT_L(0); PG8_BAR; PG8_MMA(1, 0, At, B0); PG8_MMA(1, 1, At, B1); PG8_BAR; PG8_SCHED;
            PG8_LDB(B0, 1, 0); PG8_LDB(B1, 1, 1); PG8_SCHED; PG8_LDA(At, 1, 0); PG8_STAGE(PG8_SA(0, 1), a2 + hstep, voffA);
            PG8_WAIT_V(8); PG8_WAIT_L(0); PG8_BAR; PG8_MMA(0, 0, At, B0); PG8_MMA(0, 1, At, B1); PG8_BAR; PG8_SCHED;
            PG8_LDA(At, 1, 1); PG8_STAGE(PG8_SB(1, 0), b3, voffB); PG8_STAGE(PG8_SB(1, 1), b3 + hstep, voffB); PG8_STAGE(PG8_SA(1, 0), a3, voffA);
            PG8_WAIT_V(8); PG8_WAIT_L(0); PG8_BAR; PG8_MMA(1, 0, At, B0); PG8_MMA(1, 1, At, B1); PG8_BAR; PG8_SCHED;
            } else {
            PG8_LDB(B0, 0, 0); PG8_SCHED; PG8_LDA(At, 0, 0); PG8_STAGE(PG8_SA(1, 1), a1 + hstep, voffA);
            PG8_WAIT_L(8); PG8_BAR; PG8_WAIT_L(0); PG8_MMA(0, 0, At, B0); PG8_BAR; PG8_SCHED;
            PG8_LDB(B1, 0, 1); PG8_STAGE(PG8_SB(0, 0), b2, voffB);
            PG8_BAR; PG8_WAIT_L(0); PG8_MMA(0, 1, At, B1); PG8_BAR;
            PG8_LDA(At, 0, 1); PG8_STAGE(PG8_SA(0, 0), a2, voffA);
            PG8_BAR; PG8_WAIT_L(0); PG8_MMA(1, 0, At, B0); PG8_BAR; PG8_SCHED;
            PG8_STAGE(PG8_SB(0, 1), b2 + hstep, voffB);
            PG8_WAIT_V(6); PG8_BAR; PG8_MMA(1, 1, At, B1); PG8_BAR;
            PG8_LDB(B0, 1, 0); PG8_SCHED; PG8_LDA(At, 1, 0); PG8_STAGE(PG8_SA(0, 1), a2 + hstep, voffA);
            PG8_WAIT_L(8); PG8_BAR; PG8_WAIT_L(0); PG8_MMA(0, 0, At, B0); PG8_BAR; PG8_SCHED;
            PG8_LDB(B1, 1, 1); PG8_STAGE(PG8_SB(1, 0), b3, voffB);
            PG8_BAR; PG8_WAIT_L(0); PG8_MMA(0, 1, At, B1); PG8_BAR;
            PG8_LDA(At, 1, 1); PG8_STAGE(PG8_SA(1, 0), a3, voffA);
            PG8_BAR; PG8_WAIT_L(0); PG8_MMA(1, 0, At, B0); PG8_BAR; PG8_SCHED;
            PG8_STAGE(PG8_SB(1, 1), b3 + hstep, voffB);
            PG8_WAIT_V(6); PG8_BAR; PG8_MMA(1, 1, At, B1); PG8_BAR;
            }
        }
        if constexpr (ALIGN_EPI) { if (wr == 0) PG8_BAR; }
        if constexpr (!Epi::AFTER_DRAIN) { E(acc, cur, wr, wc, fr, fq); S.done(cur); }
        if (!has_next) break;
#pragma unroll
        for (int a = 0; a < 2; ++a)
#pragma unroll
            for (int b = 0; b < 2; ++b)
#pragma unroll
                for (int m = 0; m < 4; ++m)
#pragma unroll
                    for (int n = 0; n < 2; ++n) acc[a][b][m][n] = (f32x4){0.f, 0.f, 0.f, 0.f};
        cur = nxt; cA = nA; cB = nB; ++ui;
        if constexpr (ALIGN_EPI) { if (wr == 1) PG8_BAR; }
    }
    PG8_WAIT_V(0);
    if constexpr (!ALIGN_EPI) { if (wr == 0) PG8_BAR; }
    PG8_BAR;
    if constexpr (Epi::AFTER_DRAIN) { E.fused(acc, cur, wr, wc, fr, fq, lds, wid, lane); S.done(cur); }
#undef PG8_SA
#undef PG8_SB
#undef PG8_STAGE
#undef PG8_LDA
#undef PG8_LDB
#undef PG8_MMA
#undef PG8_WAIT_V
#undef PG8_WAIT_L
#undef PG8_BAR
#undef PG8_SCHED
}
}

#define LAS __attribute__((address_space(3)))
#define DEV __device__ __forceinline__
typedef unsigned short bf16_t;
typedef float f32x4 __attribute__((ext_vector_type(4)));
typedef short bf16x8 __attribute__((ext_vector_type(8)));
typedef unsigned u32x4 __attribute__((ext_vector_type(4)));
typedef unsigned u32x2 __attribute__((ext_vector_type(2)));
typedef __bf16 bf2_t __attribute__((ext_vector_type(2)));

constexpr int TP = 32768, TS = 1024, T = TP + TS;
constexpr float EPS = 1e-6f;
constexpr size_t O_NKP = 34603008, O_NVP = O_NKP + 131072, O_NKS = O_NVP + 131072, O_NVS = O_NKS + 131072,
                 O_SVP = O_NVS + 131072, O_SVS = O_SVP + 524288, O_END = O_SVS + 524288;
static_assert(O_END == 36175872, "output size");
constexpr size_t KiB = 1024, MiB = 1048576;
constexpr size_t WS_RSTD1 = 0, WS_LNSTAT = 256 * KiB, WS_SSQ2 = 768 * KiB, WS_RSTD3 = 1024 * KiB, WS_BAR = 1536 * KiB;
constexpr size_t WS_WIN = 2 * MiB, WS_WA = WS_WIN + 7680 * KiB, WS_WB = WS_WA + MiB, WS_WOUT = WS_WB + MiB, WS_WQ = WS_WOUT + 2 * MiB,
                 WS_SK = WS_WQ + 4 * MiB, WS_WPLE = WS_SK + 512 * KiB, WS_WG = WS_WPLE + 512 * KiB, WS_SGUW = WS_WG + 2 * MiB,
                 WS_CK = 21 * MiB, WS_CVT = 25 * MiB, WS_PU = 29 * MiB, WS_PV = 61 * MiB, WS_PB = 93 * MiB,
                 WS_S1 = 110 * MiB, WS_S2 = 242 * MiB, WS_S3 = 308 * MiB, WS_S4 = 374 * MiB, WS_S5 = 440 * MiB, WS_END = 482 * MiB;
static_assert(WS_SGUW + 128 * KiB <= WS_CK, "ws map");
constexpr int LDS_BYTES = 143360 + 64;

struct KArgs { const float* in[26]; float* out; unsigned char* ws; };

DEV unsigned pk2(float lo, float hi) { unsigned r; asm("v_cvt_pk_bf16_f32 %0, %1, %2" : "=v"(r) : "v"(lo), "v"(hi)); return r; }
DEV unsigned f2bf(float f) { return pk2(f, f) & 0xffffu; }
DEV float bflo(unsigned w) { return __builtin_bit_cast(float, w << 16); }
DEV float bfhi(unsigned w) { return __builtin_bit_cast(float, w & 0xffff0000u); }
DEV float bf1(bf16_t h) { return __builtin_bit_cast(float, (unsigned)h << 16); }
DEV float gelu_t(float x) { const float u = 1.5957691216f * (x + 0.044715f * x * x * x); return x * __builtin_amdgcn_rcpf(1.f + __expf(-u)); }
DEV float sigm(float x) { return __builtin_amdgcn_rcpf(1.f + __expf(-x)); }
DEV void st8bf(bf16_t* p, const float (&v)[8]) { u32x4 w; w.x = pk2(v[0], v[1]); w.y = pk2(v[2], v[3]); w.z = pk2(v[4], v[5]); w.w = pk2(v[6], v[7]); *(u32x4*)p = w; }
DEV void ld8bf(const bf16_t* p, float (&v)[8]) { const u32x4 w = *(const u32x4*)p; v[0] = bflo(w.x); v[1] = bfhi(w.x); v[2] = bflo(w.y); v[3] = bfhi(w.y); v[4] = bflo(w.z); v[5] = bfhi(w.z); v[6] = bflo(w.w); v[7] = bfhi(w.w); }
DEV void st8f(float* p, const float (&v)[8]) { *(f32x4*)p = (f32x4){v[0], v[1], v[2], v[3]}; *(f32x4*)(p + 4) = (f32x4){v[4], v[5], v[6], v[7]}; }
DEV void st8f_nt(float* p, const float (&v)[8]) { __builtin_nontemporal_store((f32x4){v[0], v[1], v[2], v[3]}, (f32x4*)p); __builtin_nontemporal_store((f32x4){v[4], v[5], v[6], v[7]}, (f32x4*)(p + 4)); }
DEV void ld8f(const float* p, float (&v)[8]) { const f32x4 a = *(const f32x4*)p, b = *(const f32x4*)(p + 4); v[0] = a.x; v[1] = a.y; v[2] = a.z; v[3] = a.w; v[4] = b.x; v[5] = b.y; v[6] = b.z; v[7] = b.w; }
DEV float wave_sum(float v) {
#pragma unroll
    for (int o = 1; o < 64; o <<= 1) v += __shfl_xor(v, o);
    return v;
}
DEV float rowmax16(float v) { v = fmaxf(v, __shfl_xor(v, 1)); v = fmaxf(v, __shfl_xor(v, 2)); v = fmaxf(v, __shfl_xor(v, 4)); v = fmaxf(v, __shfl_xor(v, 8)); return v; }
DEV float rowsum16(float v) { v += __shfl_xor(v, 1); v += __shfl_xor(v, 2); v += __shfl_xor(v, 4); v += __shfl_xor(v, 8); return v; }
DEV int rowmax16i(int v) { v = max(v, __shfl_xor(v, 1)); v = max(v, __shfl_xor(v, 2)); v = max(v, __shfl_xor(v, 4)); v = max(v, __shfl_xor(v, 8)); return v; }
template <int CTRL> DEV float dppf(float v) { return __builtin_bit_cast(float, __builtin_amdgcn_update_dpp(0, __builtin_bit_cast(int, v), CTRL, 0xf, 0xf, false)); }
DEV float vmax(float a, float b) { float r; asm("v_max_f32_e32 %0, %1, %2" : "=v"(r) : "v"(a), "v"(b)); return r; }
DEV float vmin(float a, float b) { float r; asm("v_min_f32_e32 %0, %1, %2" : "=v"(r) : "v"(a), "v"(b)); return r; }
#define ROR_MAX(N) DEV float vmax_ror##N(float v) { float r; asm("s_nop 1\n\tv_max_f32_dpp %0, %1, %1 row_ror:" #N " row_mask:0xf bank_mask:0xf" : "=v"(r) : "v"(v)); return r; }
ROR_MAX(8) ROR_MAX(4) ROR_MAX(2) ROR_MAX(1)
DEV float rowmax16d(float v) { v = vmax_ror8(v); v = vmax_ror4(v); v = vmax_ror2(v); v = vmax_ror1(v); return v; }
DEV float rowsum16d(float v) { v += dppf<0x128>(v); v += dppf<0x124>(v); v += dppf<0x122>(v); v += dppf<0x121>(v); return v; }
DEV f32x4 mfma16(bf16x8 a, bf16x8 b, f32x4 c) { return __builtin_amdgcn_mfma_f32_16x16x32_bf16(a, b, c, 0, 0, 0); }
DEV const float* xrow(const KArgs& A, int row) { return row < TP ? A.in[0] + (size_t)row * 1024 : A.in[1] + (size_t)(row - TP) * 1024; }

template <int mode> struct Epi {
    static constexpr bool PERM = true, AFTER_DRAIN = false;
    const float* xp; const float* xs; float* out; unsigned char* ws;
    DEV void operator()(const f32x4 (&acc)[2][2][4][2], const pg8::Unit& u, int wr, int wc, int fr, int fq) const {
        rowop<0, 0>(acc, u, wr, wc, fr, fq); rowop<0, 1>(acc, u, wr, wc, fr, fq); rowop<0, 2>(acc, u, wr, wc, fr, fq); rowop<0, 3>(acc, u, wr, wc, fr, fq);
        rowop<1, 0>(acc, u, wr, wc, fr, fq); rowop<1, 1>(acc, u, wr, wc, fr, fq); rowop<1, 2>(acc, u, wr, wc, fr, fq); rowop<1, 3>(acc, u, wr, wc, fr, fq);
    }
    template <int ai, int m>
    DEV void rowop(const f32x4 (&acc)[2][2][4][2], const pg8::Unit& u, int wr, int wc, int fr, int fq) const {
        const int pn = u.pn;
            {
                const int row = u.pm * 256 + ai * 128 + wr * 64 + m * 16 + fr;
                float rs = 1.f, s1 = 0.f, s2 = 0.f;
                if (mode == 1) rs = ((const float*)(ws + WS_RSTD1))[row];
                else if (mode == 5) rs = rsqrtf(((const float*)(ws + WS_SSQ2))[row] * (1.f / 1024.f) + EPS);
                else if (mode == 7) rs = ((const float*)(ws + WS_RSTD3))[row];
#pragma unroll
                for (int bj = 0; bj < 2; ++bj) {
                    const int col0 = pn * 256 + bj * 128 + wc * 32 + 8 * fq;
                    float v[8];
#pragma unroll
                    for (int i = 0; i < 4; ++i) { v[i] = acc[ai][bj][m][0][i] * rs; v[4 + i] = acc[ai][bj][m][1][i] * rs; }
                    if (mode == 1) {
                        if (pn < 2 || (pn == 2 && bj == 0)) {
                            st8bf((bf16_t*)(ws + WS_S3) + (size_t)row * 640 + col0, v);
                        } else if (pn == 2) {
                            const int c = col0 - 640, chunk = row >> 7, tok = row & 127;
                            bf16_t* vt = (bf16_t*)(ws + WS_S3) + (size_t)T * 640 + (size_t)chunk * 16384 + c * 128 + tok;
#pragma unroll
                            for (int i = 0; i < 8; ++i) vt[i * 128] = (bf16_t)f2bf(v[i]);
                            if (row >= TP) st8f(out + O_NVS + (size_t)(row - TP) * 128 + c, v);
                            else if ((row & 4095) >= 3968) st8f(out + O_NVP + (size_t)((row >> 12) * 128 + (row & 4095) - 3968) * 128 + c, v);
                        } else if (pn < 5) {
#pragma unroll
                            for (int i = 0; i < 8; ++i) v[i] = gelu_t(v[i]);
                            st8bf((bf16_t*)(ws + WS_S4) + (size_t)row * 512 + (col0 - 768), v);
                        } else if (pn < 7) {
                            const int c = col0 - 1280, chunk = row >> 7, tok = row & 127;
                            bf16_t* gt = (bf16_t*)(ws + WS_S4) + (size_t)T * 512 + (size_t)chunk * 65536 + c * 128 + tok;
#pragma unroll
                            for (int i = 0; i < 8; ++i) { const unsigned hb = f2bf(gelu_t(v[i])); gt[i * 128] = (bf16_t)hb; const float gr = bf1((bf16_t)hb); s1 += gr; s2 += gr * gr; }
                        } else {
#pragma unroll
                            for (int i = 0; i < 8; ++i) v[i] = sigm(v[i]);
                            st8bf((bf16_t*)(ws + WS_S1) + (size_t)row * 2048 + (col0 - 1792), v);
                        }
                    } else if (mode == 2) {
                        float g[8]; ld8bf((const bf16_t*)(ws + WS_S1) + (size_t)row * 2048 + col0, g);
#pragma unroll
                        for (int i = 0; i < 8; ++i) v[i] *= g[i];
                        st8bf((bf16_t*)(ws + WS_S3) + (size_t)row * 1024 + col0, v);
                    } else if (mode == 3) {
                        float g[8], t[8]; ld8bf((const bf16_t*)(ws + WS_S1) + (size_t)row * 2048 + 1024 + col0, g); ld8bf((const bf16_t*)(ws + WS_S3) + (size_t)row * 1024 + col0, t);
#pragma unroll
                        for (int i = 0; i < 8; ++i) v[i] = t[i] + g[i] * v[i];
                        st8bf((bf16_t*)(ws + WS_S4) + (size_t)row * 1024 + col0, v);
                    } else if (mode == 4) {
                        float xv[8]; ld8bf((const bf16_t*)out + (size_t)row * 1024 + col0, xv);
#pragma unroll
                        for (int i = 0; i < 8; ++i) { v[i] += xv[i]; s1 += v[i] * v[i]; }
                        st8bf((bf16_t*)(ws + WS_S3) + (size_t)row * 1024 + col0, v);
                    } else if (mode == 5) {
                        st8bf((bf16_t*)(ws + WS_S1) + (size_t)row * 2048 + col0, v);
                    } else if (mode == 6) {
                        st8bf((bf16_t*)(ws + WS_S4) + (size_t)row * 1024 + col0, v);
                    } else {
                        float x2[8], pe[8]; ld8bf((const bf16_t*)(ws + WS_S2) + (size_t)row * 1024 + col0, x2); ld8bf((const bf16_t*)(ws + WS_S4) + (size_t)row * 1024 + col0, pe);
#pragma unroll
                        for (int i = 0; i < 8; ++i) v[i] = x2[i] + sigm(v[i]) * pe[i];
                        st8f_nt(out + (size_t)row * 1024 + col0, v);
                    }
                }
                if ((mode == 1 && (pn == 5 || pn == 6)) || mode == 4) {
                    s1 += __shfl_xor(s1, 16); s1 += __shfl_xor(s1, 32); s2 += __shfl_xor(s2, 16); s2 += __shfl_xor(s2, 32);
                    if (fq == 0) {
                        if (mode == 1) { float* ls = (float*)(ws + WS_LNSTAT) + (size_t)row * 2; atomicAdd(ls, s1); atomicAdd(ls + 1, s2); }
                        else atomicAdd((float*)(ws + WS_SSQ2) + row, s1);
                    }
                }
            }
    }
};

DEV void tr_item(const float* W, const float* ksc, int K, int N, bf16_t* WT, LAS float* scr, int item, int lane) {
    const int nblk = N / 32, kb = item / nblk, nb = item % nblk, k0 = 64 * kb, n0 = 32 * nb;
    const int r = lane >> 3, c4 = (lane & 7) * 4;
    f32x4 w[8];
#pragma unroll
    for (int i = 0; i < 8; ++i) w[i] = *(const f32x4*)(W + (size_t)(k0 + 8 * i + r) * N + n0 + c4);
#pragma unroll
    for (int i = 0; i < 8; ++i) { const int kk = 8 * i + r; const float sc = ksc ? ksc[k0 + kk] : 1.f; LAS float* d = scr + kk * 33 + c4;
        d[0] = w[i].x * sc; d[1] = w[i].y * sc; d[2] = w[i].z * sc; d[3] = w[i].w * sc; }
    asm volatile("s_waitcnt lgkmcnt(0)" ::: "memory");
    const int c = lane & 7;
#pragma unroll
    for (int j = 0; j < 4; ++j) { const int n = (lane >> 3) + 8 * j; const LAS float* s = scr + (8 * c) * 33 + n;
        u32x4 o; o.x = pk2(s[0 * 33], s[1 * 33]); o.y = pk2(s[2 * 33], s[3 * 33]); o.z = pk2(s[4 * 33], s[5 * 33]); o.w = pk2(s[6 * 33], s[7 * 33]);
        *(u32x4*)(WT + (size_t)(n0 + n) * K + k0 + 8 * c) = o; }
    asm volatile("s_waitcnt lgkmcnt(0)" ::: "memory");
}
DEV void cvt_flat(const float* src, bf16_t* dst, int ngroups, int gtid, int NT) {
    for (int i = gtid; i < ngroups / 4; i += NT) {
        float v[4][8];
#pragma unroll
        for (int u = 0; u < 4; ++u) ld8f(src + ((size_t)u * (ngroups / 4) + i) * 8, v[u]);
#pragma unroll
        for (int u = 0; u < 4; ++u) st8bf(dst + ((size_t)u * (ngroups / 4) + i) * 8, v[u]);
    }
}
constexpr float PEER_SU = 64.f, PEER_SV = 24.f;
DEV unsigned pk8_fp4(const float (&v)[8], float sc) {
    unsigned p = 0;
    p = __builtin_amdgcn_cvt_scalef32_pk_fp4_f32(p, v[0] * sc, v[1] * sc, 1.0f, 0); p = __builtin_amdgcn_cvt_scalef32_pk_fp4_f32(p, v[2] * sc, v[3] * sc, 1.0f, 1);
    p = __builtin_amdgcn_cvt_scalef32_pk_fp4_f32(p, v[4] * sc, v[5] * sc, 1.0f, 2); p = __builtin_amdgcn_cvt_scalef32_pk_fp4_f32(p, v[6] * sc, v[7] * sc, 1.0f, 3);
    return p;
}
DEV void cvt_fp4(const float* src, unsigned char* dst, int ngroups  , float sc, int gtid, int NT) {
    for (int i = gtid; i < ngroups / 4; i += NT) {
        float v[4][8];
#pragma unroll
        for (int u = 0; u < 4; ++u) ld8f(src + ((size_t)u * (ngroups / 4) + i) * 8, v[u]);
#pragma unroll
        for (int u = 0; u < 4; ++u) ((unsigned*)dst)[(size_t)u * (ngroups / 4) + i] = pk8_fp4(v[u], sc);
    }
}
DEV void p0_phase(const KArgs& A, LAS unsigned char* lds, int lane, int wave, int gw, int NGW, int gtid, int NT, const int part) {
    unsigned char* ws = A.ws;
    if (part == 0) { float* ls = (float*)(ws + WS_LNSTAT); for (int i = gtid; i < T * 2; i += NT) ls[i] = 0.f;
      float* sq = (float*)(ws + WS_SSQ2); for (int i = gtid; i < T; i += NT) sq[i] = 0.f; }
    LAS float* scr = (LAS float*)(lds + wave * 8704);
    constexpr int I_IN = 16 * 120, I_A = 8 * 32, I_B = 8 * 32, I_O = 16 * 32, I_Q = 16 * 64, I_P = 4 * 32, I_G = 16 * 32, NIT = I_IN + I_A + I_B + I_O + I_Q + I_P + I_G;
    constexpr int I_MID = I_IN + I_A + I_B + I_O;
    for (int it = (part == 0 ? gw : (part == 1 ? I_IN + gw : I_MID + gw)); it < (part == 0 ? I_IN : (part == 1 ? I_MID : (part == 3 ? NIT : 0))); it += NGW) {
        int r = it; const float* W; const float* sc = nullptr; int K, N; bf16_t* WT;
        if (r < I_IN) { W = A.in[7]; sc = A.in[6]; K = 1024; N = 3840; WT = (bf16_t*)(ws + WS_WIN); }
        else if ((r -= I_IN) < I_A) { W = A.in[15]; K = 512; N = 1024; WT = (bf16_t*)(ws + WS_WA); }
        else if ((r -= I_A) < I_B) { W = A.in[16]; K = 512; N = 1024; WT = (bf16_t*)(ws + WS_WB); }
        else if ((r -= I_B) < I_O) { W = A.in[17]; K = 1024; N = 1024; WT = (bf16_t*)(ws + WS_WOUT); }
        else if ((r -= I_O) < I_Q) { W = A.in[19]; sc = A.in[18]; K = 1024; N = 2048; WT = (bf16_t*)(ws + WS_WQ); }
        else if ((r -= I_Q) < I_P) { W = A.in[24]; K = 256; N = 1024; WT = (bf16_t*)(ws + WS_WPLE); }
        else { r -= I_P; W = A.in[25]; sc = A.in[23]; K = 1024; N = 1024; WT = (bf16_t*)(ws + WS_WG); }
        tr_item(W, sc, K, N, WT, scr, r, lane);
    }
    if (part == 2) {
    cvt_flat(A.in[4], (bf16_t*)(ws + WS_PB), 1048576, gtid, NT);
    cvt_flat(A.in[5], (bf16_t*)(ws + WS_PB) + (size_t)TP * 256, 32768, gtid, NT);
    }
    if (part == 1) {
    cvt_flat(A.in[20], (bf16_t*)(ws + WS_SK), 32768, gtid, NT);
    cvt_flat(A.in[2], (bf16_t*)(ws + WS_CK), 262144, gtid, NT);
    for (int i = gtid; i < 8192; i += NT) {
        const int t = (i >> 4) & 127, s0 = (i & 15) * 8; float v[8]; ld8f(A.in[13] + (size_t)i * 8, v);
#pragma unroll
        for (int e = 0; e < 8; ++e) if (s0 + e > t) v[e] = 0.f;
        st8bf((bf16_t*)(ws + WS_SGUW) + (size_t)i * 8, v);
    }
    for (int i = gtid; i < 262144; i += NT) {
        const int d = i & 63, kg = (i >> 6) & 15, kvh = (i >> 10) & 1, seq = i >> 11; float v[8];
#pragma unroll
        for (int e = 0; e < 8; ++e) v[e] = A.in[3][((size_t)(seq * 128 + kg * 8 + e) * 2 + kvh) * 64 + d];
        st8bf((bf16_t*)(ws + WS_CVT) + ((size_t)(seq * 2 + kvh) * 64 + d) * 128 + kg * 8, v);
    }
    }
    if (part == 0)
    for (int row0 = gw * 2; row0 < T; row0 += NGW * 2) {
        f32x4 v[2][4]; float s[2];
#pragma unroll
        for (int r = 0; r < 2; ++r) { const f32x4* xr = (const f32x4*)xrow(A, row0 + r) + lane;
#pragma unroll
            for (int j = 0; j < 4; ++j) v[r][j] = __builtin_nontemporal_load(xr + 64 * j); }
#pragma unroll
        for (int r = 0; r < 2; ++r) { s[r] = 0.f;
#pragma unroll
            for (int j = 0; j < 4; ++j) s[r] += (v[r][j].x * v[r][j].x + v[r][j].y * v[r][j].y) + (v[r][j].z * v[r][j].z + v[r][j].w * v[r][j].w);
            s[r] = wave_sum(s[r]);
            if (lane == 0) ((float*)(ws + WS_RSTD1))[row0 + r] = rsqrtf(s[r] * (1.f / 1024.f) + EPS);
            u32x2* o = (u32x2*)((bf16_t*)A.out + (size_t)(row0 + r) * 1024) + lane;
#pragma unroll
            for (int j = 0; j < 4; ++j) { u32x2 w; w.x = pk2(v[r][j].x, v[r][j].y); w.y = pk2(v[r][j].z, v[r][j].w); o[64 * j] = w; } }
    }
}

DEV void p2_item(const KArgs& A, const bf16_t* zqk, bf16_t* qn, bf16_t* kn, int i, float (&v)[8]) {
    const int row = i / 80, g = i - row * 80;
    float ss = 0.f;
#pragma unroll
    for (int e = 0; e < 8; ++e) ss += v[e] * v[e];
    ss += __shfl_xor(ss, 1); ss += __shfl_xor(ss, 2); ss += __shfl_xor(ss, 4);
    const float r = rsqrtf(ss * (1.f / 64.f) + EPS);
    const int d0 = (g & 7) * 8;
    if (g < 64) {
        float gg[8]; ld8f(A.in[8] + d0, gg);
#pragma unroll
        for (int e = 0; e < 8; ++e) v[e] = v[e] * r * gg[e] * 0.125f;
        st8bf(qn + (size_t)row * 512 + g * 8, v);
    } else {
        float gg[8]; ld8f(A.in[9] + d0, gg);
#pragma unroll
        for (int e = 0; e < 8; ++e) v[e] = v[e] * r * gg[e];
        const int c = (g - 64) * 8;
        st8bf(kn + (size_t)row * 128 + c, v);
        if (row >= TP) st8f(A.out + O_NKS + (size_t)(row - TP) * 128 + c, v);
        else if ((row & 4095) >= 3968) st8f(A.out + O_NKP + (size_t)((row >> 12) * 128 + (row & 4095) - 3968) * 128 + c, v);
    }
}
DEV void p2_phase(const KArgs& A, int gtid, int NT) {
    unsigned char* ws = A.ws;
    const bf16_t* zqk = (const bf16_t*)(ws + WS_S3);
    bf16_t* qn = (bf16_t*)(ws + WS_S5); bf16_t* kn = qn + (size_t)T * 512;
    constexpr int NI = T * 80, Q4 = NI / 4;
    static_assert(NI % 4 == 0 && Q4 % 64 == 0, "p2 split");
    for (int i = gtid; i < Q4; i += NT) {
        float v[4][8];
#pragma unroll
        for (int u = 0; u < 4; ++u) { const int ii = u * Q4 + i; const int row = ii / 80, g = ii - row * 80; ld8bf(zqk + (size_t)row * 640 + g * 8, v[u]); }
#pragma unroll
        for (int u = 0; u < 4; ++u) p2_item(A, zqk, qn, kn, u * Q4 + i, v[u]);
    }
}

template <bool SAMPLE>
DEV void attn_task(const KArgs& A, int task, LAS bf16_t* P, int lane) {
    unsigned char* ws = A.ws;
    const bf16_t* qn = (const bf16_t*)(ws + WS_S5);
    const bf16_t* kn = qn + (size_t)T * 512;
    const bf16_t* VT = (const bf16_t*)(ws + WS_S3) + (size_t)T * 640;
    const bf16_t* ck = (const bf16_t*)(ws + WS_CK);
    const bf16_t* cvT = (const bf16_t*)(ws + WS_CVT);
    bf16_t* ab = (bf16_t*)(ws + WS_S2);
    const int fr = lane & 15, quad = lane >> 4;
    int kvh, st = 0, cj = 0, j = 0, prevc = 0, seq = 0, i0 = 0, hq_u = 0, p2 = 0;
    if (!SAMPLE) { const int unit = task >> 5, sub = task & 31, w = sub >> 2, a = (w & 1) * 4 + (sub & 3); kvh = unit & 1; cj = unit >> 1; j = cj & 31; prevc = j > 0 ? cj - 1 : cj; i0 = 16 * a; st = a < 6 ? a : 6; hq_u = kvh * 4 + (w >> 1); }
    else { seq = task >> 2; kvh = (task >> 1) & 1; p2 = task & 1; }
    size_t qoff;
    if (!SAMPLE) qoff = (size_t)(cj * 128 + i0 + fr) * 512 + hq_u * 64;
    else qoff = (size_t)(TP + seq * 8 + (fr & 7)) * 512 + (kvh * 4 + 2 * p2 + (fr >> 3)) * 64;
    const bf16x8 qa0 = *(const bf16x8*)(qn + qoff + quad * 8), qa1 = *(const bf16x8*)(qn + qoff + 32 + quad * 8);
    f32x4 S[10];
#pragma unroll
    for (int t = 0; t < 10; ++t) {
        const int r = (st + t) * 16 + fr; const bf16_t* kp;
        if (!SAMPLE) { const int tk = (r < 128) ? prevc * 128 + r : cj * 128 + r - 128; kp = kn + (size_t)tk * 128 + kvh * 64; }
        else { if (r < 128) kp = ck + ((size_t)(seq * 128 + r) * 2 + kvh) * 64; else { int l2 = r - 128; l2 = l2 > 7 ? 7 : l2; kp = kn + (size_t)(TP + seq * 8 + l2) * 128 + kvh * 64; } }
        const bf16x8 kb0 = *(const bf16x8*)(kp + quad * 8), kb1 = *(const bf16x8*)(kp + 32 + quad * 8);
        f32x4 z = {0.f, 0.f, 0.f, 0.f}; z = mfma16(qa0, kb0, z); z = mfma16(qa1, kb1, z); S[t] = z;
    }
    bf16x8 vbf[5][4];
#pragma unroll
    for (int ks = 0; ks < 5; ++ks) {
        const int k0 = st * 16 + ks * 32 + quad * 8;
#pragma unroll
        for (int nt = 0; nt < 4; ++nt) {
            const int d = nt * 16 + fr; const bf16_t* vp;
            if (!SAMPLE) vp = (k0 < 128) ? VT + (size_t)prevc * 16384 + (kvh * 64 + d) * 128 + k0 : VT + (size_t)cj * 16384 + (kvh * 64 + d) * 128 + (k0 - 128);
            else vp = (k0 < 128) ? cvT + ((size_t)(seq * 2 + kvh) * 64 + d) * 128 + k0 : VT + (size_t)(256 + (seq >> 4)) * 16384 + (kvh * 64 + d) * 128 + (seq & 15) * 8;
            vbf[ks][nt] = *(const bf16x8*)vp;
        }
    }
    const int hq_c = SAMPLE ? (kvh * 4 + 2 * p2 + (quad >> 1)) : hq_u;
    const float slope = exp2f(-(float)(hq_c + 1)), sink = A.in[10][hq_c];
    float inv_l[4];
#pragma unroll
    for (int reg = 0; reg < 4; ++reg) {
        const int irow = SAMPLE ? ((quad & 1) * 4 + reg) : (i0 + quad * 4 + reg);
        float mx = sink, sv[10];
#pragma unroll
        for (int t = 0; t < 10; ++t) {
            const int r = (st + t) * 16 + fr, dist = irow - r + 128;
            const bool valid = dist >= 0 && dist < 128 && (SAMPLE ? (r < 136) : (j > 0 || r >= 128));
            const float s = valid ? S[t][reg] - slope * (float)dist : -1e30f; sv[t] = s; mx = vmax(mx, s);
        }
        mx = rowmax16d(mx);
        float l = 0.f;
#pragma unroll
        for (int t = 0; t < 10; ++t) { const float p = __expf(sv[t] - mx); l += p; P[(quad * 4 + reg) * 168 + t * 16 + fr] = (bf16_t)f2bf(p); }
        l = rowsum16d(l) + __expf(sink - mx);
        inv_l[reg] = __builtin_amdgcn_rcpf(l);
    }
    if (fr == 0) { LAS float* Li = (LAS float*)(P + 16 * 168);
#pragma unroll
        for (int reg = 0; reg < 4; ++reg) Li[quad * 4 + reg] = inv_l[reg]; }
    asm volatile("s_waitcnt lgkmcnt(0)" ::: "memory");
    f32x4 O[4];
#pragma unroll
    for (int nt = 0; nt < 4; ++nt) O[nt] = (f32x4){0.f, 0.f, 0.f, 0.f};
#pragma unroll
    for (int ks = 0; ks < 5; ++ks) {
        const bf16x8 pa = *(const LAS bf16x8*)(P + fr * 168 + ks * 32 + quad * 8);
#pragma unroll
        for (int nt = 0; nt < 4; ++nt) O[nt] = mfma16(vbf[ks][nt], pa, O[nt]);
    }
    {
        const float il = ((const LAS float*)(P + 16 * 168))[fr]; size_t ooff;
        if (!SAMPLE) ooff = (size_t)(cj * 128 + i0 + fr) * 512 + hq_u * 64;
        else ooff = (size_t)(TP + seq * 8 + (fr & 7)) * 512 + (kvh * 4 + 2 * p2 + (fr >> 3)) * 64;
#pragma unroll
        for (int nt = 0; nt < 4; ++nt) { const f32x4 ov = O[nt]; u32x2 w; w.x = pk2(ov[0] * il, ov[1] * il); w.y = pk2(ov[2] * il, ov[3] * il); *(u32x2*)(ab + ooff + nt * 16 + quad * 4) = w; }
    }
    asm volatile("s_waitcnt lgkmcnt(0)" ::: "memory");
}

DEV void ln_stats8(const float* st, float (&mean)[8], float (&rstd)[8]) {
#pragma unroll
    for (int e2 = 0; e2 < 4; ++e2) {
        const f32x4 q = ((const f32x4*)st)[e2];
        const float m0 = q.x * (1.f / 512.f), m1 = q.z * (1.f / 512.f);
        mean[2 * e2] = m0; mean[2 * e2 + 1] = m1;
        rstd[2 * e2] = rsqrtf(fmaxf(q.y * (1.f / 512.f) - m0 * m0, 0.f) + EPS); rstd[2 * e2 + 1] = rsqrtf(fmaxf(q.w * (1.f / 512.f) - m1 * m1, 0.f) + EPS);
    }
}

DEV void sgu_task(const KArgs& A, int task, int lane) {
    unsigned char* ws = A.ws;
    const int fr = lane & 15, quad = lane >> 4;
    const int cj = task >> 5, g = (task >> 3) & 3, rb = task & 7, kk = (task >> 11) & 3, rb4 = (rb + 4) & 7;
    const int rt = kk == 0 ? rb : (kk == 1 ? 7 - rb : (kk == 2 ? rb4 : 7 - rb4)), nks = (rt >> 1) + 1;
    const bf16_t* W = (const bf16_t*)(ws + WS_SGUW) + (size_t)(g * 128 + rt * 16 + fr) * 128;
    const bf16_t* gv = (const bf16_t*)(ws + WS_S4) + (size_t)T * 512 + (size_t)cj * 65536 + (size_t)(g * 128 + fr) * 128;
    const float* st = (const float*)(ws + WS_LNSTAT) + (size_t)cj * 256;
    const bf16_t* ub = (const bf16_t*)(ws + WS_S4);
    bf16_t* mb = (bf16_t*)(ws + WS_S2) + (size_t)T * 512;
    f32x4 acc[8];
#pragma unroll
    for (int nt = 0; nt < 8; ++nt) acc[nt] = (f32x4){0.f, 0.f, 0.f, 0.f};
    for (int ks = 0; ks < nks; ++ks) {
        const bf16x8 wa = *(const bf16x8*)(W + ks * 32 + quad * 8);
        float mean[8], rstd[8]; ln_stats8(st + (ks * 32 + quad * 8) * 2, mean, rstd);
#pragma unroll
        for (int nt = 0; nt < 8; ++nt) {
            const int c = g * 128 + nt * 16 + fr; float x[8]; ld8bf(gv + nt * 2048 + ks * 32 + quad * 8, x);
            const float lg = A.in[11][c], lb = A.in[12][c];
#pragma unroll
            for (int e = 0; e < 8; ++e) x[e] = (x[e] - mean[e]) * rstd[e] * lg + lb;
            u32x4 w; w.x = pk2(x[0], x[1]); w.y = pk2(x[2], x[3]); w.z = pk2(x[4], x[5]); w.w = pk2(x[6], x[7]);
            acc[nt] = mfma16(__builtin_bit_cast(bf16x8, w), wa, acc[nt]);
        }
    }
    {
        const int t = rt * 16 + fr; const size_t tok = (size_t)cj * 128 + t; const float bb = A.in[14][g * 128 + t];
#pragma unroll
        for (int nt = 0; nt < 8; ++nt) {
            const int c = g * 128 + nt * 16 + quad * 4;
            const u32x2 uu = *(const u32x2*)(ub + tok * 512 + c); const f32x4 av = acc[nt];
            u32x2 o; o.x = pk2(bflo(uu.x) * (av[0] + bb), bfhi(uu.x) * (av[1] + bb)); o.y = pk2(bflo(uu.y) * (av[2] + bb), bfhi(uu.y) * (av[3] + bb));
            *(u32x2*)(mb + tok * 512 + c) = o;
        }
    }
}

DEV void sgu_small(const KArgs& A, int gtid, int NT) {
    unsigned char* ws = A.ws;
    const bf16_t* gvT = (const bf16_t*)(ws + WS_S4) + (size_t)T * 512;
    const bf16_t* ub = (const bf16_t*)(ws + WS_S4);
    bf16_t* mb = (bf16_t*)(ws + WS_S2) + (size_t)T * 512;
    for (int i = gtid; i < 131072; i += NT) {
        const bool samp = i < 65536; const int ii = samp ? i : i - 65536, c = ii & 511, grp = ii >> 9;
        const int tokbase = samp ? TP + grp * 8 : ((grp >> 4) * 4096 + 3968 + (grp & 15) * 8);
        const int chunk = tokbase >> 7, tok0 = tokbase & 127;
        float x[8], mean[8], rstd[8]; ld8bf(gvT + (size_t)chunk * 65536 + c * 128 + tok0, x);
        ln_stats8((const float*)(ws + WS_LNSTAT) + (size_t)tokbase * 2, mean, rstd);
        const float lg = A.in[11][c], lb = A.in[12][c];
        float* o = samp ? A.out + O_SVS + (size_t)(grp * 8) * 512 + c : A.out + O_SVP + (size_t)((grp >> 4) * 128 + (grp & 15) * 8) * 512 + c;
#pragma unroll
        for (int e = 0; e < 8; ++e) { x[e] = (x[e] - mean[e]) * rstd[e] * lg + lb; o[e * 512] = x[e]; }
        if (samp) {
            const int g = c >> 7;
#pragma unroll
            for (int t = 0; t < 8; ++t) {
                float s = A.in[14][g * 128 + t];
#pragma unroll
                for (int e = 0; e <= t; ++e) s += A.in[13][(size_t)(g * 128 + t) * 128 + e] * x[e];
                const size_t tk = (size_t)tokbase + t; mb[tk * 512 + c] = (bf16_t)f2bf(bf1(ub[tk * 512 + c]) * s);
            }
        }
    }
}

DEV void topk_task(const KArgs& A, int task, LAS float* L  , int lane) {
    unsigned char* ws = A.ws;
    const int fr = lane & 15, quad = lane >> 4;
    const int tok0 = (task >> 3) * 16, h = task & 7;
    const bf16_t* pq = (const bf16_t*)(ws + WS_S1) + (size_t)(tok0 + fr) * 2048 + h * 256 + quad * 8;
    const bf16_t* SK = (const bf16_t*)(ws + WS_SK) + (size_t)(h * 2) * 16384 + (size_t)fr * 128 + quad * 8;
    int* pidx = (int*)(ws + WS_S5); float* pgate = (float*)(ws + WS_S5 + (size_t)T * 512);
    const float NINF = -__builtin_inff();
#pragma unroll
    for (int c = 0; c < 2; ++c) {
        bf16x8 qa[4];
#pragma unroll
        for (int ks = 0; ks < 4; ++ks) qa[ks] = *(const bf16x8*)(pq + c * 128 + ks * 32);
#pragma unroll
        for (int nt = 0; nt < 8; ++nt) {
            f32x4 z = {0.f, 0.f, 0.f, 0.f};
#pragma unroll
            for (int ks = 0; ks < 4; ++ks) z = mfma16(qa[ks], *(const bf16x8*)(SK + (size_t)c * 16384 + nt * 2048 + ks * 32), z);
#pragma unroll
            for (int reg = 0; reg < 4; ++reg)
            { const float zr = z[reg]; L[(c * 16 + quad * 4 + reg) * 128 + nt * 16 + fr] = __builtin_bit_cast(float, (__builtin_bit_cast(unsigned, zr) & ~0x7Fu) | (unsigned)(127 - (nt * 16 + fr))); }
        }
    }
    asm volatile("s_waitcnt lgkmcnt(0)" ::: "memory");
#pragma nounroll
    for (int it = 0; it < 4; ++it) {
        const int row = quad * 4 + it;
        float v[8], top0[16], t1 = 0.f;
#pragma unroll
        for (int nt = 0; nt < 8; ++nt) v[nt] = L[row * 128 + nt * 16 + fr];
#pragma unroll
        for (int rd = 0; rd < 16; ++rd) {
            float m = v[0];
#pragma unroll
            for (int nt = 1; nt < 8; ++nt) m = fmaxf(m, v[nt]);
            const float gm = rowmax16(m); top0[rd] = gm;
#pragma unroll
            for (int nt = 0; nt < 8; ++nt) if (v[nt] == gm) v[nt] = NINF;
        }
#pragma unroll
        for (int nt = 0; nt < 8; ++nt) v[nt] = L[(16 + row) * 128 + nt * 16 + fr];
#pragma unroll
        for (int rd = 0; rd < 16; ++rd) {
            float m = v[0];
#pragma unroll
            for (int nt = 1; nt < 8; ++nt) m = fmaxf(m, v[nt]);
            const float gm = rowmax16(m); if (fr == rd) t1 = gm;
#pragma unroll
            for (int nt = 0; nt < 8; ++nt) if (v[nt] == gm) v[nt] = NINF;
        }
        float cand[16];
#pragma unroll
        for (int i = 0; i < 16; ++i) cand[i] = __builtin_bit_cast(float, (__builtin_bit_cast(unsigned, top0[i] + t1) & ~0xFFu) | (unsigned)(255 - (i * 16 + fr)));
        const int i1 = 127 - (int)(__builtin_bit_cast(unsigned, t1) & 0x7Fu);
        float best = 0.f; int bidx = 0;
#pragma unroll
        for (int rd = 0; rd < 16; ++rd) {
            float m = cand[0];
#pragma unroll
            for (int i = 1; i < 16; ++i) m = fmaxf(m, cand[i]);
            const float gm = rowmax16(m);
            int mine = -1;
#pragma unroll
            for (int i = 0; i < 16; ++i) if (cand[i] == gm) { cand[i] = NINF; mine = (127 - (int)(__builtin_bit_cast(unsigned, top0[i]) & 0x7Fu)) * 128 + i1; }
            const int gi = rowmax16i(mine);
            if (fr == rd) { best = gm; bidx = gi; }
        }
        const float mx = rowmax16(best), e = __expf(best - mx), ssum = rowsum16(e);
        const size_t o = ((size_t)(tok0 + row) * 8 + h) * 16 + fr;
        pidx[o] = bidx; pgate[o] = e / ssum;
    }
    asm volatile("s_waitcnt lgkmcnt(0)" ::: "memory");
}

#define TK_CE(a, b) { const float hi_ = vmax(a, b), lo_ = vmin(a, b); a = hi_; b = lo_; }
DEV float select16(float (&s)[8], int fr) {
    TK_CE(s[0], s[1]) TK_CE(s[2], s[3]) TK_CE(s[4], s[5]) TK_CE(s[6], s[7])
    TK_CE(s[0], s[2]) TK_CE(s[1], s[3]) TK_CE(s[4], s[6]) TK_CE(s[5], s[7])
    TK_CE(s[1], s[2]) TK_CE(s[5], s[6])
    TK_CE(s[0], s[4]) TK_CE(s[1], s[5]) TK_CE(s[2], s[6]) TK_CE(s[3], s[7])
    TK_CE(s[2], s[4]) TK_CE(s[3], s[5])
    TK_CE(s[1], s[2]) TK_CE(s[3], s[4]) TK_CE(s[5], s[6])
    const float NINF = -__builtin_inff(); float mine = 0.f;
#pragma unroll
    for (int rd = 0; rd < 16; ++rd) {
        const float gm = rowmax16d(s[0]); const bool own = (s[0] == gm);
        mine = (fr == rd) ? gm : mine;
#pragma unroll
        for (int k = 0; k < 7; ++k) s[k] = own ? s[k + 1] : s[k];
        s[7] = own ? NINF : s[7];
    }
    return mine;
}
DEV void topk2_task(const KArgs& A, int task, LAS float* L  , int lane) {
    unsigned char* ws = A.ws;
    const int fr = lane & 15, quad = lane >> 4;
    const int tok0 = (task >> 3) * 16, h = task & 7;
    const bf16_t* pq = (const bf16_t*)(ws + WS_S1) + (size_t)(tok0 + fr) * 2048 + h * 256 + quad * 8;
    const bf16_t* SK = (const bf16_t*)(ws + WS_SK) + (size_t)(h * 2) * 16384 + (size_t)fr * 128 + quad * 8;
    int* pidx = (int*)(ws + WS_S5); float* pgate = (float*)(ws + WS_S5 + (size_t)T * 512);
    const float NINF = -__builtin_inff();
#pragma unroll
    for (int c = 0; c < 2; ++c) {
        bf16x8 qa[4];
#pragma unroll
        for (int ks = 0; ks < 4; ++ks) qa[ks] = *(const bf16x8*)(pq + c * 128 + ks * 32);
#pragma unroll
        for (int nt = 0; nt < 8; ++nt) {
            f32x4 z = {0.f, 0.f, 0.f, 0.f};
#pragma unroll
            for (int ks = 0; ks < 4; ++ks) z = mfma16(qa[ks], *(const bf16x8*)(SK + (size_t)c * 16384 + nt * 2048 + ks * 32), z);
#pragma unroll
            for (int reg = 0; reg < 4; ++reg)
            { const float zr = z[reg]; L[(c * 16 + quad * 4 + reg) * 128 + nt * 16 + fr] = __builtin_bit_cast(float, (__builtin_bit_cast(unsigned, zr) & ~0x7Fu) | (unsigned)(127 - (nt * 16 + fr))); }
        }
    }
    asm volatile("s_waitcnt lgkmcnt(0)" ::: "memory");
    const unsigned long long TI1 = 0xFEDCBA9811111111ull, TJ0 = 0xFEDCBA9876543210ull, TJ1 = 0x0000000076543210ull,
                             TI2 = 0x6655444333322222ull, TJ2 = 0x1010210321043210ull;
    const int sh = 4 * fr, rb = lane & 48;
    const int i_s[4] = {0, (int)(TI1 >> sh) & 15, (int)(TI2 >> sh) & 15, 7};
    const int j_s[4] = {(int)(TJ0 >> sh) & 15, (int)(TJ1 >> sh) & 15, (int)(TJ2 >> sh) & 15, fr & 1};
#pragma nounroll
    for (int it = 0; it < 4; ++it) {
        const int row = quad * 4 + it;
        float v[8];
#pragma unroll
        for (int nt = 0; nt < 8; ++nt) v[nt] = L[row * 128 + nt * 16 + fr];
        const float t0 = select16(v, fr);
#pragma unroll
        for (int nt = 0; nt < 8; ++nt) v[nt] = L[(16 + row) * 128 + nt * 16 + fr];
        const float t1 = select16(v, fr);
        float val[4], cur[4]; int idx[4], rec[4];
#pragma unroll
        for (int s4 = 0; s4 < 4; ++s4) {
            const float a = __builtin_bit_cast(float, __builtin_amdgcn_ds_bpermute((rb + i_s[s4]) * 4, __builtin_bit_cast(int, t0)));
            const float b = __builtin_bit_cast(float, __builtin_amdgcn_ds_bpermute((rb + j_s[s4]) * 4, __builtin_bit_cast(int, t1)));
            float sm = __builtin_bit_cast(float, (__builtin_bit_cast(unsigned, a + b) & ~0x3Fu) | (unsigned)(63 - (s4 * 16 + fr)));
            if (s4 == 3 && fr >= 2) sm = NINF;
            val[s4] = sm; cur[s4] = sm; rec[s4] = -1;
            idx[s4] = (127 - (int)(__builtin_bit_cast(unsigned, a) & 0x7Fu)) * 128 + (127 - (int)(__builtin_bit_cast(unsigned, b) & 0x7Fu));
        }
        float gmax = 0.f, ssum = 0.f;
#pragma unroll
        for (int rd = 0; rd < 16; ++rd) {
            const float gm = rowmax16d(vmax(vmax(cur[0], cur[1]), vmax(cur[2], cur[3])));
            if (rd == 0) gmax = gm;
            ssum += __expf(gm - gmax);
#pragma unroll
            for (int s4 = 0; s4 < 4; ++s4) { const bool own = (cur[s4] == gm); cur[s4] = own ? NINF : cur[s4]; rec[s4] = own ? rd : rec[s4]; }
        }
        const float inv = 1.f / ssum; const size_t ob = ((size_t)(tok0 + row) * 8 + h) * 16;
#pragma unroll
        for (int s4 = 0; s4 < 4; ++s4) if (rec[s4] >= 0) { pidx[ob + rec[s4]] = idx[s4]; pgate[ob + rec[s4]] = __expf(val[s4] - gmax) * inv; }
    }
    asm volatile("s_waitcnt lgkmcnt(0)" ::: "memory");
}

constexpr int TK_SKROW = 272, TK_SK_BYTES = 256 * TK_SKROW, TK_L_OFF = TK_SK_BYTES, TK_LT_OFF = TK_L_OFF + 8 * 8192, TK_LDS_END = TK_LT_OFF + 8 * 1024;
DEV void topk3_phase(const KArgs& A, LAS unsigned char* lds, int lane, int wave, int G) {
    unsigned char* ws = A.ws;
    const int fr = lane & 15, quad = lane >> 4, tid = wave * 64 + lane;
    const int h = blockIdx.x & 7, grp = blockIdx.x >> 3, ngrp = G >> 3;
    {
        const unsigned char* src = ws + WS_SK + (size_t)h * 65536;
#pragma unroll
        for (int i = 0; i < 8; ++i) { const int q = tid + 512 * i, row = q >> 4, c16 = q & 15; *(LAS u32x4*)(lds + row * TK_SKROW + c16 * 16) = *(const u32x4*)(src + (size_t)q * 16); }
        asm volatile("s_waitcnt vmcnt(0) lgkmcnt(0)" ::: "memory");
        __builtin_amdgcn_s_barrier();
        asm volatile("" ::: "memory");
    }
    LAS float* L = (LAS float*)(lds + TK_L_OFF + wave * 8192);
    LAS float* Lt = (LAS float*)(lds + TK_LT_OFF + wave * 1024);
    const LAS unsigned char* skb = lds + fr * TK_SKROW + quad * 16;
    int* pidx = (int*)(ws + WS_S5); float* pgate = (float*)(ws + WS_S5 + (size_t)T * 512);
    const float NINF = -__builtin_inff();
    const unsigned long long TI1 = 0xFEDCBA9811111111ull, TJ0 = 0xFEDCBA9876543210ull, TJ1 = 0x0000000076543210ull,
                             TI2 = 0x6655444333322222ull, TJ2 = 0x1010210321043210ull;
    const int sh = 4 * fr, rb = lane & 48;
    const int i_s[4] = {0, (int)(TI1 >> sh) & 15, (int)(TI2 >> sh) & 15, 7};
    const int j_s[4] = {(int)(TJ0 >> sh) & 15, (int)(TJ1 >> sh) & 15, (int)(TJ2 >> sh) & 15, fr & 1};
#pragma nounroll
    for (int tt = grp + ngrp * wave; tt < T / 16; tt += ngrp * 8) {
        const int tok0 = tt * 16;
        const bf16_t* pq = (const bf16_t*)(ws + WS_S1) + (size_t)(tok0 + fr) * 2048 + h * 256 + quad * 8;
        bf16x8 qa[2][4];
#pragma unroll
        for (int c = 0; c < 2; ++c)
#pragma unroll
            for (int ks = 0; ks < 4; ++ks) qa[c][ks] = *(const bf16x8*)(pq + c * 128 + ks * 32);
#pragma unroll
        for (int c = 0; c < 2; ++c) {
#pragma unroll
            for (int nt = 0; nt < 8; ++nt) {
                f32x4 z = {0.f, 0.f, 0.f, 0.f};
#pragma unroll
                for (int ks = 0; ks < 4; ++ks) z = mfma16(qa[c][ks], *(const LAS bf16x8*)(skb + (c * 128 + nt * 16) * TK_SKROW + ks * 64), z);
#pragma unroll
                for (int reg = 0; reg < 4; ++reg)
                { const float zr = z[reg]; L[(quad * 4 + reg) * 128 + nt * 16 + fr] = __builtin_bit_cast(float, (__builtin_bit_cast(unsigned, zr) & ~0x7Fu) | (unsigned)(127 - (nt * 16 + fr))); }
            }
            asm volatile("s_waitcnt lgkmcnt(0)" ::: "memory");
#pragma nounroll
            for (int it = 0; it < 4; ++it) {
                const int row = quad * 4 + it;
                float v[8];
#pragma unroll
                for (int nt = 0; nt < 8; ++nt) v[nt] = L[row * 128 + nt * 16 + fr];
                const float tc = select16(v, fr);
                if (c == 0) { Lt[row * 16 + fr] = tc; }
                else {
                    const float t1 = tc, t0 = Lt[row * 16 + fr];
                    float val[4], cur[4]; int idx[4], rec[4];
#pragma unroll
                    for (int s4 = 0; s4 < 4; ++s4) {
                        const float a = __builtin_bit_cast(float, __builtin_amdgcn_ds_bpermute((rb + i_s[s4]) * 4, __builtin_bit_cast(int, t0)));
                        const float b = __builtin_bit_cast(float, __builtin_amdgcn_ds_bpermute((rb + j_s[s4]) * 4, __builtin_bit_cast(int, t1)));
                        float sm = __builtin_bit_cast(float, (__builtin_bit_cast(unsigned, a + b) & ~0x3Fu) | (unsigned)(63 - (s4 * 16 + fr)));
                        if (s4 == 3 && fr >= 2) sm = NINF;
                        val[s4] = sm; cur[s4] = sm; rec[s4] = -1;
                        idx[s4] = (127 - (int)(__builtin_bit_cast(unsigned, a) & 0x7Fu)) * 128 + (127 - (int)(__builtin_bit_cast(unsigned, b) & 0x7Fu));
                    }
                    float gmax = 0.f, ssum = 0.f;
#pragma unroll
                    for (int rd = 0; rd < 16; ++rd) {
                        const float gm = rowmax16d(vmax(vmax(cur[0], cur[1]), vmax(cur[2], cur[3])));
                        if (rd == 0) gmax = gm;
                        ssum += __expf(gm - gmax);
#pragma unroll
                        for (int s4 = 0; s4 < 4; ++s4) { const bool own = (cur[s4] == gm); cur[s4] = own ? NINF : cur[s4]; rec[s4] = own ? rd : rec[s4]; }
                    }
                    const float inv = __builtin_amdgcn_rcpf(ssum); const size_t ob = ((size_t)(tok0 + row) * 8 + h) * 16;
#pragma unroll
                    for (int s4 = 0; s4 < 4; ++s4) if (rec[s4] >= 0) { pidx[ob + rec[s4]] = idx[s4]; pgate[ob + rec[s4]] = __expf(val[s4] - gmax) * inv; }
                }
            }
            asm volatile("s_waitcnt lgkmcnt(0)" ::: "memory");
        }
    }
}

DEV float wave_max(float v) {
#pragma unroll
    for (int o = 1; o < 64; o <<= 1) v = fmaxf(v, __shfl_xor(v, o));
    return v;
}
DEV void topk_ref_task(const KArgs& A, int task, LAS float* L  , int lane) {
    unsigned char* ws = A.ws;
    const int tok = task >> 3, h = task & 7;
    const bf16_t* pq = (const bf16_t*)(ws + WS_S1) + (size_t)tok * 2048 + h * 256;
    const bf16_t* SK = (const bf16_t*)(ws + WS_SK) + (size_t)(h * 2) * 16384;
    int* pidx = (int*)(ws + WS_S5); float* pgate = (float*)(ws + WS_S5 + (size_t)T * 512);
    const float NINF = -__builtin_inff();
    LAS float* qf = L;
    LAS float* tv = L + 256;
    LAS int* ti = (LAS int*)(L + 288);
    LAS float* bv = L + 320;
    LAS int* bi = (LAS int*)(L + 336);
    { const unsigned long long w = *(const unsigned long long*)(pq + lane * 4); const unsigned lo = (unsigned)w, hi = (unsigned)(w >> 32);
      qf[lane * 4] = bflo(lo); qf[lane * 4 + 1] = bfhi(lo); qf[lane * 4 + 2] = bflo(hi); qf[lane * 4 + 3] = bfhi(hi); }
    asm volatile("s_waitcnt lgkmcnt(0)" ::: "memory");
    float sc[4];
#pragma unroll
    for (int e = 0; e < 4; ++e) {
        const int p = lane + 64 * e, c = p >> 7, n = p & 127; const bf16_t* kr = SK + (size_t)(c * 128 + n) * 128; float s = 0.f;
#pragma nounroll
        for (int d = 0; d < 128; d += 8) { float kv[8]; ld8bf(kr + d, kv);
#pragma unroll
            for (int j = 0; j < 8; ++j) s += qf[c * 128 + d + j] * kv[j]; }
        sc[e] = s;
    }
#pragma unroll
    for (int c = 0; c < 2; ++c)
#pragma nounroll
        for (int rd = 0; rd < 16; ++rd) {
            const float m = wave_max(fmaxf(sc[2 * c], sc[2 * c + 1]));
            if (sc[2 * c] == m) { sc[2 * c] = NINF; tv[c * 16 + rd] = m; ti[c * 16 + rd] = (lane + 128 * c) & 127; }
            else if (sc[2 * c + 1] == m) { sc[2 * c + 1] = NINF; tv[c * 16 + rd] = m; ti[c * 16 + rd] = (lane + 64 + 128 * c) & 127; }
        }
    asm volatile("s_waitcnt lgkmcnt(0)" ::: "memory");
    float cd[4];
#pragma unroll
    for (int e = 0; e < 4; ++e) { const int p = lane * 4 + e; cd[e] = tv[p >> 4] + tv[16 + (p & 15)]; }
#pragma nounroll
    for (int rd = 0; rd < 16; ++rd) {
        const float m = wave_max(fmaxf(fmaxf(cd[0], cd[1]), fmaxf(cd[2], cd[3])));
        int pe = -1;
#pragma unroll
        for (int e = 3; e >= 0; --e) if (cd[e] == m) pe = e;
        if (pe >= 0) {
#pragma unroll
            for (int e = 0; e < 4; ++e) if (e == pe) cd[e] = NINF;
            const int p = lane * 4 + pe; bv[rd] = m; bi[rd] = ti[p >> 4] * 128 + ti[16 + (p & 15)];
        }
    }
    asm volatile("s_waitcnt lgkmcnt(0)" ::: "memory");
    if (lane < 16) {
        const float b = bv[lane], mx = bv[0]; const float e = __expf(b - mx); float ssum = rowsum16(e);
        const size_t o = ((size_t)tok * 8 + h) * 16 + lane; pidx[o] = bi[lane]; pgate[o] = e / ssum;
    }
    asm volatile("s_waitcnt lgkmcnt(0)" ::: "memory");
}

typedef float f32x2 __attribute__((ext_vector_type(2)));
DEV void cvt16(const u32x4 q, f32x2 (&f)[8]) {
    const int q0 = (int)q.x, q1 = (int)q.y, q2 = (int)q.z, q3 = (int)q.w;
    f[0] = __builtin_amdgcn_cvt_pk_f32_fp8(q0, false); f[1] = __builtin_amdgcn_cvt_pk_f32_fp8(q0, true);
    f[2] = __builtin_amdgcn_cvt_pk_f32_fp8(q1, false); f[3] = __builtin_amdgcn_cvt_pk_f32_fp8(q1, true);
    f[4] = __builtin_amdgcn_cvt_pk_f32_fp8(q2, false); f[5] = __builtin_amdgcn_cvt_pk_f32_fp8(q2, true);
    f[6] = __builtin_amdgcn_cvt_pk_f32_fp8(q3, false); f[7] = __builtin_amdgcn_cvt_pk_f32_fp8(q3, true);
}
DEV void peer_token(const KArgs& A, int tok, int lane) {
    unsigned char* ws = A.ws;
    float* x1 = A.out + (size_t)tok * 1024 + lane * 16;
    const unsigned char* PU = ws + WS_PU + lane * 16; const unsigned char* PV = ws + WS_PV + lane * 16;
    const int* pidx = (const int*)(ws + WS_S5); const float* pgate = (const float*)(ws + WS_S5 + (size_t)T * 512);
    const float rs = rsqrtf(((const float*)(ws + WS_SSQ2))[tok] * (1.f / 1024.f) + EPS);
    f32x2 xs[8];
    { float a[8], b[8], ga[8], gb[8]; ld8f(x1, a); ld8f(x1 + 8, b); ld8f(A.in[18] + lane * 16, ga); ld8f(A.in[18] + lane * 16 + 8, gb);
#pragma unroll
      for (int i = 0; i < 4; ++i) { xs[i] = (f32x2){a[2 * i] * rs * ga[2 * i], a[2 * i + 1] * rs * ga[2 * i + 1]}; xs[4 + i] = (f32x2){b[2 * i] * rs * gb[2 * i], b[2 * i + 1] * rs * gb[2 * i + 1]}; } }
    f32x2 o[8];
#pragma unroll
    for (int i = 0; i < 8; ++i) o[i] = (f32x2){0.f, 0.f};
    const int* pi = pidx + (size_t)tok * 128 + (lane >> 2); const float* pg = pgate + (size_t)tok * 128 + (lane >> 2);
    int eidx = pi[0];
    u32x4 uq[16];
#pragma unroll
    for (int k = 0; k < 16; ++k) { const int row = __builtin_amdgcn_readlane(eidx, 4 * k); uq[k] = *(const u32x4*)(PU + (size_t)row * 1024); }
#pragma nounroll
    for (int h = 0; h < 8; ++h) {
        const float gt = pg[h * 16];
        const int enext = pi[(h < 7 ? h + 1 : 7) * 16];
        u32x4 vq[16];
#pragma unroll
        for (int k = 0; k < 16; ++k) { const int row = __builtin_amdgcn_readlane(eidx, 4 * k); vq[k] = *(const u32x4*)(PV + (size_t)row * 1024); }
        float part[16];
#pragma unroll
        for (int k = 0; k < 16; ++k) { f32x2 f[8]; cvt16(uq[k], f); f32x2 acc = f[0] * xs[0];
#pragma unroll
            for (int i = 1; i < 8; ++i) acc += f[i] * xs[i];
            part[k] = acc.x + acc.y; }
        eidx = enext;
#pragma unroll
        for (int k = 0; k < 16; ++k) { const int row = __builtin_amdgcn_readlane(eidx, 4 * k); uq[k] = *(const u32x4*)(PU + (size_t)row * 1024); }
        float r8[8], r4[4], r2[2];
        const bool b5 = lane & 32, b4 = lane & 16, b3 = lane & 8, b2 = lane & 4;
#pragma unroll
        for (int i = 0; i < 8; ++i) { const float keep = b5 ? part[i + 8] : part[i], send = b5 ? part[i] : part[i + 8]; r8[i] = keep + __shfl_xor(send, 32); }
#pragma unroll
        for (int i = 0; i < 4; ++i) { const float keep = b4 ? r8[i + 4] : r8[i], send = b4 ? r8[i] : r8[i + 4]; r4[i] = keep + __shfl_xor(send, 16); }
#pragma unroll
        for (int i = 0; i < 2; ++i) { const float keep = b3 ? r4[i + 2] : r4[i], send = b3 ? r4[i] : r4[i + 2]; r2[i] = keep + __shfl_xor(send, 8); }
        float act = (b2 ? r2[1] : r2[0]) + __shfl_xor(b2 ? r2[0] : r2[1], 4);
        act += __shfl_xor(act, 2); act += __shfl_xor(act, 1);
        const float w = gt * gelu_t(act * (1.f / 256.f)) * (1.f / 64.f);
#pragma unroll
        for (int k = 0; k < 16; ++k) { const float wk = __builtin_bit_cast(float, __builtin_amdgcn_readlane(__builtin_bit_cast(int, w), 4 * k)); const f32x2 w2 = {wk, wk}; f32x2 f[8]; cvt16(vq[k], f);
#pragma unroll
            for (int i = 0; i < 8; ++i) o[i] += w2 * f[i]; }
    }
    float a[8], b[8]; ld8f(x1, a); ld8f(x1 + 8, b);
    float ss = 0.f;
#pragma unroll
    for (int i = 0; i < 4; ++i) { a[2 * i] += o[i].x; a[2 * i + 1] += o[i].y; b[2 * i] += o[4 + i].x; b[2 * i + 1] += o[4 + i].y; }
#pragma unroll
    for (int i = 0; i < 8; ++i) ss += a[i] * a[i] + b[i] * b[i];
    st8f(x1, a); st8f(x1 + 8, b);
    bf16_t* x2b = (bf16_t*)(ws + WS_S2) + (size_t)tok * 1024 + lane * 16;
    st8bf(x2b, a); st8bf(x2b + 8, b);
    ss = wave_sum(ss);
    if (lane == 0) ((float*)(ws + WS_RSTD3))[tok] = rsqrtf(ss * (1.f / 1024.f) + EPS);
}

DEV void cvt32(const u32x4 q, f32x2 (&f)[16]) {
    const unsigned q0 = q.x, q1 = q.y, q2 = q.z, q3 = q.w;
    f[0] = __builtin_amdgcn_cvt_scalef32_pk_f32_fp4(q0, 1.0f, 0); f[1] = __builtin_amdgcn_cvt_scalef32_pk_f32_fp4(q0, 1.0f, 1); f[2] = __builtin_amdgcn_cvt_scalef32_pk_f32_fp4(q0, 1.0f, 2); f[3] = __builtin_amdgcn_cvt_scalef32_pk_f32_fp4(q0, 1.0f, 3);
    f[4] = __builtin_amdgcn_cvt_scalef32_pk_f32_fp4(q1, 1.0f, 0); f[5] = __builtin_amdgcn_cvt_scalef32_pk_f32_fp4(q1, 1.0f, 1); f[6] = __builtin_amdgcn_cvt_scalef32_pk_f32_fp4(q1, 1.0f, 2); f[7] = __builtin_amdgcn_cvt_scalef32_pk_f32_fp4(q1, 1.0f, 3);
    f[8] = __builtin_amdgcn_cvt_scalef32_pk_f32_fp4(q2, 1.0f, 0); f[9] = __builtin_amdgcn_cvt_scalef32_pk_f32_fp4(q2, 1.0f, 1); f[10] = __builtin_amdgcn_cvt_scalef32_pk_f32_fp4(q2, 1.0f, 2); f[11] = __builtin_amdgcn_cvt_scalef32_pk_f32_fp4(q2, 1.0f, 3);
    f[12] = __builtin_amdgcn_cvt_scalef32_pk_f32_fp4(q3, 1.0f, 0); f[13] = __builtin_amdgcn_cvt_scalef32_pk_f32_fp4(q3, 1.0f, 1); f[14] = __builtin_amdgcn_cvt_scalef32_pk_f32_fp4(q3, 1.0f, 2); f[15] = __builtin_amdgcn_cvt_scalef32_pk_f32_fp4(q3, 1.0f, 3);
}
DEV void peer_token4(const KArgs& A, int tok, int lane) {
    unsigned char* ws = A.ws;
    const int half = lane >> 5, sub = lane & 31;
    const bf16_t* x1 = (const bf16_t*)(ws + WS_S3) + (size_t)tok * 1024 + sub * 32;
    const unsigned char* PU = ws + WS_PU + sub * 16; const unsigned char* PV = ws + WS_PV + sub * 16;
    const int e_l = (half << 3) | ((lane >> 2) & 7);
    const int* pi = (const int*)(ws + WS_S5) + (size_t)tok * 128 + e_l; const float* pg = (const float*)(ws + WS_S5 + (size_t)T * 512) + (size_t)tok * 128 + e_l;
    const float rs = rsqrtf(((const float*)(ws + WS_SSQ2))[tok] * (1.f / 1024.f) + EPS);
    f32x2 xs[16];
#pragma unroll
    for (int j = 0; j < 4; ++j) { float a[8], g[8]; ld8bf(x1 + 8 * j, a); ld8f(A.in[18] + sub * 32 + 8 * j, g);
#pragma unroll
        for (int i = 0; i < 4; ++i) xs[4 * j + i] = (f32x2){a[2 * i] * rs * g[2 * i], a[2 * i + 1] * rs * g[2 * i + 1]}; }
    f32x2 o[16];
#pragma unroll
    for (int i = 0; i < 16; ++i) o[i] = (f32x2){0.f, 0.f};
    const bool b4 = lane & 16, b3 = lane & 8, b2 = lane & 4;
#pragma nounroll
    for (int h = 0; h < 8; ++h) {
        const int eidx = pi[h * 16]; const float gt = pg[h * 16];
        float part[8];
        {
            u32x4 uq[8];
#pragma unroll
            for (int k = 0; k < 8; ++k) { const int r0 = __builtin_amdgcn_readlane(eidx, 4 * k), r1 = __builtin_amdgcn_readlane(eidx, 32 + 4 * k); uq[k] = *(const u32x4*)(PU + (size_t)(half ? r1 : r0) * 512); }
#pragma unroll
            for (int k = 0; k < 8; ++k) { f32x2 f[16]; cvt32(uq[k], f); f32x2 acc = f[0] * xs[0];
#pragma unroll
                for (int i = 1; i < 16; ++i) acc += f[i] * xs[i];
                part[k] = acc.x + acc.y; }
        }
        float r4[4], r2[2];
#pragma unroll
        for (int i = 0; i < 4; ++i) { const float keep = b4 ? part[i + 4] : part[i], send = b4 ? part[i] : part[i + 4]; r4[i] = keep + __shfl_xor(send, 16); }
#pragma unroll
        for (int i = 0; i < 2; ++i) { const float keep = b3 ? r4[i + 2] : r4[i], send = b3 ? r4[i] : r4[i + 2]; r2[i] = keep + __shfl_xor(send, 8); }
        float act = (b2 ? r2[1] : r2[0]) + __shfl_xor(b2 ? r2[0] : r2[1], 4);
        act += __shfl_xor(act, 2); act += __shfl_xor(act, 1);
        const float w = gt * gelu_t(act * (1.f / PEER_SU)) * (1.f / PEER_SV);
        {
            u32x4 vq[8];
#pragma unroll
            for (int k = 0; k < 8; ++k) { const int r0 = __builtin_amdgcn_readlane(eidx, 4 * k), r1 = __builtin_amdgcn_readlane(eidx, 32 + 4 * k); vq[k] = *(const u32x4*)(PV + (size_t)(half ? r1 : r0) * 512); }
#pragma unroll
            for (int k = 0; k < 8; ++k) {
                const float w0 = __builtin_bit_cast(float, __builtin_amdgcn_readlane(__builtin_bit_cast(int, w), 4 * k)), w1 = __builtin_bit_cast(float, __builtin_amdgcn_readlane(__builtin_bit_cast(int, w), 32 + 4 * k));
                const float wk = half ? w1 : w0; const f32x2 w2 = {wk, wk}; f32x2 f[16]; cvt32(vq[k], f);
#pragma unroll
                for (int i = 0; i < 16; ++i) o[i] += w2 * f[i]; }
        }
    }
    float a[8], b[8];
#pragma unroll
    for (int i = 0; i < 8; ++i) {
        const float lo0 = o[i].x + __shfl_xor(o[i].x, 32), lo1 = o[i].y + __shfl_xor(o[i].y, 32), hi0 = o[8 + i].x + __shfl_xor(o[8 + i].x, 32), hi1 = o[8 + i].y + __shfl_xor(o[8 + i].y, 32);
        const float e0 = half ? hi0 : lo0, e1 = half ? hi1 : lo1;
        if (i < 4) { a[2 * i] = e0; a[2 * i + 1] = e1; } else { b[2 * (i - 4)] = e0; b[2 * (i - 4) + 1] = e1; }
    }
    float xa[8], xb[8]; ld8bf(x1 + half * 16, xa); ld8bf(x1 + half * 16 + 8, xb);
    float ss = 0.f;
#pragma unroll
    for (int i = 0; i < 8; ++i) { a[i] += xa[i]; b[i] += xb[i]; ss += a[i] * a[i] + b[i] * b[i]; }
    bf16_t* x2b = (bf16_t*)(ws + WS_S2) + (size_t)tok * 1024 + sub * 32 + half * 16;
    st8bf(x2b, a); st8bf(x2b + 8, b);
    ss = wave_sum(ss);
    if (lane == 0) ((float*)(ws + WS_RSTD3))[tok] = rsqrtf(ss * (1.f / 1024.f) + EPS);
}

typedef int v8i_t __attribute__((ext_vector_type(8)));
DEV unsigned pk4_e4m3(float a, float b, float c, float d) { int p = __builtin_amdgcn_cvt_pk_fp8_f32(a, b, 0, false); p = __builtin_amdgcn_cvt_pk_fp8_f32(c, d, p, true); return (unsigned)p; }
DEV void peer_token5(const KArgs& A, int tok, int lane, LAS unsigned char* xq  , const int h0, const int h1, LAS float* xsend, const LAS float* xrecv, const bool do_bar) {
    unsigned char* ws = A.ws;
    const int fr = lane & 15, quad = lane >> 4, half = lane >> 5, sub = lane & 31;
    const bf16_t* x1 = (const bf16_t*)(ws + WS_S3) + (size_t)tok * 1024;
    const unsigned char* PU = ws + WS_PU + quad * 16; const unsigned char* PV = ws + WS_PV + sub * 16;
    const int* pi = (const int*)(ws + WS_S5) + (size_t)tok * 128 + fr; const float* pg = (const float*)(ws + WS_S5 + (size_t)T * 512) + (size_t)tok * 128 + quad * 4;
    const float rs = rsqrtf(((const float*)(ws + WS_SSQ2))[tok] * (1.f / 1024.f) + EPS);
    {
        float a[8], b[8], ga[8], gb[8]; ld8bf(x1 + lane * 16, a); ld8bf(x1 + lane * 16 + 8, b); ld8f(A.in[18] + lane * 16, ga); ld8f(A.in[18] + lane * 16 + 8, gb);
#pragma unroll
        for (int i = 0; i < 8; ++i) { a[i] *= rs * ga[i]; b[i] *= rs * gb[i]; }
        const unsigned h0 = pk8_fp4(a, 1.f), h1 = pk8_fp4(b, 1.f);
        float ra[8], rb[8];
#define XRES(i) { const f32x2 d0 = __builtin_amdgcn_cvt_scalef32_pk_f32_fp4(h0, 1.0f, i), d1 = __builtin_amdgcn_cvt_scalef32_pk_f32_fp4(h1, 1.0f, i); \
            ra[2 * i] = a[2 * i] - d0.x; ra[2 * i + 1] = a[2 * i + 1] - d0.y; rb[2 * i] = b[2 * i] - d1.x; rb[2 * i + 1] = b[2 * i + 1] - d1.y; }
        XRES(0) XRES(1) XRES(2) XRES(3)
#undef XRES
        const unsigned l0 = pk8_fp4(ra, 8.f), l1 = pk8_fp4(rb, 8.f);
        *(LAS u32x2*)(xq + lane * 8) = (u32x2){h0, h1};
        *(LAS u32x2*)(xq + 512 + lane * 8) = (u32x2){l0, l1};
    }
    asm volatile("s_waitcnt lgkmcnt(0)" ::: "memory");
    u32x4 xh[8], xl[8];
#pragma unroll
    for (int ks = 0; ks < 8; ++ks) { xh[ks] = *(const LAS u32x4*)(xq + ks * 64 + quad * 16); xl[ks] = *(const LAS u32x4*)(xq + 512 + ks * 64 + quad * 16); }
    f32x2 o[16];
#pragma unroll
    for (int i = 0; i < 16; ++i) o[i] = (f32x2){0.f, 0.f};
    int idx_l = pi[h0 * 16]; f32x4 gt4 = *(const f32x4*)(pg + h0 * 16);
    u32x4 ua[8];
#pragma unroll
    for (int ks = 0; ks < 8; ++ks) ua[ks] = *(const u32x4*)(PU + (size_t)idx_l * 512 + ks * 64);
#pragma nounroll
    for (int h = h0; h < h1; ++h) {
        const int hn = h < h1 - 1 ? h + 1 : h1 - 1;
        const int idx_n = pi[hn * 16]; const f32x4 gt_n = *(const f32x4*)(pg + hn * 16);
        u32x4 vq[8];
#pragma unroll
        for (int k = 0; k < 8; ++k) { const int r0 = __builtin_amdgcn_readlane(idx_l, k), r1 = __builtin_amdgcn_readlane(idx_l, k + 8); vq[k] = *(const u32x4*)(PV + (size_t)(half ? r1 : r0) * 512); }
        f32x4 c = {0.f, 0.f, 0.f, 0.f};
#pragma unroll
        for (int ks = 0; ks < 8; ++ks) { const u32x4 u = ua[ks], bh = xh[ks], bl = xl[ks];
            const v8i_t av = {(int)u.x, (int)u.y, (int)u.z, (int)u.w, 0, 0, 0, 0}, bhv = {(int)bh.x, (int)bh.y, (int)bh.z, (int)bh.w, 0, 0, 0, 0}, blv = {(int)bl.x, (int)bl.y, (int)bl.z, (int)bl.w, 0, 0, 0, 0};
            c = __builtin_amdgcn_mfma_scale_f32_16x16x128_f8f6f4(av, bhv, c, 4, 4, 0, 0x7F7F7F7F, 0, 0x7F7F7F7F);
            c = __builtin_amdgcn_mfma_scale_f32_16x16x128_f8f6f4(av, blv, c, 4, 4, 0, 0x7F7F7F7F, 0, 0x7C7C7C7C); }
#pragma unroll
        for (int ks = 0; ks < 8; ++ks) ua[ks] = *(const u32x4*)(PU + (size_t)idx_n * 512 + ks * 64);
        float w[4];
        { const float c0 = c[0], c1 = c[1], c2 = c[2], c3 = c[3], g0 = gt4[0], g1 = gt4[1], g2 = gt4[2], g3 = gt4[3];
          w[0] = g0 * gelu_t(c0 * (1.f / PEER_SU)) * (1.f / PEER_SV); w[1] = g1 * gelu_t(c1 * (1.f / PEER_SU)) * (1.f / PEER_SV);
          w[2] = g2 * gelu_t(c2 * (1.f / PEER_SU)) * (1.f / PEER_SV); w[3] = g3 * gelu_t(c3 * (1.f / PEER_SU)) * (1.f / PEER_SV); }
#pragma unroll
        for (int k = 0; k < 8; ++k) {
            const float w0 = __builtin_bit_cast(float, __builtin_amdgcn_readlane(__builtin_bit_cast(int, w[k & 3]), 16 * (k >> 2))), w1 = __builtin_bit_cast(float, __builtin_amdgcn_readlane(__builtin_bit_cast(int, w[k & 3]), 16 * ((k + 8) >> 2)));
            const float wk = half ? w1 : w0; const f32x2 w2 = {wk, wk}; f32x2 f[16]; cvt32(vq[k], f);
#pragma unroll
            for (int i = 0; i < 16; ++i) o[i] += w2 * f[i]; }
        idx_l = idx_n; gt4 = gt_n;
    }
    float a[8], b[8];
#pragma unroll
    for (int i = 0; i < 8; ++i) {
        const float lo0 = o[i].x + __shfl_xor(o[i].x, 32), lo1 = o[i].y + __shfl_xor(o[i].y, 32), hi0 = o[8 + i].x + __shfl_xor(o[8 + i].x, 32), hi1 = o[8 + i].y + __shfl_xor(o[8 + i].y, 32);
        const float e0 = half ? hi0 : lo0, e1 = half ? hi1 : lo1;
        if (i < 4) { a[2 * i] = e0; a[2 * i + 1] = e1; } else { b[2 * (i - 4)] = e0; b[2 * (i - 4) + 1] = e1; }
    }
    if (xsend) { *(LAS f32x4*)(xsend + lane * 16) = (f32x4){a[0], a[1], a[2], a[3]}; *(LAS f32x4*)(xsend + lane * 16 + 4) = (f32x4){a[4], a[5], a[6], a[7]};
                 *(LAS f32x4*)(xsend + lane * 16 + 8) = (f32x4){b[0], b[1], b[2], b[3]}; *(LAS f32x4*)(xsend + lane * 16 + 12) = (f32x4){b[4], b[5], b[6], b[7]}; }
    if (do_bar) { asm volatile("s_waitcnt lgkmcnt(0)" ::: "memory"); __builtin_amdgcn_s_barrier(); asm volatile("" ::: "memory"); }
    if (xsend) return;
    if (xrecv) { const f32x4 r0 = *(const LAS f32x4*)(xrecv + lane * 16), r1 = *(const LAS f32x4*)(xrecv + lane * 16 + 4), r2 = *(const LAS f32x4*)(xrecv + lane * 16 + 8), r3 = *(const LAS f32x4*)(xrecv + lane * 16 + 12);
        a[0] += r0.x; a[1] += r0.y; a[2] += r0.z; a[3] += r0.w; a[4] += r1.x; a[5] += r1.y; a[6] += r1.z; a[7] += r1.w;
        b[0] += r2.x; b[1] += r2.y; b[2] += r2.z; b[3] += r2.w; b[4] += r3.x; b[5] += r3.y; b[6] += r3.z; b[7] += r3.w; }
    float xa[8], xb[8]; ld8bf(x1 + sub * 32 + half * 16, xa); ld8bf(x1 + sub * 32 + half * 16 + 8, xb);
    float ss = 0.f;
#pragma unroll
    for (int i = 0; i < 8; ++i) { a[i] += xa[i]; b[i] += xb[i]; ss += a[i] * a[i] + b[i] * b[i]; }
    bf16_t* x2b = (bf16_t*)(ws + WS_S2) + (size_t)tok * 1024 + sub * 32 + half * 16;
    st8bf(x2b, a); st8bf(x2b + 8, b);
    ss = wave_sum(ss);
    if (lane == 0) ((float*)(ws + WS_RSTD3))[tok] = rsqrtf(ss * (1.f / 1024.f) + EPS);
}

DEV int lane_id_asm() { int l; asm volatile("v_mbcnt_lo_u32_b32 %0, -1, 0\n\tv_mbcnt_hi_u32_b32 %0, -1, %0" : "=v"(l)); return l; }
DEV void grid_bar(unsigned* ctr, unsigned target, bool leader) {
    asm volatile("s_waitcnt vmcnt(0) lgkmcnt(0)" ::: "memory");
    __builtin_amdgcn_s_barrier();
    if (leader) {
        __builtin_amdgcn_fence(__ATOMIC_RELEASE, "agent");
        asm volatile("s_waitcnt vmcnt(0)" ::: "memory");
        (void)__hip_atomic_fetch_add(ctr, 1u, __ATOMIC_RELAXED, __HIP_MEMORY_SCOPE_AGENT);
        while (__hip_atomic_load(ctr, __ATOMIC_RELAXED, __HIP_MEMORY_SCOPE_AGENT) < target) __builtin_amdgcn_s_sleep(2);
        __builtin_amdgcn_fence(__ATOMIC_ACQUIRE, "agent");
        asm volatile("s_waitcnt vmcnt(0)" ::: "memory");
    }
    __builtin_amdgcn_s_barrier();
}
#define XB_TMO      128
#define XB_XCNT(j)  (256  + 64 * (j))
#define XB_XSUB(j)  (1280 + 64 * (j))
#define XB_XGEN(j)  (2304 + 64 * (j))
#define XB_TOP      3328
#define XB_TOPGEN   3392
#define XCD_BAR_WORDS 3456
#define XB_SPIN_CAP (1u << 20)
DEV unsigned xb_ld(unsigned* p)              { return __hip_atomic_load(p, __ATOMIC_RELAXED, __HIP_MEMORY_SCOPE_AGENT); }
DEV unsigned xb_add(unsigned* p, unsigned v) { return __hip_atomic_fetch_add(p, v, __ATOMIC_RELAXED, __HIP_MEMORY_SCOPE_AGENT); }
DEV unsigned xb_xcc_id() { return (unsigned)__builtin_amdgcn_s_getreg((3 << 11) | 20) & 0xFu; }
#define XB_SPIN(cond, bar) do { unsigned _sp = 0; while (cond) { __builtin_amdgcn_s_sleep(1); \
    if ((++_sp & 255u) == 0u) { if (xb_ld(&(bar)[XB_TMO])) break; if (_sp > XB_SPIN_CAP) { (void)xb_add(&(bar)[XB_TMO], 1u); break; } } } } while (0)
DEV void xcd_bar(unsigned* bar, volatile LAS unsigned* st, bool leader, unsigned G) {
    asm volatile("s_waitcnt vmcnt(0) lgkmcnt(0)" ::: "memory");
    __builtin_amdgcn_s_barrier();
    if (leader) {
        const unsigned x = xb_xcc_id();
        unsigned nloc = st[0], nx = st[1];
        if (nloc == 0u) {
            unsigned sum = 0u, cnt = 0u, mine = 0u, sp = 0u;
            for (;;) { sum = 0u; cnt = 0u; mine = 0u;
#pragma unroll
                for (unsigned j = 0; j < 16; ++j) { const unsigned c = xb_ld(&bar[XB_XCNT(j)]); sum += c; cnt += (c > 0u) ? 1u : 0u; mine = (j == x) ? c : mine; }
                if (sum == G) break;
                __builtin_amdgcn_s_sleep(1);
                if ((++sp & 255u) == 0u) { if (xb_ld(&bar[XB_TMO])) break; if (sp > XB_SPIN_CAP) { (void)xb_add(&bar[XB_TMO], 1u); break; } } }
            nloc = mine > 0u ? mine : 1u; nx = cnt > 0u ? cnt : 1u; st[0] = nloc; st[1] = nx;
        }
        const unsigned old = xb_add(&bar[XB_XSUB(x)], 1u), gen = old / nloc;
        if (old + 1u == (gen + 1u) * nloc) {
            __builtin_amdgcn_fence(__ATOMIC_RELEASE, "agent");
            asm volatile("s_waitcnt vmcnt(0)" ::: "memory");
            const unsigned og = xb_add(&bar[XB_TOP], 1u), tg = og / nx;
            if (og + 1u == (tg + 1u) * nx) (void)xb_add(&bar[XB_TOPGEN], 1u);
            else XB_SPIN(xb_ld(&bar[XB_TOPGEN]) == tg, bar);
            __builtin_amdgcn_fence(__ATOMIC_ACQUIRE, "agent");
            (void)xb_add(&bar[XB_XGEN(x)], 1u);
            asm volatile("s_waitcnt vmcnt(0)" ::: "memory");
        } else {
            XB_SPIN(xb_ld(&bar[XB_XGEN(x)]) == gen, bar);
            __builtin_amdgcn_fence(__ATOMIC_ACQUIRE, "agent");
            asm volatile("s_waitcnt vmcnt(0)" ::: "memory");
        }
    }
    __builtin_amdgcn_s_barrier();
    asm volatile("" ::: "memory");
}
typedef const KArgs __attribute__((address_space(4))) CKArgs;
DEV KArgs fresh_args() {
#if defined(__HIP_DEVICE_COMPILE__)
    CKArgs* p = (CKArgs*)__builtin_amdgcn_kernarg_segment_ptr(); asm volatile("" : "+s"(p)); KArgs r;
#pragma unroll
    for (int i = 0; i < 26; ++i) r.in[i] = p->in[i];
    r.out = p->out; r.ws = p->ws; return r;
#else
    return KArgs{};
#endif
}
__global__ void __launch_bounds__(512, 2) mega(KArgs Akern) {
    extern __shared__ __attribute__((aligned(16))) unsigned char lds_raw[];
    LAS unsigned char* lds = (LAS unsigned char*)lds_raw;
    cg::grid_group grid = cg::this_grid();
    (void)Akern;
    const int G = gridDim.x;
    const int wave_s = __builtin_amdgcn_readfirstlane((int)threadIdx.x >> 6);
    unsigned* bar_ctr;
    volatile LAS unsigned* bar_st = (volatile LAS unsigned*)(lds + LDS_BYTES - 64);
    { const KArgs A0 = fresh_args(); bar_ctr = (unsigned*)(A0.ws + WS_BAR);
      if (blockIdx.x == 0) for (int i = threadIdx.x; i < XCD_BAR_WORDS; i += 512) __hip_atomic_store(bar_ctr + i, 0u, __ATOMIC_RELAXED, __HIP_MEMORY_SCOPE_AGENT);
      if (threadIdx.x == 0) { bar_st[0] = 0u; bar_st[1] = 0u; } }
    grid.sync();
    if (threadIdx.x == 0) (void)xb_add(&bar_ctr[XB_XCNT(xb_xcc_id())], 1u);
#define GRID_SYNC() xcd_bar(bar_ctr, bar_st, wave_s == 0 && lane_id_asm() == 0, (unsigned)G)
#define FRESH_IDS const int lane = lane_id_asm(), wave = wave_s, tid_ = wave * 64 + lane, \
        gw = blockIdx.x * 8 + wave, NGW = G * 8, gtid = blockIdx.x * 512 + tid_, NT = G * 512; const KArgs A = fresh_args(); (void)lane; (void)wave; (void)gw; (void)NGW; (void)gtid; (void)NT
#ifndef GEMM_STAGGER_N
#define GEMM_STAGGER_N 0
#endif
#define GEMM_STAGGER() do { if (GEMM_STAGGER_N > 0 && (blockIdx.x & 1)) { for (int s_ = 0; s_ < GEMM_STAGGER_N; ++s_) __builtin_amdgcn_s_sleep(127); } } while (0)
#ifndef GEMM_ALIGN_EPI
#define GEMM_ALIGN_EPI true
#endif
#define RUN_GEMM(MODE, APTR, BPTR, NN, KK) RUN_GEMM_ON(MODE, APTR, BPTR, NN, KK, G, (int)blockIdx.x)
#define RUN_GEMM_ON(MODE, APTR, BPTR, NN, KK, SG, SC) do { const KArgs A = fresh_args(); unsigned char* ws = A.ws; pg8::Gemm g; g.A = (const bf16_t*)(APTR); g.Bt = (const bf16_t*)(BPTR); g.M = T; g.N = NN; { int kk_ = KK; asm volatile("" : "+s"(kk_)); g.K = kk_; } \
        Epi<MODE> E; E.xp = A.in[0]; E.xs = A.in[1]; E.out = A.out; E.ws = ws; pg8::StaticOrder S; S.init(T, NN, SG, SC); \
        GEMM_STAGGER(); pg8::gemm_phase<Epi<MODE>, pg8::StaticOrder, GEMM_ALIGN_EPI, true>(lds, g, S, E, wave_s); } while (0)
#ifndef SKIP_P0
#ifndef REP_P0
#define REP_P0 1
#endif
#pragma nounroll
    for (int rep = 0; rep < REP_P0; ++rep) { FRESH_IDS; p0_phase(A, lds, lane, wave, gw, NGW, gtid, NT, 0); }
#endif
#ifdef XBAR
    for (int xb = 0; xb < XBAR; ++xb) GRID_SYNC();
#endif
    GRID_SYNC();
#ifndef SKIP_G1
    RUN_GEMM(1, A.out, ws + WS_WIN, 3840, 1024);
#endif
    if (G > 188 && (int)blockIdx.x >= 188) { FRESH_IDS; p0_phase(A, lds, lane, wave, gw - 188 * 8, NGW - 188 * 8, gtid - 188 * 512, NT - 188 * 512, 1); }
    else if (G <= 188) { FRESH_IDS; p0_phase(A, lds, lane, wave, gw, NGW, gtid, NT, 1); }
    GRID_SYNC();
#ifndef SKIP_P2
#ifndef REP_P2
#define REP_P2 1
#endif
#pragma nounroll
    for (int rep = 0; rep < REP_P2; ++rep) { FRESH_IDS; p2_phase(A, gtid, NT); }
#endif
    GRID_SYNC();
#ifndef REP_P3
#define REP_P3 1
#endif
#pragma nounroll
    for (int rep = 0; rep < REP_P3; ++rep) {
        FRESH_IDS;
        LAS bf16_t* P = (LAS bf16_t*)(lds + wave * 5440);
#ifndef SKIP_ATT
        for (int t = gw; t < 16384; t += NGW) attn_task<false>(A, t, P, lane);
        for (int t = gw; t < 512; t += NGW) attn_task<true>(A, t, P, lane);
#endif
#ifndef SKIP_SGU
        for (int t = gw; t < 8192; t += NGW) sgu_task(A, t, lane);
        sgu_small(A, gtid, NT);
#endif
    }
    GRID_SYNC();
#ifndef REP_G4
#define REP_G4 1
#endif
#pragma nounroll
    for (int rep4 = 0; rep4 < REP_G4; ++rep4) {
#ifndef SKIP_G2
    RUN_GEMM(2, ws + WS_S2, ws + WS_WA, 1024, 512);
#endif
#ifndef SKIP_G3
    RUN_GEMM(3, ws + WS_S2 + (size_t)T * 1024, ws + WS_WB, 1024, 512);
#endif
    }
    if (G > 16 && (int)blockIdx.x >= 16) { FRESH_IDS; cvt_fp4(A.in[21], A.ws + WS_PU, 2097152, PEER_SU, gtid - 16 * 512, NT - 16 * 512); p0_phase(A, lds, lane, wave, gw - 16 * 8, NGW - 16 * 8, gtid - 16 * 512, NT - 16 * 512, 2); }
    else if (G <= 16) { FRESH_IDS; cvt_fp4(A.in[21], A.ws + WS_PU, 2097152, PEER_SU, gtid, NT); p0_phase(A, lds, lane, wave, gw, NGW, gtid, NT, 2); }
    GRID_SYNC();
#ifndef SKIP_G4
    RUN_GEMM(4, ws + WS_S4, ws + WS_WOUT, 1024, 1024);
#endif
    if (G > 16 && (int)blockIdx.x >= 16) { FRESH_IDS; cvt_fp4(A.in[22], A.ws + WS_PV, 2097152, PEER_SV, gtid - 16 * 512, NT - 16 * 512); p0_phase(A, lds, lane, wave, gw - 16 * 8, NGW - 16 * 8, gtid - 16 * 512, NT - 16 * 512, 3); }
    else if (G <= 16) { FRESH_IDS; cvt_fp4(A.in[22], A.ws + WS_PV, 2097152, PEER_SV, gtid, NT); p0_phase(A, lds, lane, wave, gw, NGW, gtid, NT, 3); }
    GRID_SYNC();
#ifndef SKIP_G5
#ifndef REP_G6
#define REP_G6 1
#endif
#pragma nounroll
    for (int rep = 0; rep < REP_G6; ++rep) {
    RUN_GEMM(5, ws + WS_S3, ws + WS_WQ, 2048, 1024);
    }
    if (G > 64 && (int)blockIdx.x >= 32) { RUN_GEMM_ON(6, ws + WS_PB, ws + WS_WPLE, 1024, 256, G - 32, (int)blockIdx.x - 32); }
    else if (G <= 64) { RUN_GEMM(6, ws + WS_PB, ws + WS_WPLE, 1024, 256); }
#endif
    GRID_SYNC();
#ifndef SKIP_TOPK
#ifndef REP_P7
#define REP_P7 1
#endif
#pragma nounroll
    for (int rep = 0; rep < REP_P7; ++rep) { FRESH_IDS; LAS float* L = (LAS float*)(lds + wave * 16384);
#ifdef TOPK_REF
      for (int t = gw; t < T * 8; t += NGW) topk_ref_task(A, t, L, lane);
#else
#ifdef TOPK_V1
      for (int t = gw; t < (T / 16) * 8; t += NGW) topk_task(A, t, L, lane);
#else
      if ((G & 7) == 0) topk3_phase(A, lds, lane, wave, G);
      else for (int t = gw; t < (T / 16) * 8; t += NGW) topk2_task(A, t, L, lane);
#endif
#endif
    }
#endif
    GRID_SYNC();
#ifndef SKIP_PEER
#ifndef REP_P8
#define REP_P8 1
#endif
#pragma nounroll
    for (int rep = 0; rep < REP_P8; ++rep) { FRESH_IDS;
#ifdef PEER_V4
      for (int t = gw; t < T; t += NGW) peer_token4(A, t, lane);
#else
      if (NGW == 2048) {
          for (int k = 0; k < 16; ++k) peer_token5(A, gw + k * 2048, lane, lds + wave * 1024, 0, 8, nullptr, nullptr, false);
          const int tl = 32768 + (int)blockIdx.x * 4 + (wave & 3); LAS float* xch = (LAS float*)(lds + 8192 + (wave & 3) * 4096);
          if (wave < 4) peer_token5(A, tl, lane, lds + wave * 1024, 0, 4, nullptr, xch, true);
          else          peer_token5(A, tl, lane, lds + wave * 1024, 4, 8, xch, nullptr, true);
      } else
      for (int t = gw; t < T; t += NGW) peer_token5(A, t, lane, lds + wave * 1024, 0, 8, nullptr, nullptr, false);
#endif
    }
#endif
    GRID_SYNC();
#ifndef REP_G9
#define REP_G9 1
#endif
#pragma nounroll
    for (int rep9 = 0; rep9 < REP_G9; ++rep9) {
#ifndef SKIP_G7
    RUN_GEMM(7, ws + WS_S2, ws + WS_WG, 1024, 1024);
#endif
    }
}

extern "C" void kernel_launch(void* const* d_in, const int* in_sizes, int n_in, void* d_out, int out_size, void* d_ws, size_t ws_size, hipStream_t stream) {
    static int grid = 0;
    if (grid == 0) {
        if (n_in != 26 || (size_t)out_size != O_END || ws_size < WS_END) { fprintf(stderr, "kernel_launch: unexpected shapes: n_in %d out %d ws %zu (need %zu)\n", n_in, out_size, ws_size, (size_t)WS_END); grid = -1; return; }
        int dev = 0, cus = 0, per_cu = 0;
        if (hipGetDevice(&dev) != hipSuccess || hipDeviceGetAttribute(&cus, hipDeviceAttributeMultiprocessorCount, dev) != hipSuccess) { grid = -1; return; }
        if (hipFuncSetAttribute((const void*)mega, hipFuncAttributeMaxDynamicSharedMemorySize, LDS_BYTES) != hipSuccess) { fprintf(stderr, "kernel_launch: hipFuncSetAttribute failed\n"); grid = -1; return; }
        if (hipOccupancyMaxActiveBlocksPerMultiprocessor(&per_cu, (const void*)mega, 512, LDS_BYTES) != hipSuccess || per_cu < 1) { fprintf(stderr, "kernel_launch: occupancy query says %d blocks/CU\n", per_cu); grid = -1; return; }
        grid = cus;
    }
    if (grid < 0) return;
    KArgs a{};
    for (int i = 0; i < 26; ++i) a.in[i] = (const float*)d_in[i];
    a.out = (float*)d_out; a.ws = (unsigned char*)d_ws;
    void* args[] = {&a};
    const hipError_t e = hipLaunchCooperativeKernel((const void*)mega, dim3(grid), dim3(512), args, LDS_BYTES, stream);
    if (e != hipSuccess) fprintf(stderr, "kernel_launch: cooperative launch failed: %s (grid %d)\n", hipGetErrorString(e), grid);
}
```

```cpp
#include <hip/hip_runtime.h>
#include <hip/hip_cooperative_groups.h>
#include <cstdio>
#include <cstdint>
namespace cg = cooperative_groups;
namespace pg8 {
#define PG8_LAS __attribute__((address_space(3)))
typedef unsigned short bf16_t;
typedef short bf16x8 __attribute__((ext_vector_type(8)));
typedef float f32x4 __attribute__((ext_vector_type(4)));
typedef unsigned u32x4 __attribute__((ext_vector_type(4)));
constexpr int BM = 256, BK = 64, HALF = 128, HTB = HALF * BK * 2  , STAGE_BYTES = 8 * HTB, NXCD = 8, WGM = 8;

__host__ __device__ __forceinline__ int lds_byte(int r, int c) { const int st = (r >> 4) * 2 + (c >> 5), rr = r & 15, cc = c & 31, ob = rr * 64 + cc * 2; return st * 1024 + (ob ^ (((ob >> 9) & 1) << 5)); }
__host__ __device__ __forceinline__ void stage_rc(int b, int& R, int& C) { const int st = b / 1024, sb = b % 1024, swz = sb ^ (((sb >> 9) & 1) << 5); R = (st >> 1) * 16 + swz / 64; C = (st & 1) * 32 + (swz % 64) / 2; }
__host__ __device__ __forceinline__ int perm32(int rho) { const int n = rho >> 4, i = rho & 15; return 8 * (i >> 2) + 4 * n + (i & 3); }

struct Unit { int pm, pn; };
struct Gemm { const bf16_t* A; const bf16_t* Bt; int M, N, K; };

struct StaticOrder {
    int nM, nN, nwg, G, c;
    __host__ __device__ void init(int M, int N, int G_, int c_) { nM = M / BM; nN = N / BM; nwg = nM * nN; G = G_; c = c_; }
    __host__ __device__ bool next(int i, Unit& u) const {
        const long L = (long)i * G + c; if (L >= nwg) return false;
        int wgid = (int)L; { const int q = nwg / NXCD, r = nwg % NXCD, xcd = wgid % NXCD, off = wgid / NXCD; wgid = (xcd < r ? xcd * (q + 1) : r * (q + 1) + (xcd - r) * q) + off; }
        const int nig = WGM * nN, gid = wgid / nig, fm = gid * WGM, gsz = (nM - fm) < WGM ? (nM - fm) : WGM;
        u.pm = fm + ((wgid % nig) % gsz); u.pn = (wgid % nig) / gsz; return true;
    }
    __device__ __forceinline__ void a_ready(const Unit&) const {}
    __device__ __forceinline__ void done(const Unit&) const {}
};

__device__ __forceinline__ unsigned cvt_pk_bf16(float lo, float hi) { unsigned r; asm volatile("v_cvt_pk_bf16_f32 %0, %1, %2" : "=v"(r) : "v"(lo), "v"(hi)); return r; }
template <class Epi, class Sched, bool ALIGN_EPI = false, bool SP2 = false>
__device__ __forceinline__ void gemm_phase(PG8_LAS unsigned char* lds, const Gemm g, const Sched& S, const Epi& E, const int wave_in) {
    int lane_l; asm volatile("v_mbcnt_lo_u32_b32 %0, -1, 0\n\tv_mbcnt_hi_u32_b32 %0, -1, %0" : "=v"(lane_l));
    const int wid = wave_in, lane = lane_l, tid = wid * 64 + lane, wr = wid >> 2, wc = wid & 3, fr = lane & 15, fq = lane >> 4;
    const int K = g.K, nt = K / BK;
    unsigned voffA[2], voffB[2];
#pragma unroll
    for (int i = 0; i < 2; ++i) { int R, C; stage_rc(tid * 16 + i * 8192, R, C); const int Rb = Epi::PERM ? ((R & ~31) + perm32(R & 31)) : R;
        voffA[i] = (unsigned)(R * K + C) * 2u; voffB[i] = (unsigned)(Rb * K + C) * 2u; }
    const size_t kstep = (size_t)(BK * 2);
    const size_t hstep = (size_t)HALF * K * 2;
    const size_t tstep = 2 * hstep;
    const unsigned ldsw = (unsigned)wid * 1024u;
    const int aoff = lds_byte(wr * 64 + fr, fq * 8), boff = lds_byte(wc * 32 + fr, fq * 8);
#define PG8_SA(b, h) (((b) * 2 + (h)) * HTB)
#define PG8_SB(b, h) ((4 + (b) * 2 + (h)) * HTB)
#define PG8_STAGE(bufoff, gbase, voff) do { _Pragma("unroll") for (int _i = 0; _i < 2; ++_i) \
        __builtin_amdgcn_global_load_lds((const unsigned*)((const char*)(gbase) + (voff)[_i]), (PG8_LAS unsigned*)(lds + (bufoff) + ldsw + _i * 8192), 16, 0, 0); } while (0)
#define PG8_LDA(dst, b, h) do { _Pragma("unroll") for (int m = 0; m < 4; ++m) _Pragma("unroll") for (int k = 0; k < 2; ++k) dst[m][k] = *(const PG8_LAS bf16x8*)(lds + PG8_SA(b, h) + aoff + m * 2048 + k * 1024); } while (0)
#define PG8_LDB(dst, b, h) do { _Pragma("unroll") for (int n = 0; n < 2; ++n) _Pragma("unroll") for (int k = 0; k < 2; ++k) dst[n][k] = *(const PG8_LAS bf16x8*)(lds + PG8_SB(b, h) + boff + n * 2048 + k * 1024); } while (0)
#define PG8_MMA(ai, bj, At, Bt) do { __builtin_amdgcn_s_setprio(1); _Pragma("unroll") for (int m = 0; m < 4; ++m) _Pragma("unroll") for (int n = 0; n < 2; ++n) _Pragma("unroll") for (int k = 0; k < 2; ++k) \
        acc[ai][bj][m][n] = __builtin_amdgcn_mfma_f32_16x16x32_bf16(Bt[n][k], At[m][k], acc[ai][bj][m][n], 0, 0, 0); __builtin_amdgcn_s_setprio(0); } while (0)
#define PG8_WAIT_V(n) asm volatile("s_waitcnt vmcnt(" #n ")" ::: "memory")
#define PG8_WAIT_L(n) asm volatile("s_waitcnt lgkmcnt(" #n ")" ::: "memory")
#define PG8_BAR __builtin_amdgcn_s_barrier()
#define PG8_SCHED __builtin_amdgcn_sched_barrier(0)
    Unit cur, nxt; int ui = 0;
    if (!S.next(0, cur)) return;
    f32x4 acc[2][2][4][2];
#pragma unroll
    for (int a = 0; a < 2; ++a)
#pragma unroll
        for (int b = 0; b < 2; ++b)
#pragma unroll
            for (int m = 0; m < 4; ++m)
#pragma unroll
                for (int n = 0; n < 2; ++n) acc[a][b][m][n] = (f32x4){0.f, 0.f, 0.f, 0.f};
    bf16x8 At[4][2], B0[2][2], B1[2][2];
    const char* cA = (const char*)g.A + (size_t)cur.pm * tstep; const char* cB = (const char*)g.Bt + (size_t)cur.pn * tstep;
    S.a_ready(cur);
    if constexpr (SP2) {
        PG8_STAGE(PG8_SB(0, 0), cB, voffB); PG8_STAGE(PG8_SB(0, 1), cB + hstep, voffB); PG8_STAGE(PG8_SA(0, 0), cA, voffA); PG8_STAGE(PG8_SA(0, 1), cA + hstep, voffA);
        if (wr == 1) PG8_BAR;
        PG8_WAIT_V(2); PG8_BAR;
        PG8_STAGE(PG8_SB(1, 0), cB + kstep, voffB); PG8_STAGE(PG8_SA(1, 0), cA + kstep, voffA); PG8_STAGE(PG8_SB(1, 1), cB + hstep + kstep, voffB);
        PG8_WAIT_V(6); PG8_BAR;
    } else {
        PG8_STAGE(PG8_SB(0, 0), cB, voffB); PG8_STAGE(PG8_SA(0, 0), cA, voffA); PG8_STAGE(PG8_SB(0, 1), cB + hstep, voffB); PG8_STAGE(PG8_SA(0, 1), cA + hstep, voffA);
        if (wr == 1) PG8_BAR;
        PG8_WAIT_V(4); PG8_BAR;
        PG8_STAGE(PG8_SB(1, 0), cB + kstep, voffB); PG8_STAGE(PG8_SA(1, 0), cA + kstep, voffA); PG8_STAGE(PG8_SB(1, 1), cB + hstep + kstep, voffB);
        PG8_WAIT_V(6); PG8_BAR;
    }
    for (;;) {
        const bool has_next = S.next(ui + 1, nxt);
        const char* nA = has_next ? (const char*)g.A + (size_t)nxt.pm * tstep : cA; const char* nB = has_next ? (const char*)g.Bt + (size_t)nxt.pn * tstep : cB;
        for (int t = 0; t < nt; t += 2) {
            const bool last = (t == nt - 2);
            const char* a1 = cA + (size_t)(t + 1) * kstep;
            const char* a2 = last ? nA : cA + (size_t)(t + 2) * kstep; const char* b2 = last ? nB : cB + (size_t)(t + 2) * kstep;
            const char* a3 = a2 + kstep; const char* b3 = b2 + kstep;
            if (last && has_next) S.a_ready(nxt);
            if constexpr (SP2) {
            PG8_LDB(B0, 0, 0); PG8_LDB(B1, 0, 1); PG8_SCHED; PG8_LDA(At, 0, 0); PG8_STAGE(PG8_SA(1, 1), a1 + hstep, voffA);
            PG8_WAIT_V(8); PG8_WAIT_L(0); PG8_BAR; PG8_MMA(0, 0, At, B0); PG8_MMA(0, 1, At, B1); PG8_BAR; PG8_SCHED;
            PG8_LDA(At, 0, 1); PG8_STAGE(PG8_SB(0, 0), b2, voffB); PG8_STAGE(PG8_SB(0, 1), b2 + hstep, voffB); PG8_STAGE(PG8_SA(0, 0), a2, voffA);
            PG8_WAIT_V(8); PG8_WAIT_L(0); PG8_BAR; PG8_MMA(1, 0, At, B0); PG8_MMA(1, 1, At, B1); PG8_BAR; PG8_SCHED;
            PG8_LDB(B0, 1, 0); PG8_LDB(B1, 1, 1); PG8_SCHED; PG8_LDA(At, 1, 0); PG8_STAGE(PG8_SA(0, 1), a2 + hstep, voffA);
            PG8_WAIT_V(8); PG8_WAIT_L(0); PG8_BAR; PG8_MMA(0, 0, At, B0); PG8_MMA(0, 1, At, B1); PG8_BAR; PG8_SCHED;
            PG8_LDA(At, 1, 1); PG8_STAGE(PG8_SB(1, 0), b3, voffB); PG8_STAGE(PG8_SB(1, 1), b3 + hstep, voffB); PG8_STAGE(PG8_SA(1, 0), a3, voffA);
            PG8_WAIT_V(8); PG8_WAIT_L(0); PG8_BAR; PG8_MMA(1, 0, At, B0); PG8_MMA(1, 1, At, B1); PG8_BAR; PG8_SCHED;
            } else {
            PG8_LDB(B0, 0, 0); PG8_SCHED; PG8_LDA(At, 0, 0); PG8_STAGE(PG8_SA(1, 1), a1 + hstep, voffA);
            PG8_WAIT_L(8); PG8_BAR; PG8_WAIT_L(0); PG8_MMA(0, 0, At, B0); PG8_BAR; PG8_SCHED;
            PG8_LDB(B1, 0, 1); PG8_STAGE(PG8_SB(0, 0), b2, voffB);
            PG8_BAR; PG8_WAIT_L(0); PG8_MMA(0, 1, At, B1); PG8_BAR;
            PG8_LDA(At, 0, 1); PG8_STAGE(PG8_SA(0, 0), a2, voffA);
            PG8_BAR; PG8_WAIT_L(0); PG8_MMA(1, 0, At, B0); PG8_BAR; PG8_SCHED;
            PG8_STAGE(PG8_SB(0, 1), b2 + hstep, voffB);
            PG8_WAIT_V(6); PG8_BAR; PG8_MMA(1, 1, At, B1); PG8_BAR;
            PG8_LDB(B0, 1, 0); PG8_SCHED; PG8_LDA(At, 1, 0); PG8_STAGE(PG8_SA(0, 1), a2 + hstep, voffA);
            PG8_WAIT_L(8); PG8_BAR; PG8_WAIT_L(0); PG8_MMA(0, 0, At, B0); PG8_BAR; PG8_SCHED;
            PG8_LDB(B1, 1, 1); PG8_STAGE(PG8_SB(1, 0), b3, voffB);
            PG8_BAR; PG8_WAIT_L(0); PG8_MMA(0, 1, At, B1); PG8_BAR;
            PG8_LDA(At, 1, 1); PG8_STAGE(PG8_SA(1, 0), a3, voffA);
            PG8_BAR; PG8_WAIT_L(0); PG8_MMA(1, 0, At, B0); PG8_BAR; PG8_SCHED;
            PG8_STAGE(PG8_SB(1, 1), b3 + hstep, voffB);
            PG8_WAIT_V(6); PG8_BAR; PG8_MMA(1, 1, At, B1); PG8_BAR;
            }
        }
        if constexpr (ALIGN_EPI) { if (wr == 0) PG8_BAR; }
        if constexpr (!Epi::AFTER_DRAIN) { E(acc, cur, wr, wc, fr, fq); S.done(cur); }
        if (!has_next) break;
#pragma unroll
        for (int a = 0; a < 2; ++a)
#pragma unroll
            for (int b = 0; b < 2; ++b)
#pragma unroll
                for (int m = 0; m < 4; ++m)
#pragma unroll
                    for (int n = 0; n < 2; ++n) acc[a][b][m][n] = (f32x4){0.f, 0.f, 0.f, 0.f};
        cur = nxt; cA = nA; cB = nB; ++ui;
        if constexpr (ALIGN_EPI) { if (wr == 1) PG8_BAR; }
    }
    PG8_WAIT_V(0);
    if constexpr (!ALIGN_EPI) { if (wr == 0) PG8_BAR; }
    PG8_BAR;
    if constexpr (Epi::AFTER_DRAIN) { E.fused(acc, cur, wr, wc, fr, fq, lds, wid, lane); S.done(cur); }
#undef PG8_SA
#undef PG8_SB
#undef PG8_STAGE
#undef PG8_LDA
#undef PG8_LDB
#undef PG8_MMA
#undef PG8_WAIT_V
#undef PG8_WAIT_L
#undef PG8_BAR
#undef PG8_SCHED
}
}

#define LAS __attribute__((address_space(3)))
#define DEV __device__ __forceinline__
typedef unsigned short bf16_t;
typedef float f32x4 __attribute__((ext_vector_type(4)));
typedef short bf16x8 __attribute__((ext_vector_type(8)));
typedef unsigned u32x4 __attribute__((ext_vector_type(4)));
typedef unsigned u32x2 __attribute__((ext_vector_type(2)));
typedef __bf16 bf2_t __attribute__((ext_vector_type(2)));

constexpr int TP = 32768, TS = 1024, T = TP + TS;
constexpr float EPS = 1e-6f;
constexpr size_t O_NKP = 34603008, O_NVP = O_NKP + 131072, O_NKS = O_NVP + 131072, O_NVS = O_NKS + 131072,
                 O_SVP = O_NVS + 131072, O_SVS = O_SVP + 524288, O_END = O_SVS + 524288;
static_assert(O_END == 36175872, "output size");
constexpr size_t KiB = 1024, MiB = 1048576;
constexpr size_t WS_RSTD1 = 0, WS_LNSTAT = 256 * KiB, WS_SSQ2 = 768 * KiB, WS_RSTD3 = 1024 * KiB, WS_BAR = 1536 * KiB;
constexpr size_t WS_WIN = 2 * MiB, WS_WA = WS_WIN + 7680 * KiB, WS_WB = WS_WA + MiB, WS_WOUT = WS_WB + MiB, WS_WQ = WS_WOUT + 2 * MiB,
                 WS_SK = WS_WQ + 4 * MiB, WS_WPLE = WS_SK + 512 * KiB, WS_WG = WS_WPLE + 512 * KiB, WS_SGUW = WS_WG + 2 * MiB,
                 WS_CK = 21 * MiB, WS_CVT = 25 * MiB, WS_PU = 29 * MiB, WS_PV = 61 * MiB, WS_PB = 93 * MiB,
                 WS_S1 = 110 * MiB, WS_S2 = 242 * MiB, WS_S3 = 308 * MiB, WS_S4 = 374 * MiB, WS_S5 = 440 * MiB, WS_END = 482 * MiB;
static_assert(WS_SGUW + 128 * KiB <= WS_CK, "ws map");
constexpr int LDS_BYTES = 143360 + 64;

struct KArgs { const float* in[26]; float* out; unsigned char* ws; };

DEV unsigned pk2(float lo, float hi) { unsigned r; asm("v_cvt_pk_bf16_f32 %0, %1, %2" : "=v"(r) : "v"(lo), "v"(hi)); return r; }
DEV unsigned f2bf(float f) { return pk2(f, f) & 0xffffu; }
DEV float bflo(unsigned w) { return __builtin_bit_cast(float, w << 16); }
DEV float bfhi(unsigned w) { return __builtin_bit_cast(float, w & 0xffff0000u); }
DEV float bf1(bf16_t h) { return __builtin_bit_cast(float, (unsigned)h << 16); }
DEV float gelu_t(float x) { const float u = 1.5957691216f * (x + 0.044715f * x * x * x); return x * __builtin_amdgcn_rcpf(1.f + __expf(-u)); }
DEV float sigm(float x) { return __builtin_amdgcn_rcpf(1.f + __expf(-x)); }
DEV void st8bf(bf16_t* p, const float (&v)[8]) { u32x4 w; w.x = pk2(v[0], v[1]); w.y = pk2(v[2], v[3]); w.z = pk2(v[4], v[5]); w.w = pk2(v[6], v[7]); *(u32x4*)p = w; }
DEV void ld8bf(const bf16_t* p, float (&v)[8]) { const u32x4 w = *(const u32x4*)p; v[0] = bflo(w.x); v[1] = bfhi(w.x); v[2] = bflo(w.y); v[3] = bfhi(w.y); v[4] = bflo(w.z); v[5] = bfhi(w.z); v[6] = bflo(w.w); v[7] = bfhi(w.w); }
DEV void st8f(float* p, const float (&v)[8]) { *(f32x4*)p = (f32x4){v[0], v[1], v[2], v[3]}; *(f32x4*)(p + 4) = (f32x4){v[4], v[5], v[6], v[7]}; }
DEV void st8bf_nt(bf16_t* p, const float (&v)[8]) { u32x4 w; w.x = pk2(v[0], v[1]); w.y = pk2(v[2], v[3]); w.z = pk2(v[4], v[5]); w.w = pk2(v[6], v[7]); __builtin_nontemporal_store(w, (u32x4*)p); }
DEV void ld8f_nt(const float* p, float (&v)[8]) { const f32x4 a = __builtin_nontemporal_load((const f32x4*)p), b = __builtin_nontemporal_load((const f32x4*)(p + 4)); v[0] = a.x; v[1] = a.y; v[2] = a.z; v[3] = a.w; v[4] = b.x; v[5] = b.y; v[6] = b.z; v[7] = b.w; }
DEV void st8f_nt(float* p, const float (&v)[8]) { __builtin_nontemporal_store((f32x4){v[0], v[1], v[2], v[3]}, (f32x4*)p); __builtin_nontemporal_store((f32x4){v[4], v[5], v[6], v[7]}, (f32x4*)(p + 4)); }
DEV void ld8f(const float* p, float (&v)[8]) { const f32x4 a = *(const f32x4*)p, b = *(const f32x4*)(p + 4); v[0] = a.x; v[1] = a.y; v[2] = a.z; v[3] = a.w; v[4] = b.x; v[5] = b.y; v[6] = b.z; v[7] = b.w; }
DEV float wave_sum(float v) {
#pragma unroll
    for (int o = 1; o < 64; o <<= 1) v += __shfl_xor(v, o);
    return v;
}
DEV float rowmax16(float v) { v = fmaxf(v, __shfl_xor(v, 1)); v = fmaxf(v, __shfl_xor(v, 2)); v = fmaxf(v, __shfl_xor(v, 4)); v = fmaxf(v, __shfl_xor(v, 8)); return v; }
DEV float rowsum16(float v) { v += __shfl_xor(v, 1); v += __shfl_xor(v, 2); v += __shfl_xor(v, 4); v += __shfl_xor(v, 8); return v; }
DEV int rowmax16i(int v) { v = max(v, __shfl_xor(v, 1)); v = max(v, __shfl_xor(v, 2)); v = max(v, __shfl_xor(v, 4)); v = max(v, __shfl_xor(v, 8)); return v; }
template <int CTRL> DEV float dppf(float v) { return __builtin_bit_cast(float, __builtin_amdgcn_update_dpp(0, __builtin_bit_cast(int, v), CTRL, 0xf, 0xf, false)); }
DEV float vmax(float a, float b) { float r; asm("v_max_f32_e32 %0, %1, %2" : "=v"(r) : "v"(a), "v"(b)); return r; }
DEV float vmin(float a, float b) { float r; asm("v_min_f32_e32 %0, %1, %2" : "=v"(r) : "v"(a), "v"(b)); return r; }
#define ROR_MAX(N) DEV float vmax_ror##N(float v) { float r; asm("s_nop 1\n\tv_max_f32_dpp %0, %1, %1 row_ror:" #N " row_mask:0xf bank_mask:0xf" : "=v"(r) : "v"(v)); return r; }
ROR_MAX(8) ROR_MAX(4) ROR_MAX(2) ROR_MAX(1)
DEV float rowmax16d(float v) { v = vmax_ror8(v); v = vmax_ror4(v); v = vmax_ror2(v); v = vmax_ror1(v); return v; }
DEV float rowsum16d(float v) { v += dppf<0x128>(v); v += dppf<0x124>(v); v += dppf<0x122>(v); v += dppf<0x121>(v); return v; }
DEV f32x4 mfma16(bf16x8 a, bf16x8 b, f32x4 c) { return __builtin_amdgcn_mfma_f32_16x16x32_bf16(a, b, c, 0, 0, 0); }
DEV const float* xrow(const KArgs& A, int row) { return row < TP ? A.in[0] + (size_t)row * 1024 : A.in[1] + (size_t)(row - TP) * 1024; }

template <int mode> struct Epi {
    static constexpr bool PERM = true, AFTER_DRAIN = false;
    const float* xp; const float* xs; float* out; unsigned char* ws;
    DEV void operator()(const f32x4 (&acc)[2][2][4][2], const pg8::Unit& u, int wr, int wc, int fr, int fq) const {
        rowop<0, 0>(acc, u, wr, wc, fr, fq); rowop<0, 1>(acc, u, wr, wc, fr, fq); rowop<0, 2>(acc, u, wr, wc, fr, fq); rowop<0, 3>(acc, u, wr, wc, fr, fq);
        rowop<1, 0>(acc, u, wr, wc, fr, fq); rowop<1, 1>(acc, u, wr, wc, fr, fq); rowop<1, 2>(acc, u, wr, wc, fr, fq); rowop<1, 3>(acc, u, wr, wc, fr, fq);
    }
    template <int ai, int m>
    DEV void rowop(const f32x4 (&acc)[2][2][4][2], const pg8::Unit& u, int wr, int wc, int fr, int fq) const {
        const int pn = u.pn;
            {
                const int row = u.pm * 256 + ai * 128 + wr * 64 + m * 16 + fr;
                float rs = 1.f, s1 = 0.f, s2 = 0.f;
                if (mode == 1) rs = ((const float*)(ws + WS_RSTD1))[row];
                else if (mode == 5) rs = rsqrtf(((const float*)(ws + WS_SSQ2))[row] * (1.f / 1024.f) + EPS);
                else if (mode == 7) rs = ((const float*)(ws + WS_RSTD3))[row];
#pragma unroll
                for (int bj = 0; bj < 2; ++bj) {
                    const int col0 = pn * 256 + bj * 128 + wc * 32 + 8 * fq;
                    float v[8];
#pragma unroll
                    for (int i = 0; i < 4; ++i) { v[i] = acc[ai][bj][m][0][i] * rs; v[4 + i] = acc[ai][bj][m][1][i] * rs; }
                    if (mode == 1) {
                        if (pn < 2 || (pn == 2 && bj == 0)) {
                            st8bf((bf16_t*)(ws + WS_S3) + (size_t)row * 640 + col0, v);
                        } else if (pn == 2) {
                            const int c = col0 - 640, chunk = row >> 7, tok = row & 127;
                            bf16_t* vt = (bf16_t*)(ws + WS_S3) + (size_t)T * 640 + (size_t)chunk * 16384 + c * 128 + tok;
#pragma unroll
                            for (int i = 0; i < 8; ++i) vt[i * 128] = (bf16_t)f2bf(v[i]);
                            if (row >= TP) st8f(out + O_NVS + (size_t)(row - TP) * 128 + c, v);
                            else if ((row & 4095) >= 3968) st8f(out + O_NVP + (size_t)((row >> 12) * 128 + (row & 4095) - 3968) * 128 + c, v);
                        } else if (pn < 5) {
#pragma unroll
                            for (int i = 0; i < 8; ++i) v[i] = gelu_t(v[i]);
                            st8bf((bf16_t*)(ws + WS_S4) + (size_t)row * 512 + (col0 - 768), v);
                        } else if (pn < 7) {
                            const int c = col0 - 1280, chunk = row >> 7, tok = row & 127;
                            bf16_t* gt = (bf16_t*)(ws + WS_S4) + (size_t)T * 512 + (size_t)chunk * 65536 + c * 128 + tok;
#pragma unroll
                            for (int i = 0; i < 8; ++i) { const unsigned hb = f2bf(gelu_t(v[i])); gt[i * 128] = (bf16_t)hb; const float gr = bf1((bf16_t)hb); s1 += gr; s2 += gr * gr; }
                        } else {
#pragma unroll
                            for (int i = 0; i < 8; ++i) v[i] = sigm(v[i]);
                            st8bf_nt((bf16_t*)(ws + WS_S1) + (size_t)row * 2048 + (col0 - 1792), v);
                        }
                    } else if (mode == 2) {
                        float g[8]; ld8bf((const bf16_t*)(ws + WS_S1) + (size_t)row * 2048 + col0, g);
#pragma unroll
                        for (int i = 0; i < 8; ++i) v[i] *= g[i];
                        st8bf((bf16_t*)(ws + WS_S3) + (size_t)row * 1024 + col0, v);
                    } else if (mode == 3) {
                        float g[8], t[8]; ld8bf((const bf16_t*)(ws + WS_S1) + (size_t)row * 2048 + 1024 + col0, g); ld8bf((const bf16_t*)(ws + WS_S3) + (size_t)row * 1024 + col0, t);
#pragma unroll
                        for (int i = 0; i < 8; ++i) v[i] = t[i] + g[i] * v[i];
                        st8bf((bf16_t*)(ws + WS_S4) + (size_t)row * 1024 + col0, v);
                    } else if (mode == 4) {
                        float xv[8]; ld8bf((const bf16_t*)out + (size_t)row * 1024 + col0, xv);
#pragma unroll
                        for (int i = 0; i < 8; ++i) { v[i] += xv[i]; s1 += v[i] * v[i]; }
                        st8bf((bf16_t*)(ws + WS_S3) + (size_t)row * 1024 + col0, v);
                    } else if (mode == 5) {
                        st8bf((bf16_t*)(ws + WS_S1) + (size_t)row * 2048 + col0, v);
                    } else if (mode == 6) {
                        st8bf((bf16_t*)(ws + WS_S4) + (size_t)row * 1024 + col0, v);
                    } else {
                        float x2[8], pe[8]; ld8bf((const bf16_t*)(ws + WS_S2) + (size_t)row * 1024 + col0, x2); ld8bf((const bf16_t*)(ws + WS_S4) + (size_t)row * 1024 + col0, pe);
#pragma unroll
                        for (int i = 0; i < 8; ++i) v[i] = x2[i] + sigm(v[i]) * pe[i];
                        st8f_nt(out + (size_t)row * 1024 + col0, v);
                    }
                }
                if ((mode == 1 && (pn == 5 || pn == 6)) || mode == 4) {
                    s1 += __shfl_xor(s1, 16); s1 += __shfl_xor(s1, 32); s2 += __shfl_xor(s2, 16); s2 += __shfl_xor(s2, 32);
                    if (fq == 0) {
                        if (mode == 1) { float* ls = (float*)(ws + WS_LNSTAT) + (size_t)row * 2; atomicAdd(ls, s1); atomicAdd(ls + 1, s2); }
                        else atomicAdd((float*)(ws + WS_SSQ2) + row, s1);
                    }
                }
            }
    }
};

DEV void tr_item(const float* W, const float* ksc, int K, int N, bf16_t* WT, LAS float* scr, int item, int lane) {
    const int nblk = N / 32, kb = item / nblk, nb = item % nblk, k0 = 64 * kb, n0 = 32 * nb;
    const int r = lane >> 3, c4 = (lane & 7) * 4;
    f32x4 w[8];
#pragma unroll
    for (int i = 0; i < 8; ++i) w[i] = *(const f32x4*)(W + (size_t)(k0 + 8 * i + r) * N + n0 + c4);
#pragma unroll
    for (int i = 0; i < 8; ++i) { const int kk = 8 * i + r; const float sc = ksc ? ksc[k0 + kk] : 1.f; LAS float* d = scr + kk * 33 + c4;
        d[0] = w[i].x * sc; d[1] = w[i].y * sc; d[2] = w[i].z * sc; d[3] = w[i].w * sc; }
    asm volatile("s_waitcnt lgkmcnt(0)" ::: "memory");
    const int c = lane & 7;
#pragma unroll
    for (int j = 0; j < 4; ++j) { const int n = (lane >> 3) + 8 * j; const LAS float* s = scr + (8 * c) * 33 + n;
        u32x4 o; o.x = pk2(s[0 * 33], s[1 * 33]); o.y = pk2(s[2 * 33], s[3 * 33]); o.z = pk2(s[4 * 33], s[5 * 33]); o.w = pk2(s[6 * 33], s[7 * 33]);
        *(u32x4*)(WT + (size_t)(n0 + n) * K + k0 + 8 * c) = o; }
    asm volatile("s_waitcnt lgkmcnt(0)" ::: "memory");
}
DEV void cvt_flat(const float* src, bf16_t* dst, int ngroups, int gtid, int NT) {
    for (int i = gtid; i < ngroups / 4; i += NT) {
        float v[4][8];
#pragma unroll
        for (int u = 0; u < 4; ++u) ld8f_nt(src + ((size_t)u * (ngroups / 4) + i) * 8, v[u]);
#pragma unroll
        for (int u = 0; u < 4; ++u) st8bf(dst + ((size_t)u * (ngroups / 4) + i) * 8, v[u]);
    }
}
constexpr float PEER_SU = 64.f, PEER_SV = 24.f;
DEV unsigned pk8_fp4(const float (&v)[8], float sc) {
    unsigned p = 0;
    p = __builtin_amdgcn_cvt_scalef32_pk_fp4_f32(p, v[0] * sc, v[1] * sc, 1.0f, 0); p = __builtin_amdgcn_cvt_scalef32_pk_fp4_f32(p, v[2] * sc, v[3] * sc, 1.0f, 1);
    p = __builtin_amdgcn_cvt_scalef32_pk_fp4_f32(p, v[4] * sc, v[5] * sc, 1.0f, 2); p = __builtin_amdgcn_cvt_scalef32_pk_fp4_f32(p, v[6] * sc, v[7] * sc, 1.0f, 3);
    return p;
}
DEV void cvt_fp4(const float* src, unsigned char* dst, int ngroups  , float sc, int gtid, int NT) {
    for (int i = gtid; i < ngroups / 4; i += NT) {
        float v[4][8];
#pragma unroll
        for (int u = 0; u < 4; ++u) ld8f_nt(src + ((size_t)u * (ngroups / 4) + i) * 8, v[u]);
#pragma unroll
        for (int u = 0; u < 4; ++u) ((unsigned*)dst)[(size_t)u * (ngroups / 4) + i] = pk8_fp4(v[u], sc);
    }
}
DEV void p0_phase(const KArgs& A, LAS unsigned char* lds, int lane, int wave, int gw, int NGW, int gtid, int NT, const int part) {
    unsigned char* ws = A.ws;
    if (part == 0) { float* ls = (float*)(ws + WS_LNSTAT); for (int i = gtid; i < T * 2; i += NT) ls[i] = 0.f;
      float* sq = (float*)(ws + WS_SSQ2); for (int i = gtid; i < T; i += NT) sq[i] = 0.f; }
    LAS float* scr = (LAS float*)(lds + wave * 8704);
    constexpr int I_IN = 16 * 120, I_A = 8 * 32, I_B = 8 * 32, I_O = 16 * 32, I_Q = 16 * 64, I_P = 4 * 32, I_G = 16 * 32, NIT = I_IN + I_A + I_B + I_O + I_Q + I_P + I_G;
    constexpr int I_MID = I_IN + I_A + I_B + I_O;
    for (int it = (part == 0 ? gw : (part == 1 ? I_IN + gw : I_MID + gw)); it < (part == 0 ? I_IN : (part == 1 ? I_MID : (part == 3 ? NIT : 0))); it += NGW) {
        int r = it; const float* W; const float* sc = nullptr; int K, N; bf16_t* WT;
        if (r < I_IN) { W = A.in[7]; sc = A.in[6]; K = 1024; N = 3840; WT = (bf16_t*)(ws + WS_WIN); }
        else if ((r -= I_IN) < I_A) { W = A.in[15]; K = 512; N = 1024; WT = (bf16_t*)(ws + WS_WA); }
        else if ((r -= I_A) < I_B) { W = A.in[16]; K = 512; N = 1024; WT = (bf16_t*)(ws + WS_WB); }
        else if ((r -= I_B) < I_O) { W = A.in[17]; K = 1024; N = 1024; WT = (bf16_t*)(ws + WS_WOUT); }
        else if ((r -= I_O) < I_Q) { W = A.in[19]; sc = A.in[18]; K = 1024; N = 2048; WT = (bf16_t*)(ws + WS_WQ); }
        else if ((r -= I_Q) < I_P) { W = A.in[24]; K = 256; N = 1024; WT = (bf16_t*)(ws + WS_WPLE); }
        else { r -= I_P; W = A.in[25]; sc = A.in[23]; K = 1024; N = 1024; WT = (bf16_t*)(ws + WS_WG); }
        tr_item(W, sc, K, N, WT, scr, r, lane);
    }
    if (part == 2) {
    cvt_flat(A.in[4], (bf16_t*)(ws + WS_PB), 1048576, gtid, NT);
    cvt_flat(A.in[5], (bf16_t*)(ws + WS_PB) + (size_t)TP * 256, 32768, gtid, NT);
    }
    if (part == 1) {
    cvt_flat(A.in[20], (bf16_t*)(ws + WS_SK), 32768, gtid, NT);
    cvt_flat(A.in[2], (bf16_t*)(ws + WS_CK), 262144, gtid, NT);
    for (int i = gtid; i < 8192; i += NT) {
        const int t = (i >> 4) & 127, s0 = (i & 15) * 8; float v[8]; ld8f(A.in[13] + (size_t)i * 8, v);
#pragma unroll
        for (int e = 0; e < 8; ++e) if (s0 + e > t) v[e] = 0.f;
        st8bf((bf16_t*)(ws + WS_SGUW) + (size_t)i * 8, v);
    }
    for (int i = gtid; i < 262144; i += NT) {
        const int d = i & 63, kg = (i >> 6) & 15, kvh = (i >> 10) & 1, seq = i >> 11; float v[8];
#pragma unroll
        for (int e = 0; e < 8; ++e) v[e] = A.in[3][((size_t)(seq * 128 + kg * 8 + e) * 2 + kvh) * 64 + d];
        st8bf((bf16_t*)(ws + WS_CVT) + ((size_t)(seq * 2 + kvh) * 64 + d) * 128 + kg * 8, v);
    }
    }
    if (part == 0)
    for (int row0 = gw * 2; row0 < T; row0 += NGW * 2) {
        f32x4 v[2][4]; float s[2];
#pragma unroll
        for (int r = 0; r < 2; ++r) { const f32x4* xr = (const f32x4*)xrow(A, row0 + r) + lane;
#pragma unroll
            for (int j = 0; j < 4; ++j) v[r][j] = __builtin_nontemporal_load(xr + 64 * j); }
#pragma unroll
        for (int r = 0; r < 2; ++r) { s[r] = 0.f;
#pragma unroll
            for (int j = 0; j < 4; ++j) s[r] += (v[r][j].x * v[r][j].x + v[r][j].y * v[r][j].y) + (v[r][j].z * v[r][j].z + v[r][j].w * v[r][j].w);
            s[r] = wave_sum(s[r]);
            if (lane == 0) ((float*)(ws + WS_RSTD1))[row0 + r] = rsqrtf(s[r] * (1.f / 1024.f) + EPS);
            u32x2* o = (u32x2*)((bf16_t*)A.out + (size_t)(row0 + r) * 1024) + lane;
#pragma unroll
            for (int j = 0; j < 4; ++j) { u32x2 w; w.x = pk2(v[r][j].x, v[r][j].y); w.y = pk2(v[r][j].z, v[r][j].w); o[64 * j] = w; } }
    }
}

DEV void p2_item(const KArgs& A, const bf16_t* zqk, bf16_t* qn, bf16_t* kn, int i, float (&v)[8]) {
    const int row = i / 80, g = i - row * 80;
    float ss = 0.f;
#pragma unroll
    for (int e = 0; e < 8; ++e) ss += v[e] * v[e];
    ss += __shfl_xor(ss, 1); ss += __shfl_xor(ss, 2); ss += __shfl_xor(ss, 4);
    const float r = rsqrtf(ss * (1.f / 64.f) + EPS);
    const int d0 = (g & 7) * 8;
    if (g < 64) {
        float gg[8]; ld8f(A.in[8] + d0, gg);
#pragma unroll
        for (int e = 0; e < 8; ++e) v[e] = v[e] * r * gg[e] * 0.125f;
        st8bf(qn + (size_t)row * 512 + g * 8, v);
    } else {
        float gg[8]; ld8f(A.in[9] + d0, gg);
#pragma unroll
        for (int e = 0; e < 8; ++e) v[e] = v[e] * r * gg[e];
        const int c = (g - 64) * 8;
        st8bf(kn + (size_t)row * 128 + c, v);
        if (row >= TP) st8f(A.out + O_NKS + (size_t)(row - TP) * 128 + c, v);
        else if ((row & 4095) >= 3968) st8f(A.out + O_NKP + (size_t)((row >> 12) * 128 + (row & 4095) - 3968) * 128 + c, v);
    }
}
DEV void p2_phase(const KArgs& A, int gtid, int NT) {
    unsigned char* ws = A.ws;
    const bf16_t* zqk = (const bf16_t*)(ws + WS_S3);
    bf16_t* qn = (bf16_t*)(ws + WS_S5); bf16_t* kn = qn + (size_t)T * 512;
    constexpr int NI = T * 80, Q4 = NI / 4;
    static_assert(NI % 4 == 0 && Q4 % 64 == 0, "p2 split");
    for (int i = gtid; i < Q4; i += NT) {
        float v[4][8];
#pragma unroll
        for (int u = 0; u < 4; ++u) { const int ii = u * Q4 + i; const int row = ii / 80, g = ii - row * 80; ld8bf(zqk + (size_t)row * 640 + g * 8, v[u]); }
#pragma unroll
        for (int u = 0; u < 4; ++u) p2_item(A, zqk, qn, kn, u * Q4 + i, v[u]);
    }
}

template <bool SAMPLE>
DEV void attn_task(const KArgs& A, int task, LAS bf16_t* P, int lane) {
    unsigned char* ws = A.ws;
    const bf16_t* qn = (const bf16_t*)(ws + WS_S5);
    const bf16_t* kn = qn + (size_t)T * 512;
    const bf16_t* VT = (const bf16_t*)(ws + WS_S3) + (size_t)T * 640;
    const bf16_t* ck = (const bf16_t*)(ws + WS_CK);
    const bf16_t* cvT = (const bf16_t*)(ws + WS_CVT);
    bf16_t* ab = (bf16_t*)(ws + WS_S2);
    const int fr = lane & 15, quad = lane >> 4;
    int kvh, st = 0, cj = 0, j = 0, prevc = 0, seq = 0, i0 = 0, hq_u = 0, p2 = 0;
    if (!SAMPLE) { const int unit = task >> 5, sub = task & 31, w = sub >> 2, a = (w & 1) * 4 + (sub & 3); kvh = unit & 1; cj = unit >> 1; j = cj & 31; prevc = j > 0 ? cj - 1 : cj; i0 = 16 * a; st = a < 6 ? a : 6; hq_u = kvh * 4 + (w >> 1); }
    else { seq = task >> 2; kvh = (task >> 1) & 1; p2 = task & 1; }
    size_t qoff;
    if (!SAMPLE) qoff = (size_t)(cj * 128 + i0 + fr) * 512 + hq_u * 64;
    else qoff = (size_t)(TP + seq * 8 + (fr & 7)) * 512 + (kvh * 4 + 2 * p2 + (fr >> 3)) * 64;
    const bf16x8 qa0 = *(const bf16x8*)(qn + qoff + quad * 8), qa1 = *(const bf16x8*)(qn + qoff + 32 + quad * 8);
    f32x4 S[10];
#pragma unroll
    for (int t = 0; t < 10; ++t) {
        const int r = (st + t) * 16 + fr; const bf16_t* kp;
        if (!SAMPLE) { const int tk = (r < 128) ? prevc * 128 + r : cj * 128 + r - 128; kp = kn + (size_t)tk * 128 + kvh * 64; }
        else { if (r < 128) kp = ck + ((size_t)(seq * 128 + r) * 2 + kvh) * 64; else { int l2 = r - 128; l2 = l2 > 7 ? 7 : l2; kp = kn + (size_t)(TP + seq * 8 + l2) * 128 + kvh * 64; } }
        const bf16x8 kb0 = *(const bf16x8*)(kp + quad * 8), kb1 = *(const bf16x8*)(kp + 32 + quad * 8);
        f32x4 z = {0.f, 0.f, 0.f, 0.f}; z = mfma16(qa0, kb0, z); z = mfma16(qa1, kb1, z); S[t] = z;
    }
    bf16x8 vbf[5][4];
#pragma unroll
    for (int ks = 0; ks < 5; ++ks) {
        const int k0 = st * 16 + ks * 32 + quad * 8;
#pragma unroll
        for (int nt = 0; nt < 4; ++nt) {
            const int d = nt * 16 + fr; const bf16_t* vp;
            if (!SAMPLE) vp = (k0 < 128) ? VT + (size_t)prevc * 16384 + (kvh * 64 + d) * 128 + k0 : VT + (size_t)cj * 16384 + (kvh * 64 + d) * 128 + (k0 - 128);
            else vp = (k0 < 128) ? cvT + ((size_t)(seq * 2 + kvh) * 64 + d) * 128 + k0 : VT + (size_t)(256 + (seq >> 4)) * 16384 + (kvh * 64 + d) * 128 + (seq & 15) * 8;
            vbf[ks][nt] = *(const bf16x8*)vp;
        }
    }
    const int hq_c = SAMPLE ? (kvh * 4 + 2 * p2 + (quad >> 1)) : hq_u;
    const float slope = exp2f(-(float)(hq_c + 1)), sink = A.in[10][hq_c];
    float inv_l[4];
#pragma unroll
    for (int reg = 0; reg < 4; ++reg) {
        const int irow = SAMPLE ? ((quad & 1) * 4 + reg) : (i0 + quad * 4 + reg);
        float mx = sink, sv[10];
#pragma unroll
        for (int t = 0; t < 10; ++t) {
            const int r = (st + t) * 16 + fr, dist = irow - r + 128;
            const bool valid = dist >= 0 && dist < 128 && (SAMPLE ? (r < 136) : (j > 0 || r >= 128));
            const float s = valid ? S[t][reg] - slope * (float)dist : -1e30f; sv[t] = s; mx = vmax(mx, s);
        }
        mx = rowmax16d(mx);
        float l = 0.f;
#pragma unroll
        for (int t = 0; t < 10; ++t) { const float p = __expf(sv[t] - mx); l += p; P[(quad * 4 + reg) * 168 + t * 16 + fr] = (bf16_t)f2bf(p); }
        l = rowsum16d(l) + __expf(sink - mx);
        inv_l[reg] = __builtin_amdgcn_rcpf(l);
    }
    if (fr == 0) { LAS float* Li = (LAS float*)(P + 16 * 168);
#pragma unroll
        for (int reg = 0; reg < 4; ++reg) Li[quad * 4 + reg] = inv_l[reg]; }
    asm volatile("s_waitcnt lgkmcnt(0)" ::: "memory");
    f32x4 O[4];
#pragma unroll
    for (int nt = 0; nt < 4; ++nt) O[nt] = (f32x4){0.f, 0.f, 0.f, 0.f};
#pragma unroll
    for (int ks = 0; ks < 5; ++ks) {
        const bf16x8 pa = *(const LAS bf16x8*)(P + fr * 168 + ks * 32 + quad * 8);
#pragma unroll
        for (int nt = 0; nt < 4; ++nt) O[nt] = mfma16(vbf[ks][nt], pa, O[nt]);
    }
    {
        const float il = ((const LAS float*)(P + 16 * 168))[fr]; size_t ooff;
        if (!SAMPLE) ooff = (size_t)(cj * 128 + i0 + fr) * 512 + hq_u * 64;
        else ooff = (size_t)(TP + seq * 8 + (fr & 7)) * 512 + (kvh * 4 + 2 * p2 + (fr >> 3)) * 64;
#pragma unroll
        for (int nt = 0; nt < 4; ++nt) { const f32x4 ov = O[nt]; u32x2 w; w.x = pk2(ov[0] * il, ov[1] * il); w.y = pk2(ov[2] * il, ov[3] * il); *(u32x2*)(ab + ooff + nt * 16 + quad * 4) = w; }
    }
    asm volatile("s_waitcnt lgkmcnt(0)" ::: "memory");
}

DEV void ln_stats8(const float* st, float (&mean)[8], float (&rstd)[8]) {
#pragma unroll
    for (int e2 = 0; e2 < 4; ++e2) {
        const f32x4 q = ((const f32x4*)st)[e2];
        const float m0 = q.x * (1.f / 512.f), m1 = q.z * (1.f / 512.f);
        mean[2 * e2] = m0; mean[2 * e2 + 1] = m1;
        rstd[2 * e2] = rsqrtf(fmaxf(q.y * (1.f / 512.f) - m0 * m0, 0.f) + EPS); rstd[2 * e2 + 1] = rsqrtf(fmaxf(q.w * (1.f / 512.f) - m1 * m1, 0.f) + EPS);
    }
}

DEV void sgu_task(const KArgs& A, int task, int lane) {
    unsigned char* ws = A.ws;
    const int fr = lane & 15, quad = lane >> 4;
    const int cj = task >> 5, g = (task >> 3) & 3, rb = task & 7, kk = (task >> 11) & 3, rb4 = (rb + 4) & 7;
    const int rt = kk == 0 ? rb : (kk == 1 ? 7 - rb : (kk == 2 ? rb4 : 7 - rb4)), nks = (rt >> 1) + 1;
    const bf16_t* W = (const bf16_t*)(ws + WS_SGUW) + (size_t)(g * 128 + rt * 16 + fr) * 128;
    const bf16_t* gv = (const bf16_t*)(ws + WS_S4) + (size_t)T * 512 + (size_t)cj * 65536 + (size_t)(g * 128 + fr) * 128;
    const float* st = (const float*)(ws + WS_LNSTAT) + (size_t)cj * 256;
    const bf16_t* ub = (const bf16_t*)(ws + WS_S4);
    bf16_t* mb = (bf16_t*)(ws + WS_S2) + (size_t)T * 512;
    f32x4 acc[8];
#pragma unroll
    for (int nt = 0; nt < 8; ++nt) acc[nt] = (f32x4){0.f, 0.f, 0.f, 0.f};
    for (int ks = 0; ks < nks; ++ks) {
        const bf16x8 wa = *(const bf16x8*)(W + ks * 32 + quad * 8);
        float mean[8], rstd[8]; ln_stats8(st + (ks * 32 + quad * 8) * 2, mean, rstd);
#pragma unroll
        for (int nt = 0; nt < 8; ++nt) {
            const int c = g * 128 + nt * 16 + fr; float x[8]; ld8bf(gv + nt * 2048 + ks * 32 + quad * 8, x);
            const float lg = A.in[11][c], lb = A.in[12][c];
#pragma unroll
            for (int e = 0; e < 8; ++e) x[e] = (x[e] - mean[e]) * rstd[e] * lg + lb;
            u32x4 w; w.x = pk2(x[0], x[1]); w.y = pk2(x[2], x[3]); w.z = pk2(x[4], x[5]); w.w = pk2(x[6], x[7]);
            acc[nt] = mfma16(__builtin_bit_cast(bf16x8, w), wa, acc[nt]);
        }
    }
    {
        const int t = rt * 16 + fr; const size_t tok = (size_t)cj * 128 + t; const float bb = A.in[14][g * 128 + t];
#pragma unroll
        for (int nt = 0; nt < 8; ++nt) {
            const int c = g * 128 + nt * 16 + quad * 4;
            const u32x2 uu = *(const u32x2*)(ub + tok * 512 + c); const f32x4 av = acc[nt];
            u32x2 o; o.x = pk2(bflo(uu.x) * (av[0] + bb), bfhi(uu.x) * (av[1] + bb)); o.y = pk2(bflo(uu.y) * (av[2] + bb), bfhi(uu.y) * (av[3] + bb));
            *(u32x2*)(mb + tok * 512 + c) = o;
        }
    }
}

DEV void sgu_small(const KArgs& A, int gtid, int NT) {
    unsigned char* ws = A.ws;
    const bf16_t* gvT = (const bf16_t*)(ws + WS_S4) + (size_t)T * 512;
    const bf16_t* ub = (const bf16_t*)(ws + WS_S4);
    bf16_t* mb = (bf16_t*)(ws + WS_S2) + (size_t)T * 512;
    for (int i = gtid; i < 131072; i += NT) {
        const bool samp = i < 65536; const int ii = samp ? i : i - 65536, c = ii & 511, grp = ii >> 9;
        const int tokbase = samp ? TP + grp * 8 : ((grp >> 4) * 4096 + 3968 + (grp & 15) * 8);
        const int chunk = tokbase >> 7, tok0 = tokbase & 127;
        float x[8], mean[8], rstd[8]; ld8bf(gvT + (size_t)chunk * 65536 + c * 128 + tok0, x);
        ln_stats8((const float*)(ws + WS_LNSTAT) + (size_t)tokbase * 2, mean, rstd);
        const float lg = A.in[11][c], lb = A.in[12][c];
        float* o = samp ? A.out + O_SVS + (size_t)(grp * 8) * 512 + c : A.out + O_SVP + (size_t)((grp >> 4) * 128 + (grp & 15) * 8) * 512 + c;
#pragma unroll
        for (int e = 0; e < 8; ++e) { x[e] = (x[e] - mean[e]) * rstd[e] * lg + lb; o[e * 512] = x[e]; }
        if (samp) {
            const int g = c >> 7;
#pragma unroll
            for (int t = 0; t < 8; ++t) {
                float s = A.in[14][g * 128 + t];
#pragma unroll
                for (int e = 0; e <= t; ++e) s += A.in[13][(size_t)(g * 128 + t) * 128 + e] * x[e];
                const size_t tk = (size_t)tokbase + t; mb[tk * 512 + c] = (bf16_t)f2bf(bf1(ub[tk * 512 + c]) * s);
            }
        }
    }
}

DEV void topk_task(const KArgs& A, int task, LAS float* L  , int lane) {
    unsigned char* ws = A.ws;
    const int fr = lane & 15, quad = lane >> 4;
    const int tok0 = (task >> 3) * 16, h = task & 7;
    const bf16_t* pq = (const bf16_t*)(ws + WS_S1) + (size_t)(tok0 + fr) * 2048 + h * 256 + quad * 8;
    const bf16_t* SK = (const bf16_t*)(ws + WS_SK) + (size_t)(h * 2) * 16384 + (size_t)fr * 128 + quad * 8;
    int* pidx = (int*)(ws + WS_S5); float* pgate = (float*)(ws + WS_S5 + (size_t)T * 512);
    const float NINF = -__builtin_inff();
#pragma unroll
    for (int c = 0; c < 2; ++c) {
        bf16x8 qa[4];
#pragma unroll
        for (int ks = 0; ks < 4; ++ks) qa[ks] = *(const bf16x8*)(pq + c * 128 + ks * 32);
#pragma unroll
        for (int nt = 0; nt < 8; ++nt) {
            f32x4 z = {0.f, 0.f, 0.f, 0.f};
#pragma unroll
            for (int ks = 0; ks < 4; ++ks) z = mfma16(qa[ks], *(const bf16x8*)(SK + (size_t)c * 16384 + nt * 2048 + ks * 32), z);
#pragma unroll
            for (int reg = 0; reg < 4; ++reg)
            { const float zr = z[reg]; L[(c * 16 + quad * 4 + reg) * 128 + nt * 16 + fr] = __builtin_bit_cast(float, (__builtin_bit_cast(unsigned, zr) & ~0x7Fu) | (unsigned)(127 - (nt * 16 + fr))); }
        }
    }
    asm volatile("s_waitcnt lgkmcnt(0)" ::: "memory");
#pragma nounroll
    for (int it = 0; it < 4; ++it) {
        const int row = quad * 4 + it;
        float v[8], top0[16], t1 = 0.f;
#pragma unroll
        for (int nt = 0; nt < 8; ++nt) v[nt] = L[row * 128 + nt * 16 + fr];
#pragma unroll
        for (int rd = 0; rd < 16; ++rd) {
            float m = v[0];
#pragma unroll
            for (int nt = 1; nt < 8; ++nt) m = fmaxf(m, v[nt]);
            const float gm = rowmax16(m); top0[rd] = gm;
#pragma unroll
            for (int nt = 0; nt < 8; ++nt) if (v[nt] == gm) v[nt] = NINF;
        }
#pragma unroll
        for (int nt = 0; nt < 8; ++nt) v[nt] = L[(16 + row) * 128 + nt * 16 + fr];
#pragma unroll
        for (int rd = 0; rd < 16; ++rd) {
            float m = v[0];
#pragma unroll
            for (int nt = 1; nt < 8; ++nt) m = fmaxf(m, v[nt]);
            const float gm = rowmax16(m); if (fr == rd) t1 = gm;
#pragma unroll
            for (int nt = 0; nt < 8; ++nt) if (v[nt] == gm) v[nt] = NINF;
        }
        float cand[16];
#pragma unroll
        for (int i = 0; i < 16; ++i) cand[i] = __builtin_bit_cast(float, (__builtin_bit_cast(unsigned, top0[i] + t1) & ~0xFFu) | (unsigned)(255 - (i * 16 + fr)));
        const int i1 = 127 - (int)(__builtin_bit_cast(unsigned, t1) & 0x7Fu);
        float best = 0.f; int bidx = 0;
#pragma unroll
        for (int rd = 0; rd < 16; ++rd) {
            float m = cand[0];
#pragma unroll
            for (int i = 1; i < 16; ++i) m = fmaxf(m, cand[i]);
            const float gm = rowmax16(m);
            int mine = -1;
#pragma unroll
            for (int i = 0; i < 16; ++i) if (cand[i] == gm) { cand[i] = NINF; mine = (127 - (int)(__builtin_bit_cast(unsigned, top0[i]) & 0x7Fu)) * 128 + i1; }
            const int gi = rowmax16i(mine);
            if (fr == rd) { best = gm; bidx = gi; }
        }
        const float mx = rowmax16(best), e = __expf(best - mx), ssum = rowsum16(e);
        const size_t o = ((size_t)(tok0 + row) * 8 + h) * 16 + fr;
        pidx[o] = bidx; pgate[o] = e / ssum;
    }
    asm volatile("s_waitcnt lgkmcnt(0)" ::: "memory");
}

#define TK_CE(a, b) { const float hi_ = vmax(a, b), lo_ = vmin(a, b); a = hi_; b = lo_; }
DEV float select16(float (&s)[8], int fr) {
    TK_CE(s[0], s[1]) TK_CE(s[2], s[3]) TK_CE(s[4], s[5]) TK_CE(s[6], s[7])
    TK_CE(s[0], s[2]) TK_CE(s[1], s[3]) TK_CE(s[4], s[6]) TK_CE(s[5], s[7])
    TK_CE(s[1], s[2]) TK_CE(s[5], s[6])
    TK_CE(s[0], s[4]) TK_CE(s[1], s[5]) TK_CE(s[2], s[6]) TK_CE(s[3], s[7])
    TK_CE(s[2], s[4]) TK_CE(s[3], s[5])
    TK_CE(s[1], s[2]) TK_CE(s[3], s[4]) TK_CE(s[5], s[6])
    const float NINF = -__builtin_inff(); float mine = 0.f;
#pragma unroll
    for (int rd = 0; rd < 16; ++rd) {
        const float gm = rowmax16d(s[0]); const bool own = (s[0] == gm);
        mine = (fr == rd) ? gm : mine;
#pragma unroll
        for (int k = 0; k < 7; ++k) s[k] = own ? s[k + 1] : s[k];
        s[7] = own ? NINF : s[7];
    }
    return mine;
}
DEV void topk2_task(const KArgs& A, int task, LAS float* L  , int lane) {
    unsigned char* ws = A.ws;
    const int fr = lane & 15, quad = lane >> 4;
    const int tok0 = (task >> 3) * 16, h = task & 7;
    const bf16_t* pq = (const bf16_t*)(ws + WS_S1) + (size_t)(tok0 + fr) * 2048 + h * 256 + quad * 8;
    const bf16_t* SK = (const bf16_t*)(ws + WS_SK) + (size_t)(h * 2) * 16384 + (size_t)fr * 128 + quad * 8;
    int* pidx = (int*)(ws + WS_S5); float* pgate = (float*)(ws + WS_S5 + (size_t)T * 512);
    const float NINF = -__builtin_inff();
#pragma unroll
    for (int c = 0; c < 2; ++c) {
        bf16x8 qa[4];
#pragma unroll
        for (int ks = 0; ks < 4; ++ks) qa[ks] = *(const bf16x8*)(pq + c * 128 + ks * 32);
#pragma unroll
        for (int nt = 0; nt < 8; ++nt) {
            f32x4 z = {0.f, 0.f, 0.f, 0.f};
#pragma unroll
            for (int ks = 0; ks < 4; ++ks) z = mfma16(qa[ks], *(const bf16x8*)(SK + (size_t)c * 16384 + nt * 2048 + ks * 32), z);
#pragma unroll
            for (int reg = 0; reg < 4; ++reg)
            { const float zr = z[reg]; L[(c * 16 + quad * 4 + reg) * 128 + nt * 16 + fr] = __builtin_bit_cast(float, (__builtin_bit_cast(unsigned, zr) & ~0x7Fu) | (unsigned)(127 - (nt * 16 + fr))); }
        }
    }
    asm volatile("s_waitcnt lgkmcnt(0)" ::: "memory");
    const unsigned long long TI1 = 0xFEDCBA9811111111ull, TJ0 = 0xFEDCBA9876543210ull, TJ1 = 0x0000000076543210ull,
                             TI2 = 0x6655444333322222ull, TJ2 = 0x1010210321043210ull;
    const int sh = 4 * fr, rb = lane & 48;
    const int i_s[4] = {0, (int)(TI1 >> sh) & 15, (int)(TI2 >> sh) & 15, 7};
    const int j_s[4] = {(int)(TJ0 >> sh) & 15, (int)(TJ1 >> sh) & 15, (int)(TJ2 >> sh) & 15, fr & 1};
#pragma nounroll
    for (int it = 0; it < 4; ++it) {
        const int row = quad * 4 + it;
        float v[8];
#pragma unroll
        for (int nt = 0; nt < 8; ++nt) v[nt] = L[row * 128 + nt * 16 + fr];
        const float t0 = select16(v, fr);
#pragma unroll
        for (int nt = 0; nt < 8; ++nt) v[nt] = L[(16 + row) * 128 + nt * 16 + fr];
        const float t1 = select16(v, fr);
        float val[4], cur[4]; int idx[4], rec[4];
#pragma unroll
        for (int s4 = 0; s4 < 4; ++s4) {
            const float a = __builtin_bit_cast(float, __builtin_amdgcn_ds_bpermute((rb + i_s[s4]) * 4, __builtin_bit_cast(int, t0)));
            const float b = __builtin_bit_cast(float, __builtin_amdgcn_ds_bpermute((rb + j_s[s4]) * 4, __builtin_bit_cast(int, t1)));
            float sm = __builtin_bit_cast(float, (__builtin_bit_cast(unsigned, a + b) & ~0x3Fu) | (unsigned)(63 - (s4 * 16 + fr)));
            if (s4 == 3 && fr >= 2) sm = NINF;
            val[s4] = sm; cur[s4] = sm; rec[s4] = -1;
            idx[s4] = (127 - (int)(__builtin_bit_cast(unsigned, a) & 0x7Fu)) * 128 + (127 - (int)(__builtin_bit_cast(unsigned, b) & 0x7Fu));
        }
        float gmax = 0.f, ssum = 0.f;
#pragma unroll
        for (int rd = 0; rd < 16; ++rd) {
            const float gm = rowmax16d(vmax(vmax(cur[0], cur[1]), vmax(cur[2], cur[3])));
            if (rd == 0) gmax = gm;
            ssum += __expf(gm - gmax);
#pragma unroll
            for (int s4 = 0; s4 < 4; ++s4) { const bool own = (cur[s4] == gm); cur[s4] = own ? NINF : cur[s4]; rec[s4] = own ? rd : rec[s4]; }
        }
        const float inv = 1.f / ssum; const size_t ob = ((size_t)(tok0 + row) * 8 + h) * 16;
#pragma unroll
        for (int s4 = 0; s4 < 4; ++s4) if (rec[s4] >= 0) { pidx[ob + rec[s4]] = idx[s4]; pgate[ob + rec[s4]] = __expf(val[s4] - gmax) * inv; }
    }
    asm volatile("s_waitcnt lgkmcnt(0)" ::: "memory");
}

constexpr int TK_SKROW = 272, TK_SK_BYTES = 256 * TK_SKROW, TK_L_OFF = TK_SK_BYTES, TK_LT_OFF = TK_L_OFF + 8 * 8192, TK_LDS_END = TK_LT_OFF + 8 * 1024;
DEV void topk3_phase(const KArgs& A, LAS unsigned char* lds, int lane, int wave, int G) {
    unsigned char* ws = A.ws;
    const int fr = lane & 15, quad = lane >> 4, tid = wave * 64 + lane;
    const int h = blockIdx.x & 7, grp = blockIdx.x >> 3, ngrp = G >> 3;
    {
        const unsigned char* src = ws + WS_SK + (size_t)h * 65536;
#pragma unroll
        for (int i = 0; i < 8; ++i) { const int q = tid + 512 * i, row = q >> 4, c16 = q & 15; *(LAS u32x4*)(lds + row * TK_SKROW + c16 * 16) = *(const u32x4*)(src + (size_t)q * 16); }
        asm volatile("s_waitcnt vmcnt(0) lgkmcnt(0)" ::: "memory");
        __builtin_amdgcn_s_barrier();
        asm volatile("" ::: "memory");
    }
    LAS float* L = (LAS float*)(lds + TK_L_OFF + wave * 8192);
    LAS float* Lt = (LAS float*)(lds + TK_LT_OFF + wave * 1024);
    const LAS unsigned char* skb = lds + fr * TK_SKROW + quad * 16;
    int* pidx = (int*)(ws + WS_S5); float* pgate = (float*)(ws + WS_S5 + (size_t)T * 512);
    const float NINF = -__builtin_inff();
    const unsigned long long TI1 = 0xFEDCBA9811111111ull, TJ0 = 0xFEDCBA9876543210ull, TJ1 = 0x0000000076543210ull,
                             TI2 = 0x6655444333322222ull, TJ2 = 0x1010210321043210ull;
    const int sh = 4 * fr, rb = lane & 48;
    const int i_s[4] = {0, (int)(TI1 >> sh) & 15, (int)(TI2 >> sh) & 15, 7};
    const int j_s[4] = {(int)(TJ0 >> sh) & 15, (int)(TJ1 >> sh) & 15, (int)(TJ2 >> sh) & 15, fr & 1};
#pragma nounroll
    for (int tt = grp + ngrp * wave; tt < T / 16; tt += ngrp * 8) {
        const int tok0 = tt * 16;
        const bf16_t* pq = (const bf16_t*)(ws + WS_S1) + (size_t)(tok0 + fr) * 2048 + h * 256 + quad * 8;
        bf16x8 qa[2][4];
#pragma unroll
        for (int c = 0; c < 2; ++c)
#pragma unroll
            for (int ks = 0; ks < 4; ++ks) qa[c][ks] = *(const bf16x8*)(pq + c * 128 + ks * 32);
#pragma unroll
        for (int c = 0; c < 2; ++c) {
#pragma unroll
            for (int nt = 0; nt < 8; ++nt) {
                f32x4 z = {0.f, 0.f, 0.f, 0.f};
#pragma unroll
                for (int ks = 0; ks < 4; ++ks) z = mfma16(qa[c][ks], *(const LAS bf16x8*)(skb + (c * 128 + nt * 16) * TK_SKROW + ks * 64), z);
#pragma unroll
                for (int reg = 0; reg < 4; ++reg)
                { const float zr = z[reg]; L[(quad * 4 + reg) * 128 + nt * 16 + fr] = __builtin_bit_cast(float, (__builtin_bit_cast(unsigned, zr) & ~0x7Fu) | (unsigned)(127 - (nt * 16 + fr))); }
            }
            asm volatile("s_waitcnt lgkmcnt(0)" ::: "memory");
#pragma nounroll
            for (int it = 0; it < 4; ++it) {
                const int row = quad * 4 + it;
                float v[8];
#pragma unroll
                for (int nt = 0; nt < 8; ++nt) v[nt] = L[row * 128 + nt * 16 + fr];
                const float tc = select16(v, fr);
                if (c == 0) { Lt[row * 16 + fr] = tc; }
                else {
                    const float t1 = tc, t0 = Lt[row * 16 + fr];
                    float val[4], cur[4]; int idx[4], rec[4];
#pragma unroll
                    for (int s4 = 0; s4 < 4; ++s4) {
                        const float a = __builtin_bit_cast(float, __builtin_amdgcn_ds_bpermute((rb + i_s[s4]) * 4, __builtin_bit_cast(int, t0)));
                        const float b = __builtin_bit_cast(float, __builtin_amdgcn_ds_bpermute((rb + j_s[s4]) * 4, __builtin_bit_cast(int, t1)));
                        float sm = __builtin_bit_cast(float, (__builtin_bit_cast(unsigned, a + b) & ~0x3Fu) | (unsigned)(63 - (s4 * 16 + fr)));
                        if (s4 == 3 && fr >= 2) sm = NINF;
                        val[s4] = sm; cur[s4] = sm; rec[s4] = -1;
                        idx[s4] = (127 - (int)(__builtin_bit_cast(unsigned, a) & 0x7Fu)) * 128 + (127 - (int)(__builtin_bit_cast(unsigned, b) & 0x7Fu));
                    }
                    float gmax = 0.f, ssum = 0.f;
#pragma unroll
                    for (int rd = 0; rd < 16; ++rd) {
                        const float gm = rowmax16d(vmax(vmax(cur[0], cur[1]), vmax(cur[2], cur[3])));
                        if (rd == 0) gmax = gm;
                        ssum += __expf(gm - gmax);
#pragma unroll
                        for (int s4 = 0; s4 < 4; ++s4) { const bool own = (cur[s4] == gm); cur[s4] = own ? NINF : cur[s4]; rec[s4] = own ? rd : rec[s4]; }
                    }
                    const float inv = __builtin_amdgcn_rcpf(ssum); const size_t ob = ((size_t)(tok0 + row) * 8 + h) * 16;
#pragma unroll
                    for (int s4 = 0; s4 < 4; ++s4) if (rec[s4] >= 0) { pidx[ob + rec[s4]] = idx[s4]; pgate[ob + rec[s4]] = __expf(val[s4] - gmax) * inv; }
                }
            }
            asm volatile("s_waitcnt lgkmcnt(0)" ::: "memory");
        }
    }
}

DEV float wave_max(float v) {
#pragma unroll
    for (int o = 1; o < 64; o <<= 1) v = fmaxf(v, __shfl_xor(v, o));
    return v;
}
DEV void topk_ref_task(const KArgs& A, int task, LAS float* L  , int lane) {
    unsigned char* ws = A.ws;
    const int tok = task >> 3, h = task & 7;
    const bf16_t* pq = (const bf16_t*)(ws + WS_S1) + (size_t)tok * 2048 + h * 256;
    const bf16_t* SK = (const bf16_t*)(ws + WS_SK) + (size_t)(h * 2) * 16384;
    int* pidx = (int*)(ws + WS_S5); float* pgate = (float*)(ws + WS_S5 + (size_t)T * 512);
    const float NINF = -__builtin_inff();
    LAS float* qf = L;
    LAS float* tv = L + 256;
    LAS int* ti = (LAS int*)(L + 288);
    LAS float* bv = L + 320;
    LAS int* bi = (LAS int*)(L + 336);
    { const unsigned long long w = *(const unsigned long long*)(pq + lane * 4); const unsigned lo = (unsigned)w, hi = (unsigned)(w >> 32);
      qf[lane * 4] = bflo(lo); qf[lane * 4 + 1] = bfhi(lo); qf[lane * 4 + 2] = bflo(hi); qf[lane * 4 + 3] = bfhi(hi); }
    asm volatile("s_waitcnt lgkmcnt(0)" ::: "memory");
    float sc[4];
#pragma unroll
    for (int e = 0; e < 4; ++e) {
        const int p = lane + 64 * e, c = p >> 7, n = p & 127; const bf16_t* kr = SK + (size_t)(c * 128 + n) * 128; float s = 0.f;
#pragma nounroll
        for (int d = 0; d < 128; d += 8) { float kv[8]; ld8bf(kr + d, kv);
#pragma unroll
            for (int j = 0; j < 8; ++j) s += qf[c * 128 + d + j] * kv[j]; }
        sc[e] = s;
    }
#pragma unroll
    for (int c = 0; c < 2; ++c)
#pragma nounroll
        for (int rd = 0; rd < 16; ++rd) {
            const float m = wave_max(fmaxf(sc[2 * c], sc[2 * c + 1]));
            if (sc[2 * c] == m) { sc[2 * c] = NINF; tv[c * 16 + rd] = m; ti[c * 16 + rd] = (lane + 128 * c) & 127; }
            else if (sc[2 * c + 1] == m) { sc[2 * c + 1] = NINF; tv[c * 16 + rd] = m; ti[c * 16 + rd] = (lane + 64 + 128 * c) & 127; }
        }
    asm volatile("s_waitcnt lgkmcnt(0)" ::: "memory");
    float cd[4];
#pragma unroll
    for (int e = 0; e < 4; ++e) { const int p = lane * 4 + e; cd[e] = tv[p >> 4] + tv[16 + (p & 15)]; }
#pragma nounroll
    for (int rd = 0; rd < 16; ++rd) {
        const float m = wave_max(fmaxf(fmaxf(cd[0], cd[1]), fmaxf(cd[2], cd[3])));
        int pe = -1;
#pragma unroll
        for (int e = 3; e >= 0; --e) if (cd[e] == m) pe = e;
        if (pe >= 0) {
#pragma unroll
            for (int e = 0; e < 4; ++e) if (e == pe) cd[e] = NINF;
            const int p = lane * 4 + pe; bv[rd] = m; bi[rd] = ti[p >> 4] * 128 + ti[16 + (p & 15)];
        }
    }
    asm volatile("s_waitcnt lgkmcnt(0)" ::: "memory");
    if (lane < 16) {
        const float b = bv[lane], mx = bv[0]; const float e = __expf(b - mx); float ssum = rowsum16(e);
        const size_t o = ((size_t)tok * 8 + h) * 16 + lane; pidx[o] = bi[lane]; pgate[o] = e / ssum;
    }
    asm volatile("s_waitcnt lgkmcnt(0)" ::: "memory");
}

typedef float f32x2 __attribute__((ext_vector_type(2)));
DEV void cvt16(const u32x4 q, f32x2 (&f)[8]) {
    const int q0 = (int)q.x, q1 = (int)q.y, q2 = (int)q.z, q3 = (int)q.w;
    f[0] = __builtin_amdgcn_cvt_pk_f32_fp8(q0, false); f[1] = __builtin_amdgcn_cvt_pk_f32_fp8(q0, true);
    f[2] = __builtin_amdgcn_cvt_pk_f32_fp8(q1, false); f[3] = __builtin_amdgcn_cvt_pk_f32_fp8(q1, true);
    f[4] = __builtin_amdgcn_cvt_pk_f32_fp8(q2, false); f[5] = __builtin_amdgcn_cvt_pk_f32_fp8(q2, true);
    f[6] = __builtin_amdgcn_cvt_pk_f32_fp8(q3, false); f[7] = __builtin_amdgcn_cvt_pk_f32_fp8(q3, true);
}
DEV void peer_token(const KArgs& A, int tok, int lane) {
    unsigned char* ws = A.ws;
    float* x1 = A.out + (size_t)tok * 1024 + lane * 16;
    const unsigned char* PU = ws + WS_PU + lane * 16; const unsigned char* PV = ws + WS_PV + lane * 16;
    const int* pidx = (const int*)(ws + WS_S5); const float* pgate = (const float*)(ws + WS_S5 + (size_t)T * 512);
    const float rs = rsqrtf(((const float*)(ws + WS_SSQ2))[tok] * (1.f / 1024.f) + EPS);
    f32x2 xs[8];
    { float a[8], b[8], ga[8], gb[8]; ld8f(x1, a); ld8f(x1 + 8, b); ld8f(A.in[18] + lane * 16, ga); ld8f(A.in[18] + lane * 16 + 8, gb);
#pragma unroll
      for (int i = 0; i < 4; ++i) { xs[i] = (f32x2){a[2 * i] * rs * ga[2 * i], a[2 * i + 1] * rs * ga[2 * i + 1]}; xs[4 + i] = (f32x2){b[2 * i] * rs * gb[2 * i], b[2 * i + 1] * rs * gb[2 * i + 1]}; } }
    f32x2 o[8];
#pragma unroll
    for (int i = 0; i < 8; ++i) o[i] = (f32x2){0.f, 0.f};
    const int* pi = pidx + (size_t)tok * 128 + (lane >> 2); const float* pg = pgate + (size_t)tok * 128 + (lane >> 2);
    int eidx = pi[0];
    u32x4 uq[16];
#pragma unroll
    for (int k = 0; k < 16; ++k) { const int row = __builtin_amdgcn_readlane(eidx, 4 * k); uq[k] = *(const u32x4*)(PU + (size_t)row * 1024); }
#pragma nounroll
    for (int h = 0; h < 8; ++h) {
        const float gt = pg[h * 16];
        const int enext = pi[(h < 7 ? h + 1 : 7) * 16];
        u32x4 vq[16];
#pragma unroll
        for (int k = 0; k < 16; ++k) { const int row = __builtin_amdgcn_readlane(eidx, 4 * k); vq[k] = *(const u32x4*)(PV + (size_t)row * 1024); }
        float part[16];
#pragma unroll
        for (int k = 0; k < 16; ++k) { f32x2 f[8]; cvt16(uq[k], f); f32x2 acc = f[0] * xs[0];
#pragma unroll
            for (int i = 1; i < 8; ++i) acc += f[i] * xs[i];
            part[k] = acc.x + acc.y; }
        eidx = enext;
#pragma unroll
        for (int k = 0; k < 16; ++k) { const int row = __builtin_amdgcn_readlane(eidx, 4 * k); uq[k] = *(const u32x4*)(PU + (size_t)row * 1024); }
        float r8[8], r4[4], r2[2];
        const bool b5 = lane & 32, b4 = lane & 16, b3 = lane & 8, b2 = lane & 4;
#pragma unroll
        for (int i = 0; i < 8; ++i) { const float keep = b5 ? part[i + 8] : part[i], send = b5 ? part[i] : part[i + 8]; r8[i] = keep + __shfl_xor(send, 32); }
#pragma unroll
        for (int i = 0; i < 4; ++i) { const float keep = b4 ? r8[i + 4] : r8[i], send = b4 ? r8[i] : r8[i + 4]; r4[i] = keep + __shfl_xor(send, 16); }
#pragma unroll
        for (int i = 0; i < 2; ++i) { const float keep = b3 ? r4[i + 2] : r4[i], send = b3 ? r4[i] : r4[i + 2]; r2[i] = keep + __shfl_xor(send, 8); }
        float act = (b2 ? r2[1] : r2[0]) + __shfl_xor(b2 ? r2[0] : r2[1], 4);
        act += __shfl_xor(act, 2); act += __shfl_xor(act, 1);
        const float w = gt * gelu_t(act * (1.f / 256.f)) * (1.f / 64.f);
#pragma unroll
        for (int k = 0; k < 16; ++k) { const float wk = __builtin_bit_cast(float, __builtin_amdgcn_readlane(__builtin_bit_cast(int, w), 4 * k)); const f32x2 w2 = {wk, wk}; f32x2 f[8]; cvt16(vq[k], f);
#pragma unroll
            for (int i = 0; i < 8; ++i) o[i] += w2 * f[i]; }
    }
    float a[8], b[8]; ld8f(x1, a); ld8f(x1 + 8, b);
    float ss = 0.f;
#pragma unroll
    for (int i = 0; i < 4; ++i) { a[2 * i] += o[i].x; a[2 * i + 1] += o[i].y; b[2 * i] += o[4 + i].x; b[2 * i + 1] += o[4 + i].y; }
#pragma unroll
    for (int i = 0; i < 8; ++i) ss += a[i] * a[i] + b[i] * b[i];
    st8f(x1, a); st8f(x1 + 8, b);
    bf16_t* x2b = (bf16_t*)(ws + WS_S2) + (size_t)tok * 1024 + lane * 16;
    st8bf(x2b, a); st8bf(x2b + 8, b);
    ss = wave_sum(ss);
    if (lane == 0) ((float*)(ws + WS_RSTD3))[tok] = rsqrtf(ss * (1.f / 1024.f) + EPS);
}

DEV void cvt32(const u32x4 q, f32x2 (&f)[16]) {
    const unsigned q0 = q.x, q1 = q.y, q2 = q.z, q3 = q.w;
    f[0] = __builtin_amdgcn_cvt_scalef32_pk_f32_fp4(q0, 1.0f, 0); f[1] = __builtin_amdgcn_cvt_scalef32_pk_f32_fp4(q0, 1.0f, 1); f[2] = __builtin_amdgcn_cvt_scalef32_pk_f32_fp4(q0, 1.0f, 2); f[3] = __builtin_amdgcn_cvt_scalef32_pk_f32_fp4(q0, 1.0f, 3);
    f[4] = __builtin_amdgcn_cvt_scalef32_pk_f32_fp4(q1, 1.0f, 0); f[5] = __builtin_amdgcn_cvt_scalef32_pk_f32_fp4(q1, 1.0f, 1); f[6] = __builtin_amdgcn_cvt_scalef32_pk_f32_fp4(q1, 1.0f, 2); f[7] = __builtin_amdgcn_cvt_scalef32_pk_f32_fp4(q1, 1.0f, 3);
    f[8] = __builtin_amdgcn_cvt_scalef32_pk_f32_fp4(q2, 1.0f, 0); f[9] = __builtin_amdgcn_cvt_scalef32_pk_f32_fp4(q2, 1.0f, 1); f[10] = __builtin_amdgcn_cvt_scalef32_pk_f32_fp4(q2, 1.0f, 2); f[11] = __builtin_amdgcn_cvt_scalef32_pk_f32_fp4(q2, 1.0f, 3);
    f[12] = __builtin_amdgcn_cvt_scalef32_pk_f32_fp4(q3, 1.0f, 0); f[13] = __builtin_amdgcn_cvt_scalef32_pk_f32_fp4(q3, 1.0f, 1); f[14] = __builtin_amdgcn_cvt_scalef32_pk_f32_fp4(q3, 1.0f, 2); f[15] = __builtin_amdgcn_cvt_scalef32_pk_f32_fp4(q3, 1.0f, 3);
}
DEV void peer_token4(const KArgs& A, int tok, int lane) {
    unsigned char* ws = A.ws;
    const int half = lane >> 5, sub = lane & 31;
    const bf16_t* x1 = (const bf16_t*)(ws + WS_S3) + (size_t)tok * 1024 + sub * 32;
    const unsigned char* PU = ws + WS_PU + sub * 16; const unsigned char* PV = ws + WS_PV + sub * 16;
    const int e_l = (half << 3) | ((lane >> 2) & 7);
    const int* pi = (const int*)(ws + WS_S5) + (size_t)tok * 128 + e_l; const float* pg = (const float*)(ws + WS_S5 + (size_t)T * 512) + (size_t)tok * 128 + e_l;
    const float rs = rsqrtf(((const float*)(ws + WS_SSQ2))[tok] * (1.f / 1024.f) + EPS);
    f32x2 xs[16];
#pragma unroll
    for (int j = 0; j < 4; ++j) { float a[8], g[8]; ld8bf(x1 + 8 * j, a); ld8f(A.in[18] + sub * 32 + 8 * j, g);
#pragma unroll
        for (int i = 0; i < 4; ++i) xs[4 * j + i] = (f32x2){a[2 * i] * rs * g[2 * i], a[2 * i + 1] * rs * g[2 * i + 1]}; }
    f32x2 o[16];
#pragma unroll
    for (int i = 0; i < 16; ++i) o[i] = (f32x2){0.f, 0.f};
    const bool b4 = lane & 16, b3 = lane & 8, b2 = lane & 4;
#pragma nounroll
    for (int h = 0; h < 8; ++h) {
        const int eidx = pi[h * 16]; const float gt = pg[h * 16];
        float part[8];
        {
            u32x4 uq[8];
#pragma unroll
            for (int k = 0; k < 8; ++k) { const int r0 = __builtin_amdgcn_readlane(eidx, 4 * k), r1 = __builtin_amdgcn_readlane(eidx, 32 + 4 * k); uq[k] = *(const u32x4*)(PU + (size_t)(half ? r1 : r0) * 512); }
#pragma unroll
            for (int k = 0; k < 8; ++k) { f32x2 f[16]; cvt32(uq[k], f); f32x2 acc = f[0] * xs[0];
#pragma unroll
                for (int i = 1; i < 16; ++i) acc += f[i] * xs[i];
                part[k] = acc.x + acc.y; }
        }
        float r4[4], r2[2];
#pragma unroll
        for (int i = 0; i < 4; ++i) { const float keep = b4 ? part[i + 4] : part[i], send = b4 ? part[i] : part[i + 4]; r4[i] = keep + __shfl_xor(send, 16); }
#pragma unroll
        for (int i = 0; i < 2; ++i) { const float keep = b3 ? r4[i + 2] : r4[i], send = b3 ? r4[i] : r4[i + 2]; r2[i] = keep + __shfl_xor(send, 8); }
        float act = (b2 ? r2[1] : r2[0]) + __shfl_xor(b2 ? r2[0] : r2[1], 4);
        act += __shfl_xor(act, 2); act += __shfl_xor(act, 1);
        const float w = gt * gelu_t(act * (1.f / PEER_SU)) * (1.f / PEER_SV);
        {
            u32x4 vq[8];
#pragma unroll
            for (int k = 0; k < 8; ++k) { const int r0 = __builtin_amdgcn_readlane(eidx, 4 * k), r1 = __builtin_amdgcn_readlane(eidx, 32 + 4 * k); vq[k] = *(const u32x4*)(PV + (size_t)(half ? r1 : r0) * 512); }
#pragma unroll
            for (int k = 0; k < 8; ++k) {
                const float w0 = __builtin_bit_cast(float, __builtin_amdgcn_readlane(__builtin_bit_cast(int, w), 4 * k)), w1 = __builtin_bit_cast(float, __builtin_amdgcn_readlane(__builtin_bit_cast(int, w), 32 + 4 * k));
                const float wk = half ? w1 : w0; const f32x2 w2 = {wk, wk}; f32x2 f[16]; cvt32(vq[k], f);
#pragma unroll
                for (int i = 0; i < 16; ++i) o[i] += w2 * f[i]; }
        }
    }
    float a[8], b[8];
#pragma unroll
    for (int i = 0; i < 8; ++i) {
        const float lo0 = o[i].x + __shfl_xor(o[i].x, 32), lo1 = o[i].y + __shfl_xor(o[i].y, 32), hi0 = o[8 + i].x + __shfl_xor(o[8 + i].x, 32), hi1 = o[8 + i].y + __shfl_xor(o[8 + i].y, 32);
        const float e0 = half ? hi0 : lo0, e1 = half ? hi1 : lo1;
        if (i < 4) { a[2 * i] = e0; a[2 * i + 1] = e1; } else { b[2 * (i - 4)] = e0; b[2 * (i - 4) + 1] = e1; }
    }
    float xa[8], xb[8]; ld8bf(x1 + half * 16, xa); ld8bf(x1 + half * 16 + 8, xb);
    float ss = 0.f;
#pragma unroll
    for (int i = 0; i < 8; ++i) { a[i] += xa[i]; b[i] += xb[i]; ss += a[i] * a[i] + b[i] * b[i]; }
    bf16_t* x2b = (bf16_t*)(ws + WS_S2) + (size_t)tok * 1024 + sub * 32 + half * 16;
    st8bf(x2b, a); st8bf(x2b + 8, b);
    ss = wave_sum(ss);
    if (lane == 0) ((float*)(ws + WS_RSTD3))[tok] = rsqrtf(ss * (1.f / 1024.f) + EPS);
}

typedef int v8i_t __attribute__((ext_vector_type(8)));
DEV unsigned pk4_e4m3(float a, float b, float c, float d) { int p = __builtin_amdgcn_cvt_pk_fp8_f32(a, b, 0, false); p = __builtin_amdgcn_cvt_pk_fp8_f32(c, d, p, true); return (unsigned)p; }
DEV void peer_token5(const KArgs& A, int tok, int lane, LAS unsigned char* xq  , const int h0, const int h1, LAS float* xsend, const LAS float* xrecv, const bool do_bar) {
    unsigned char* ws = A.ws;
    const int fr = lane & 15, quad = lane >> 4, half = lane >> 5, sub = lane & 31;
    const bf16_t* x1 = (const bf16_t*)(ws + WS_S3) + (size_t)tok * 1024;
    const unsigned char* PU = ws + WS_PU + quad * 16; const unsigned char* PV = ws + WS_PV + sub * 16;
    const int* pi = (const int*)(ws + WS_S5) + (size_t)tok * 128 + fr; const float* pg = (const float*)(ws + WS_S5 + (size_t)T * 512) + (size_t)tok * 128 + quad * 4;
    const float rs = rsqrtf(((const float*)(ws + WS_SSQ2))[tok] * (1.f / 1024.f) + EPS);
    {
        float a[8], b[8], ga[8], gb[8]; ld8bf(x1 + lane * 16, a); ld8bf(x1 + lane * 16 + 8, b); ld8f(A.in[18] + lane * 16, ga); ld8f(A.in[18] + lane * 16 + 8, gb);
#pragma unroll
        for (int i = 0; i < 8; ++i) { a[i] *= rs * ga[i]; b[i] *= rs * gb[i]; }
        const unsigned h0 = pk8_fp4(a, 1.f), h1 = pk8_fp4(b, 1.f);
        float ra[8], rb[8];
#define XRES(i) { const f32x2 d0 = __builtin_amdgcn_cvt_scalef32_pk_f32_fp4(h0, 1.0f, i), d1 = __builtin_amdgcn_cvt_scalef32_pk_f32_fp4(h1, 1.0f, i); \
            ra[2 * i] = a[2 * i] - d0.x; ra[2 * i + 1] = a[2 * i + 1] - d0.y; rb[2 * i] = b[2 * i] - d1.x; rb[2 * i + 1] = b[2 * i + 1] - d1.y; }
        XRES(0) XRES(1) XRES(2) XRES(3)
#undef XRES
        const unsigned l0 = pk8_fp4(ra, 8.f), l1 = pk8_fp4(rb, 8.f);
        *(LAS u32x2*)(xq + lane * 8) = (u32x2){h0, h1};
        *(LAS u32x2*)(xq + 512 + lane * 8) = (u32x2){l0, l1};
    }
    asm volatile("s_waitcnt lgkmcnt(0)" ::: "memory");
    u32x4 xh[8], xl[8];
#pragma unroll
    for (int ks = 0; ks < 8; ++ks) { xh[ks] = *(const LAS u32x4*)(xq + ks * 64 + quad * 16); xl[ks] = *(const LAS u32x4*)(xq + 512 + ks * 64 + quad * 16); }
    f32x2 o[16];
#pragma unroll
    for (int i = 0; i < 16; ++i) o[i] = (f32x2){0.f, 0.f};
    int idx_l = pi[h0 * 16]; f32x4 gt4 = *(const f32x4*)(pg + h0 * 16);
    u32x4 ua[8];
#pragma unroll
    for (int ks = 0; ks < 8; ++ks) ua[ks] = *(const u32x4*)(PU + (size_t)idx_l * 512 + ks * 64);
#pragma nounroll
    for (int h = h0; h < h1; ++h) {
        const int hn = h < h1 - 1 ? h + 1 : h1 - 1;
        const int idx_n = pi[hn * 16]; const f32x4 gt_n = *(const f32x4*)(pg + hn * 16);
        u32x4 vq[8];
#pragma unroll
        for (int k = 0; k < 8; ++k) { const int r0 = __builtin_amdgcn_readlane(idx_l, k), r1 = __builtin_amdgcn_readlane(idx_l, k + 8); vq[k] = *(const u32x4*)(PV + (size_t)(half ? r1 : r0) * 512); }
        f32x4 c = {0.f, 0.f, 0.f, 0.f};
#pragma unroll
        for (int ks = 0; ks < 8; ++ks) { const u32x4 u = ua[ks], bh = xh[ks], bl = xl[ks];
            const v8i_t av = {(int)u.x, (int)u.y, (int)u.z, (int)u.w, 0, 0, 0, 0}, bhv = {(int)bh.x, (int)bh.y, (int)bh.z, (int)bh.w, 0, 0, 0, 0}, blv = {(int)bl.x, (int)bl.y, (int)bl.z, (int)bl.w, 0, 0, 0, 0};
            c = __builtin_amdgcn_mfma_scale_f32_16x16x128_f8f6f4(av, bhv, c, 4, 4, 0, 0x7F7F7F7F, 0, 0x7F7F7F7F);
            c = __builtin_amdgcn_mfma_scale_f32_16x16x128_f8f6f4(av, blv, c, 4, 4, 0, 0x7F7F7F7F, 0, 0x7C7C7C7C); }
#pragma unroll
        for (int ks = 0; ks < 8; ++ks) ua[ks] = *(const u32x4*)(PU + (size_t)idx_n * 512 + ks * 64);
        float w[4];
        { const float c0 = c[0], c1 = c[1], c2 = c[2], c3 = c[3], g0 = gt4[0], g1 = gt4[1], g2 = gt4[2], g3 = gt4[3];
          w[0] = g0 * gelu_t(c0 * (1.f / PEER_SU)) * (1.f / PEER_SV); w[1] = g1 * gelu_t(c1 * (1.f / PEER_SU)) * (1.f / PEER_SV);
          w[2] = g2 * gelu_t(c2 * (1.f / PEER_SU)) * (1.f / PEER_SV); w[3] = g3 * gelu_t(c3 * (1.f / PEER_SU)) * (1.f / PEER_SV); }
#pragma unroll
        for (int k = 0; k < 8; ++k) {
            const float w0 = __builtin_bit_cast(float, __builtin_amdgcn_readlane(__builtin_bit_cast(int, w[k & 3]), 16 * (k >> 2))), w1 = __builtin_bit_cast(float, __builtin_amdgcn_readlane(__builtin_bit_cast(int, w[k & 3]), 16 * ((k + 8) >> 2)));
            const float wk = half ? w1 : w0; const f32x2 w2 = {wk, wk}; f32x2 f[16]; cvt32(vq[k], f);
#pragma unroll
            for (int i = 0; i < 16; ++i) o[i] += w2 * f[i]; }
        idx_l = idx_n; gt4 = gt_n;
    }
    float a[8], b[8];
#pragma unroll
    for (int i = 0; i < 8; ++i) {
        const float lo0 = o[i].x + __shfl_xor(o[i].x, 32), lo1 = o[i].y + __shfl_xor(o[i].y, 32), hi0 = o[8 + i].x + __shfl_xor(o[8 + i].x, 32), hi1 = o[8 + i].y + __shfl_xor(o[8 + i].y, 32);
        const float e0 = half ? hi0 : lo0, e1 = half ? hi1 : lo1;
        if (i < 4) { a[2 * i] = e0; a[2 * i + 1] = e1; } else { b[2 * (i - 4)] = e0; b[2 * (i - 4) + 1] = e1; }
    }
    if (xsend) { *(LAS f32x4*)(xsend + lane * 16) = (f32x4){a[0], a[1], a[2], a[3]}; *(LAS f32x4*)(xsend + lane * 16 + 4) = (f32x4){a[4], a[5], a[6], a[7]};
                 *(LAS f32x4*)(xsend + lane * 16 + 8) = (f32x4){b[0], b[1], b[2], b[3]}; *(LAS f32x4*)(xsend + lane * 16 + 12) = (f32x4){b[4], b[5], b[6], b[7]}; }
    if (do_bar) { asm volatile("s_waitcnt lgkmcnt(0)" ::: "memory"); __builtin_amdgcn_s_barrier(); asm volatile("" ::: "memory"); }
    if (xsend) return;
    if (xrecv) { const f32x4 r0 = *(const LAS f32x4*)(xrecv + lane * 16), r1 = *(const LAS f32x4*)(xrecv + lane * 16 + 4), r2 = *(const LAS f32x4*)(xrecv + lane * 16 + 8), r3 = *(const LAS f32x4*)(xrecv + lane * 16 + 12);
        a[0] += r0.x; a[1] += r0.y; a[2] += r0.z; a[3] += r0.w; a[4] += r1.x; a[5] += r1.y; a[6] += r1.z; a[7] += r1.w;
        b[0] += r2.x; b[1] += r2.y; b[2] += r2.z; b[3] += r2.w; b[4] += r3.x; b[5] += r3.y; b[6] += r3.z; b[7] += r3.w; }
    float xa[8], xb[8]; ld8bf(x1 + sub * 32 + half * 16, xa); ld8bf(x1 + sub * 32 + half * 16 + 8, xb);
    float ss = 0.f;
#pragma unroll
    for (int i = 0; i < 8; ++i) { a[i] += xa[i]; b[i] += xb[i]; ss += a[i] * a[i] + b[i] * b[i]; }
    bf16_t* x2b = (bf16_t*)(ws + WS_S2) + (size_t)tok * 1024 + sub * 32 + half * 16;
    st8bf(x2b, a); st8bf(x2b + 8, b);
    ss = wave_sum(ss);
    if (lane == 0) ((float*)(ws + WS_RSTD3))[tok] = rsqrtf(ss * (1.f / 1024.f) + EPS);
}

DEV int lane_id_asm() { int l; asm volatile("v_mbcnt_lo_u32_b32 %0, -1, 0\n\tv_mbcnt_hi_u32_b32 %0, -1, %0" : "=v"(l)); return l; }
DEV void grid_bar(unsigned* ctr, unsigned target, bool leader) {
    asm volatile("s_waitcnt vmcnt(0) lgkmcnt(0)" ::: "memory");
    __builtin_amdgcn_s_barrier();
    if (leader) {
        __builtin_amdgcn_fence(__ATOMIC_RELEASE, "agent");
        asm volatile("s_waitcnt vmcnt(0)" ::: "memory");
        (void)__hip_atomic_fetch_add(ctr, 1u, __ATOMIC_RELAXED, __HIP_MEMORY_SCOPE_AGENT);
        while (__hip_atomic_load(ctr, __ATOMIC_RELAXED, __HIP_MEMORY_SCOPE_AGENT) < target) __builtin_amdgcn_s_sleep(2);
        __builtin_amdgcn_fence(__ATOMIC_ACQUIRE, "agent");
        asm volatile("s_waitcnt vmcnt(0)" ::: "memory");
    }
    __builtin_amdgcn_s_barrier();
}
#define XB_TMO      128
#define XB_XCNT(j)  (256  + 64 * (j))
#define XB_XSUB(j)  (1280 + 64 * (j))
#define XB_XGEN(j)  (2304 + 64 * (j))
#define XB_TOP      3328
#define XB_TOPGEN   3392
#define XCD_BAR_WORDS 3456
#define XB_SPIN_CAP (1u << 20)
DEV unsigned xb_ld(unsigned* p)              { return __hip_atomic_load(p, __ATOMIC_RELAXED, __HIP_MEMORY_SCOPE_AGENT); }
DEV unsigned xb_add(unsigned* p, unsigned v) { return __hip_atomic_fetch_add(p, v, __ATOMIC_RELAXED, __HIP_MEMORY_SCOPE_AGENT); }
DEV unsigned xb_xcc_id() { return (unsigned)__builtin_amdgcn_s_getreg((3 << 11) | 20) & 0xFu; }
#define XB_SPIN(cond, bar) do { unsigned _sp = 0; while (cond) { __builtin_amdgcn_s_sleep(1); \
    if ((++_sp & 255u) == 0u) { if (xb_ld(&(bar)[XB_TMO])) break; if (_sp > XB_SPIN_CAP) { (void)xb_add(&(bar)[XB_TMO], 1u); break; } } } } while (0)
DEV void xcd_bar(unsigned* bar, volatile LAS unsigned* st, bool leader, unsigned G) {
    asm volatile("s_waitcnt vmcnt(0) lgkmcnt(0)" ::: "memory");
    __builtin_amdgcn_s_barrier();
    if (leader) {
        const unsigned x = xb_xcc_id();
        unsigned nloc = st[0], nx = st[1];
        if (nloc == 0u) {
            unsigned sum = 0u, cnt = 0u, mine = 0u, sp = 0u;
            for (;;) { sum = 0u; cnt = 0u; mine = 0u;
#pragma unroll
                for (unsigned j = 0; j < 16; ++j) { const unsigned c = xb_ld(&bar[XB_XCNT(j)]); sum += c; cnt += (c > 0u) ? 1u : 0u; mine = (j == x) ? c : mine; }
                if (sum == G) break;
                __builtin_amdgcn_s_sleep(1);
                if ((++sp & 255u) == 0u) { if (xb_ld(&bar[XB_TMO])) break; if (sp > XB_SPIN_CAP) { (void)xb_add(&bar[XB_TMO], 1u); break; } } }
            nloc = mine > 0u ? mine : 1u; nx = cnt > 0u ? cnt : 1u; st[0] = nloc; st[1] = nx;
        }
        const unsigned old = xb_add(&bar[XB_XSUB(x)], 1u), gen = old / nloc;
        if (old + 1u == (gen + 1u) * nloc) {
            __builtin_amdgcn_fence(__ATOMIC_RELEASE, "agent");
            asm volatile("s_waitcnt vmcnt(0)" ::: "memory");
            const unsigned og = xb_add(&bar[XB_TOP], 1u), tg = og / nx;
            if (og + 1u == (tg + 1u) * nx) (void)xb_add(&bar[XB_TOPGEN], 1u);
            else XB_SPIN(xb_ld(&bar[XB_TOPGEN]) == tg, bar);
            __builtin_amdgcn_fence(__ATOMIC_ACQUIRE, "agent");
            (void)xb_add(&bar[XB_XGEN(x)], 1u);
            asm volatile("s_waitcnt vmcnt(0)" ::: "memory");
        } else {
            XB_SPIN(xb_ld(&bar[XB_XGEN(x)]) == gen, bar);
            __builtin_amdgcn_fence(__ATOMIC_ACQUIRE, "agent");
            asm volatile("s_waitcnt vmcnt(0)" ::: "memory");
        }
    }
    __builtin_amdgcn_s_barrier();
    asm volatile("" ::: "memory");
}
typedef const KArgs __attribute__((address_space(4))) CKArgs;
DEV KArgs fresh_args() {
#if defined(__HIP_DEVICE_COMPILE__)
    CKArgs* p = (CKArgs*)__builtin_amdgcn_kernarg_segment_ptr(); asm volatile("" : "+s"(p)); KArgs r;
#pragma unroll
    for (int i = 0; i < 26; ++i) r.in[i] = p->in[i];
    r.out = p->out; r.ws = p->ws; return r;
#else
    return KArgs{};
#endif
}
__global__ void __launch_bounds__(512, 2) mega(KArgs Akern) {
    extern __shared__ __attribute__((aligned(16))) unsigned char lds_raw[];
    LAS unsigned char* lds = (LAS unsigned char*)lds_raw;
    cg::grid_group grid = cg::this_grid();
    (void)Akern;
    const int G = gridDim.x;
    const int wave_s = __builtin_amdgcn_readfirstlane((int)threadIdx.x >> 6);
    unsigned* bar_ctr;
    volatile LAS unsigned* bar_st = (volatile LAS unsigned*)(lds + LDS_BYTES - 64);
    { const KArgs A0 = fresh_args(); bar_ctr = (unsigned*)(A0.ws + WS_BAR);
      if (blockIdx.x == 0) for (int i = threadIdx.x; i < XCD_BAR_WORDS; i += 512) __hip_atomic_store(bar_ctr + i, 0u, __ATOMIC_RELAXED, __HIP_MEMORY_SCOPE_AGENT);
      if (threadIdx.x == 0) { bar_st[0] = 0u; bar_st[1] = 0u; } }
    grid.sync();
    if (threadIdx.x == 0) (void)xb_add(&bar_ctr[XB_XCNT(xb_xcc_id())], 1u);
#define GRID_SYNC() xcd_bar(bar_ctr, bar_st, wave_s == 0 && lane_id_asm() == 0, (unsigned)G)
#define FRESH_IDS const int lane = lane_id_asm(), wave = wave_s, tid_ = wave * 64 + lane, \
        gw = blockIdx.x * 8 + wave, NGW = G * 8, gtid = blockIdx.x * 512 + tid_, NT = G * 512; const KArgs A = fresh_args(); (void)lane; (void)wave; (void)gw; (void)NGW; (void)gtid; (void)NT
#ifndef GEMM_STAGGER_N
#define GEMM_STAGGER_N 0
#endif
#define GEMM_STAGGER() do { if (GEMM_STAGGER_N > 0 && (blockIdx.x & 1)) { for (int s_ = 0; s_ < GEMM_STAGGER_N; ++s_) __builtin_amdgcn_s_sleep(127); } } while (0)
#ifndef GEMM_ALIGN_EPI
#define GEMM_ALIGN_EPI true
#endif
#define RUN_GEMM(MODE, APTR, BPTR, NN, KK) RUN_GEMM_ON(MODE, APTR, BPTR, NN, KK, G, (int)blockIdx.x)
#define RUN_GEMM_ON(MODE, APTR, BPTR, NN, KK, SG, SC) do { const KArgs A = fresh_args(); unsigned char* ws = A.ws; pg8::Gemm g; g.A = (const bf16_t*)(APTR); g.Bt = (const bf16_t*)(BPTR); g.M = T; g.N = NN; { int kk_ = KK; asm volatile("" : "+s"(kk_)); g.K = kk_; } \
        Epi<MODE> E; E.xp = A.in[0]; E.xs = A.in[1]; E.out = A.out; E.ws = ws; pg8::StaticOrder S; S.init(T, NN, SG, SC); \
        GEMM_STAGGER(); pg8::gemm_phase<Epi<MODE>, pg8::StaticOrder, GEMM_ALIGN_EPI, true>(lds, g, S, E, wave_s); } while (0)
#ifndef SKIP_P0
#ifndef REP_P0
#define REP_P0 1
#endif
#pragma nounroll
    for (int rep = 0; rep < REP_P0; ++rep) { FRESH_IDS; p0_phase(A, lds, lane, wave, gw, NGW, gtid, NT, 0); }
#endif
#ifdef XBAR
    for (int xb = 0; xb < XBAR; ++xb) GRID_SYNC();
#endif
    GRID_SYNC();
#ifndef SKIP_G1
    RUN_GEMM(1, A.out, ws + WS_WIN, 3840, 1024);
#endif
    if (G > 188 && (int)blockIdx.x >= 188) { FRESH_IDS; p0_phase(A, lds, lane, wave, gw - 188 * 8, NGW - 188 * 8, gtid - 188 * 512, NT - 188 * 512, 1); }
    else if (G <= 188) { FRESH_IDS; p0_phase(A, lds, lane, wave, gw, NGW, gtid, NT, 1); }
    GRID_SYNC();
#ifndef SKIP_P2
#ifndef REP_P2
#define REP_P2 1
#endif
#pragma nounroll
    for (int rep = 0; rep < REP_P2; ++rep) { FRESH_IDS; p2_phase(A, gtid, NT); }
#endif
    GRID_SYNC();
#ifndef REP_P3
#define REP_P3 1
#endif
#pragma nounroll
    for (int rep = 0; rep < REP_P3; ++rep) {
        FRESH_IDS;
        LAS bf16_t* P = (LAS bf16_t*)(lds + wave * 5440);
#ifndef SKIP_ATT
        for (int t = gw; t < 16384; t += NGW) attn_task<false>(A, t, P, lane);
        for (int t = gw; t < 512; t += NGW) attn_task<true>(A, t, P, lane);
#endif
#ifndef SKIP_SGU
        for (int t = gw; t < 8192; t += NGW) sgu_task(A, t, lane);
        sgu_small(A, gtid, NT);
#endif
    }
    GRID_SYNC();
#ifndef REP_G4
#define REP_G4 1
#endif
#pragma nounroll
    for (int rep4 = 0; rep4 < REP_G4; ++rep4) {
#ifndef SKIP_G2
    RUN_GEMM(2, ws + WS_S2, ws + WS_WA, 1024, 512);
#endif
#ifndef SKIP_G3
    RUN_GEMM(3, ws + WS_S2 + (size_t)T * 1024, ws + WS_WB, 1024, 512);
#endif
    }
    if (G > 16 && (int)blockIdx.x >= 16) { FRESH_IDS; cvt_fp4(A.in[21], A.ws + WS_PU, 2097152, PEER_SU, gtid - 16 * 512, NT - 16 * 512); p0_phase(A, lds, lane, wave, gw - 16 * 8, NGW - 16 * 8, gtid - 16 * 512, NT - 16 * 512, 2); }
    else if (G <= 16) { FRESH_IDS; cvt_fp4(A.in[21], A.ws + WS_PU, 2097152, PEER_SU, gtid, NT); p0_phase(A, lds, lane, wave, gw, NGW, gtid, NT, 2); }
    GRID_SYNC();
#ifndef SKIP_G4
    RUN_GEMM(4, ws + WS_S4, ws + WS_WOUT, 1024, 1024);
#endif
    if (G > 16 && (int)blockIdx.x >= 16) { FRESH_IDS; cvt_fp4(A.in[22], A.ws + WS_PV, 2097152, PEER_SV, gtid - 16 * 512, NT - 16 * 512); p0_phase(A, lds, lane, wave, gw - 16 * 8, NGW - 16 * 8, gtid - 16 * 512, NT - 16 * 512, 3); }
    else if (G <= 16) { FRESH_IDS; cvt_fp4(A.in[22], A.ws + WS_PV, 2097152, PEER_SV, gtid, NT); p0_phase(A, lds, lane, wave, gw, NGW, gtid, NT, 3); }
    GRID_SYNC();
#ifndef SKIP_G5
#ifndef REP_G6
#define REP_G6 1
#endif
#pragma nounroll
    for (int rep = 0; rep < REP_G6; ++rep) {
    RUN_GEMM(5, ws + WS_S3, ws + WS_WQ, 2048, 1024);
    }
    if (G > 64 && (int)blockIdx.x >= 32) { RUN_GEMM_ON(6, ws + WS_PB, ws + WS_WPLE, 1024, 256, G - 32, (int)blockIdx.x - 32); }
    else if (G <= 64) { RUN_GEMM(6, ws + WS_PB, ws + WS_WPLE, 1024, 256); }
#endif
    GRID_SYNC();
#ifndef SKIP_TOPK
#ifndef REP_P7
#define REP_P7 1
#endif
#pragma nounroll
    for (int rep = 0; rep < REP_P7; ++rep) { FRESH_IDS; LAS float* L = (LAS float*)(lds + wave * 16384);
#ifdef TOPK_REF
      for (int t = gw; t < T * 8; t += NGW) topk_ref_task(A, t, L, lane);
#else
#ifdef TOPK_V1
      for (int t = gw; t < (T / 16) * 8; t += NGW) topk_task(A, t, L, lane);
#else
      if ((G & 7) == 0) topk3_phase(A, lds, lane, wave, G);
      else for (int t = gw; t < (T / 16) * 8; t += NGW) topk2_task(A, t, L, lane);
#endif
#endif
    }
#endif
    GRID_SYNC();
#ifndef SKIP_PEER
#ifndef REP_P8
#define REP_P8 1
#endif
#pragma nounroll
    for (int rep = 0; rep < REP_P8; ++rep) { FRESH_IDS;
#ifdef PEER_V4
      for (int t = gw; t < T; t += NGW) peer_token4(A, t, lane);
#else
      if (NGW == 2048) {
          for (int k = 0; k < 16; ++k) peer_token5(A, gw + k * 2048, lane, lds + wave * 1024, 0, 8, nullptr, nullptr, false);
          const int tl = 32768 + (int)blockIdx.x * 4 + (wave & 3); LAS float* xch = (LAS float*)(lds + 8192 + (wave & 3) * 4096);
          if (wave < 4) peer_token5(A, tl, lane, lds + wave * 1024, 0, 4, nullptr, xch, true);
          else          peer_token5(A, tl, lane, lds + wave * 1024, 4, 8, xch, nullptr, true);
      } else
      for (int t = gw; t < T; t += NGW) peer_token5(A, t, lane, lds + wave * 1024, 0, 8, nullptr, nullptr, false);
#endif
    }
#endif
    GRID_SYNC();
#ifndef REP_G9
#define REP_G9 1
#endif
#pragma nounroll
    for (int rep9 = 0; rep9 < REP_G9; ++rep9) {
#ifndef SKIP_G7
    RUN_GEMM(7, ws + WS_S2, ws + WS_WG, 1024, 1024);
#endif
    }
}

extern "C" void kernel_launch(void* const* d_in, const int* in_sizes, int n_in, void* d_out, int out_size, void* d_ws, size_t ws_size, hipStream_t stream) {
    static int grid = 0;
    if (grid == 0) {
        if (n_in != 26 || (size_t)out_size != O_END || ws_size < WS_END) { fprintf(stderr, "kernel_launch: unexpected shapes: n_in %d out %d ws %zu (need %zu)\n", n_in, out_size, ws_size, (size_t)WS_END); grid = -1; return; }
        int dev = 0, cus = 0, per_cu = 0;
        if (hipGetDevice(&dev) != hipSuccess || hipDeviceGetAttribute(&cus, hipDeviceAttributeMultiprocessorCount, dev) != hipSuccess) { grid = -1; return; }
        if (hipFuncSetAttribute((const void*)mega, hipFuncAttributeMaxDynamicSharedMemorySize, LDS_BYTES) != hipSuccess) { fprintf(stderr, "kernel_launch: hipFuncSetAttribute failed\n"); grid = -1; return; }
        if (hipOccupancyMaxActiveBlocksPerMultiprocessor(&per_cu, (const void*)mega, 512, LDS_BYTES) != hipSuccess || per_cu < 1) { fprintf(stderr, "kernel_launch: occupancy query says %d blocks/CU\n", per_cu); grid = -1; return; }
        grid = cus;
    }
    if (grid < 0) return;
    KArgs a{};
    for (int i = 0; i < 26; ++i) a.in[i] = (const float*)d_in[i];
    a.out = (float*)d_out; a.ws = (unsigned char*)d_ws;
    void* args[] = {&a};
    const hipError_t e = hipLaunchCooperativeKernel((const void*)mega, dim3(grid), dim3(512), args, LDS_BYTES, stream);
    if (e != hipSuccess) fprintf(stderr, "kernel_launch: cooperative launch failed: %s (grid %d)\n", hipGetErrorString(e), grid);
}
```

```cpp
#include <hip/hip_runtime.h>
#include <hip/hip_cooperative_groups.h>
#include <cstdio>
#include <cstdint>
namespace cg = cooperative_groups;
namespace pg8 {
#define PG8_LAS __attribute__((address_space(3)))
typedef unsigned short bf16_t;
typedef short bf16x8 __attribute__((ext_vector_type(8)));
typedef float f32x4 __attribute__((ext_vector_type(4)));
typedef unsigned u32x4 __attribute__((ext_vector_type(4)));
constexpr int BM = 256, BK = 64, HALF = 128, HTB = HALF * BK * 2  , STAGE_BYTES = 8 * HTB, NXCD = 8, WGM = 8;

__host__ __device__ __forceinline__ int lds_byte(int r, int c) { const int st = (r >> 4) * 2 + (c >> 5), rr = r & 15, cc = c & 31, ob = rr * 64 + cc * 2; return st * 1024 + (ob ^ (((ob >> 9) & 1) << 5)); }
__host__ __device__ __forceinline__ void stage_rc(int b, int& R, int& C) { const int st = b / 1024, sb = b % 1024, swz = sb ^ (((sb >> 9) & 1) << 5); R = (st >> 1) * 16 + swz / 64; C = (st & 1) * 32 + (swz % 64) / 2; }
__host__ __device__ __forceinline__ int perm32(int rho) { const int n = rho >> 4, i = rho & 15; return 8 * (i >> 2) + 4 * n + (i & 3); }

struct Unit { int pm, pn; };
struct Gemm { const bf16_t* A; const bf16_t* Bt; int M, N, K; };

struct StaticOrder {
    int nM, nN, nwg, G, c;
    __host__ __device__ void init(int M, int N, int G_, int c_) { nM = M / BM; nN = N / BM; nwg = nM * nN; G = G_; c = c_; }
    __host__ __device__ bool next(int i, Unit& u) const {
        const long L = (long)i * G + c; if (L >= nwg) return false;
        int wgid = (int)L; { const int q = nwg / NXCD, r = nwg % NXCD, xcd = wgid % NXCD, off = wgid / NXCD; wgid = (xcd < r ? xcd * (q + 1) : r * (q + 1) + (xcd - r) * q) + off; }
        const int nig = WGM * nN, gid = wgid / nig, fm = gid * WGM, gsz = (nM - fm) < WGM ? (nM - fm) : WGM;
        u.pm = fm + ((wgid % nig) % gsz); u.pn = (wgid % nig) / gsz; return true;
    }
    __device__ __forceinline__ void a_ready(const Unit&) const {}
    __device__ __forceinline__ void done(const Unit&) const {}
};

__device__ __forceinline__ unsigned cvt_pk_bf16(float lo, float hi) { unsigned r; asm volatile("v_cvt_pk_bf16_f32 %0, %1, %2" : "=v"(r) : "v"(lo), "v"(hi)); return r; }
template <class Epi, class Sched, bool ALIGN_EPI = false, bool SP2 = false>
__device__ __forceinline__ void gemm_phase(PG8_LAS unsigned char* lds, const Gemm g, const Sched& S, const Epi& E, const int wave_in) {
    int lane_l; asm volatile("v_mbcnt_lo_u32_b32 %0, -1, 0\n\tv_mbcnt_hi_u32_b32 %0, -1, %0" : "=v"(lane_l));
    const int wid = wave_in, lane = lane_l, tid = wid * 64 + lane, wr = wid >> 2, wc = wid & 3, fr = lane & 15, fq = lane >> 4;
    const int K = g.K, nt = K / BK;
    unsigned voffA[2], voffB[2];
#pragma unroll
    for (int i = 0; i < 2; ++i) { int R, C; stage_rc(tid * 16 + i * 8192, R, C); const int Rb = Epi::PERM ? ((R & ~31) + perm32(R & 31)) : R;
        voffA[i] = (unsigned)(R * K + C) * 2u; voffB[i] = (unsigned)(Rb * K + C) * 2u; }
    const size_t kstep = (size_t)(BK * 2);
    const size_t hstep = (size_t)HALF * K * 2;
    const size_t tstep = 2 * hstep;
    const unsigned ldsw = (unsigned)wid * 1024u;
    const int aoff = lds_byte(wr * 64 + fr, fq * 8), boff = lds_byte(wc * 32 + fr, fq * 8);
#define PG8_SA(b, h) (((b) * 2 + (h)) * HTB)
#define PG8_SB(b, h) ((4 + (b) * 2 + (h)) * HTB)
#define PG8_STAGE(bufoff, gbase, voff) do { _Pragma("unroll") for (int _i = 0; _i < 2; ++_i) \
        __builtin_amdgcn_global_load_lds((const unsigned*)((const char*)(gbase) + (voff)[_i]), (PG8_LAS unsigned*)(lds + (bufoff) + ldsw + _i * 8192), 16, 0, 0); } while (0)
#define PG8_LDA(dst, b, h) do { _Pragma("unroll") for (int m = 0; m < 4; ++m) _Pragma("unroll") for (int k = 0; k < 2; ++k) dst[m][k] = *(const PG8_LAS bf16x8*)(lds + PG8_SA(b, h) + aoff + m * 2048 + k * 1024); } while (0)
#define PG8_LDB(dst, b, h) do { _Pragma("unroll") for (int n = 0; n < 2; ++n) _Pragma("unroll") for (int k = 0; k < 2; ++k) dst[n][k] = *(const PG8_LAS bf16x8*)(lds + PG8_SB(b, h) + boff + n * 2048 + k * 1024); } while (0)
#define PG8_MMA(ai, bj, At, Bt) do { __builtin_amdgcn_s_setprio(1); _Pragma("unroll") for (int m = 0; m < 4; ++m) _Pragma("unroll") for (int n = 0; n < 2; ++n) _Pragma("unroll") for (int k = 0; k < 2; ++k) \
        acc[ai][bj][m][n] = __builtin_amdgcn_mfma_f32_16x16x32_bf16(Bt[n][k], At[m][k], acc[ai][bj][m][n], 0, 0, 0); __builtin_amdgcn_s_setprio(0); } while (0)
#define PG8_WAIT_V(n) asm volatile("s_waitcnt vmcnt(" #n ")" ::: "memory")
#define PG8_WAIT_L(n) asm volatile("s_waitcnt lgkmcnt(" #n ")" ::: "memory")
#define PG8_BAR __builtin_amdgcn_s_barrier()
#define PG8_SCHED __builtin_amdgcn_sched_barrier(0)
    Unit cur, nxt; int ui = 0;
    if (!S.next(0, cur)) return;
    f32x4 acc[2][2][4][2];
#pragma unroll
    for (int a = 0; a < 2; ++a)
#pragma unroll
        for (int b = 0; b < 2; ++b)
#pragma unroll
            for (int m = 0; m < 4; ++m)
#pragma unroll
                for (int n = 0; n < 2; ++n) acc[a][b][m][n] = (f32x4){0.f, 0.f, 0.f, 0.f};
    bf16x8 At[4][2], B0[2][2], B1[2][2];
    const char* cA = (const char*)g.A + (size_t)cur.pm * tstep; const char* cB = (const char*)g.Bt + (size_t)cur.pn * tstep;
    S.a_ready(cur);
    if constexpr (SP2) {
        PG8_STAGE(PG8_SB(0, 0), cB, voffB); PG8_STAGE(PG8_SB(0, 1), cB + hstep, voffB); PG8_STAGE(PG8_SA(0, 0), cA, voffA); PG8_STAGE(PG8_SA(0, 1), cA + hstep, voffA);
        if (wr == 1) PG8_BAR;
        PG8_WAIT_V(2); PG8_BAR;
        PG8_STAGE(PG8_SB(1, 0), cB + kstep, voffB); PG8_STAGE(PG8_SA(1, 0), cA + kstep, voffA); PG8_STAGE(PG8_SB(1, 1), cB + hstep + kstep, voffB);
        PG8_WAIT_V(6); PG8_BAR;
    } else {
        PG8_STAGE(PG8_SB(0, 0), cB, voffB); PG8_STAGE(PG8_SA(0, 0), cA, voffA); PG8_STAGE(PG8_SB(0, 1), cB + hstep, voffB); PG8_STAGE(PG8_SA(0, 1), cA + hstep, voffA);
        if (wr == 1) PG8_BAR;
        PG8_WAIT_V(4); PG8_BAR;
        PG8_STAGE(PG8_SB(1, 0), cB + kstep, voffB); PG8_STAGE(PG8_SA(1, 0), cA + kstep, voffA); PG8_STAGE(PG8_SB(1, 1), cB + hstep + kstep, voffB);
        PG8_WAIT_V(6); PG8_BAR;
    }
    for (;;) {
        const bool has_next = S.next(ui + 1, nxt);
        const char* nA = has_next ? (const char*)g.A + (size_t)nxt.pm * tstep : cA; const char* nB = has_next ? (const char*)g.Bt + (size_t)nxt.pn * tstep : cB;
        for (int t = 0; t < nt; t += 2) {
            const bool last = (t == nt - 2);
            const char* a1 = cA + (size_t)(t + 1) * kstep;
            const char* a2 = last ? nA : cA + (size_t)(t + 2) * kstep; const char* b2 = last ? nB : cB + (size_t)(t + 2) * kstep;
            const char* a3 = a2 + kstep; const char* b3 = b2 + kstep;
            if (last && has_next) S.a_ready(nxt);
            if constexpr (SP2) {
            PG8_LDB(B0, 0, 0); PG8_LDB(B1, 0, 1); PG8_SCHED; PG8_LDA(At, 0, 0); PG8_STAGE(PG8_SA(1, 1), a1 + hstep, voffA);
            PG8_WAIT_V(8); PG8_WAIT_L(0); PG8_BAR; PG8_MMA(0, 0, At, B0); PG8_MMA(0, 1, At, B1); PG8_BAR; PG8_SCHED;
            PG8_LDA(At, 0, 1); PG8_STAGE(PG8_SB(0, 0), b2, voffB); PG8_STAGE(PG8_SB(0, 1), b2 + hstep, voffB); PG8_STAGE(PG8_SA(0, 0), a2, voffA);
            PG8_WAIT_V(8); PG8_WAIT_L(0); PG8_BAR; PG8_MMA(1, 0, At, B0); PG8_MMA(1, 1, At, B1); PG8_BAR; PG8_SCHED;
            PG8_LDB(B0, 1, 0); PG8_LDB(B1, 1, 1); PG8_SCHED; PG8_LDA(At, 1, 0); PG8_STAGE(PG8_SA(0, 1), a2 + hstep, voffA);
            PG8_WAIT_V(8); PG8_WAIT_L(0); PG8_BAR; PG8_MMA(0, 0, At, B0); PG8_MMA(0, 1, At, B1); PG8_BAR; PG8_SCHED;
            PG8_LDA(At, 1, 1); PG8_STAGE(PG8_SB(1, 0), b3, voffB); PG8_STAGE(PG8_SB(1, 1), b3 + hstep, voffB); PG8_STAGE(PG8_SA(1, 0), a3, voffA);
            PG8_WAIT_V(8); PG8_WAIT_L(0); PG8_BAR; PG8_MMA(1, 0, At, B0); PG8_MMA(1, 1, At, B1); PG8_BAR; PG8_SCHED;
            } else {
            PG8_LDB(B0, 0, 0); PG8_SCHED; PG8_LDA(At, 0, 0); PG8_STAGE(PG8_SA(1, 1), a1 + hstep, voffA);
            PG8_WAIT_L(8); PG8_BAR; PG8_WAIT_L(0); PG8_MMA(0, 0, At, B0); PG8_BAR; PG8_SCHED;
            PG8_LDB(B1, 0, 1); PG8_STAGE(PG8_SB(0, 0), b2, voffB);
            PG8_BAR; PG8_WAIT_L(0); PG8_MMA(0, 1, At, B1); PG8_BAR;
            PG8_LDA(At, 0, 1); PG8_STAGE(PG8_SA(0, 0), a2, voffA);
            PG8_BAR; PG8_WAIT_L(0); PG8_MMA(1, 0, At, B0); PG8_BAR; PG8_SCHED;
            PG8_STAGE(PG8_SB(0, 1), b2 + hstep, voffB);
            PG8_WAIT_V(6); PG8_BAR; PG8_MMA(1, 1, At, B1); PG8_BAR;
            PG8_LDB(B0, 1, 0); PG8_SCHED; PG8_LDA(At, 1, 0); PG8_STAGE(PG8_SA(0, 1), a2 + hstep, voffA);
            PG8_WAIT_L(8); PG8_BAR; PG8_WAIT_L(0); PG8_MMA(0, 0, At, B0); PG8_BAR; PG8_SCHED;
            PG8_LDB(B1, 1, 1); PG8_STAGE(PG8_SB(1, 0), b3, voffB);
            PG8_BAR; PG8_WAIT_L(0); PG8_MMA(0, 1, At, B1); PG8_BAR;
            PG8_LDA(At, 1, 1); PG8_STAGE(PG8_SA(1, 0), a3, voffA);
            PG8_BAR; PG8_WAIT_L(0); PG8_MMA(1, 0, At, B0); PG8_BAR; PG8_SCHED;
            PG8_STAGE(PG8_SB(1, 1), b3 + hstep, voffB);
            PG8_WAIT_V(6); PG8_BAR; PG8_MMA(1, 1, At, B1); PG8_BAR;
            }
        }
        if constexpr (ALIGN_EPI) { if (wr == 0) PG8_BAR; }
        if constexpr (!Epi::AFTER_DRAIN) { E(acc, cur, wr, wc, fr, fq); S.done(cur); }
        if (!has_next) break;
#pragma unroll
        for (int a = 0; a < 2; ++a)
#pragma unroll
            for (int b = 0; b < 2; ++b)
#pragma unroll
                for (int m = 0; m < 4; ++m)
#pragma unroll
                    for (int n = 0; n < 2; ++n) acc[a][b][m][n] = (f32x4){0.f, 0.f, 0.f, 0.f};
        cur = nxt; cA = nA; cB = nB; ++ui;
        if constexpr (ALIGN_EPI) { if (wr == 1) PG8_BAR; }
    }
    PG8_WAIT_V(0);
    if constexpr (!ALIGN_EPI) { if (wr == 0) PG8_BAR; }
    PG8_BAR;
    if constexpr (Epi::AFTER_DRAIN) { E.fused(acc, cur, wr, wc, fr, fq, lds, wid, lane); S.done(cur); }
#undef PG8_SA
#undef PG8_SB
#undef PG8_STAGE
#undef PG8_LDA
#undef PG8_LDB
#undef PG8_MMA
#undef PG8_WAIT_V
#undef PG8_WAIT_L
#undef PG8_BAR
#undef PG8_SCHED
}
}

#define LAS __attribute__((address_space(3)))
#define DEV __device__ __forceinline__
typedef unsigned short bf16_t;
typedef float f32x4 __attribute__((ext_vector_type(4)));
typedef short bf16x8 __attribute__((ext_vector_type(8)));
typedef unsigned u32x4 __attribute__((ext_vector_type(4)));
typedef unsigned u32x2 __attribute__((ext_vector_type(2)));
typedef __bf16 bf2_t __attribute__((ext_vector_type(2)));

constexpr int TP = 32768, TS = 1024, T = TP + TS;
constexpr float EPS = 1e-6f;
constexpr size_t O_NKP = 34603008, O_NVP = O_NKP + 131072, O_NKS = O_NVP + 131072, O_NVS = O_NKS + 131072,
                 O_SVP = O_NVS + 131072, O_SVS = O_SVP + 524288, O_END = O_SVS + 524288;
static_assert(O_END == 36175872, "output size");
constexpr size_t KiB = 1024, MiB = 1048576;
constexpr size_t WS_RSTD1 = 0, WS_LNSTAT = 256 * KiB, WS_SSQ2 = 768 * KiB, WS_RSTD3 = 1024 * KiB, WS_BAR = 1536 * KiB;
constexpr size_t WS_WIN = 2 * MiB, WS_WA = WS_WIN + 7680 * KiB, WS_WB = WS_WA + MiB, WS_WOUT = WS_WB + MiB, WS_WQ = WS_WOUT + 2 * MiB,
                 WS_SK = WS_WQ + 4 * MiB, WS_WPLE = WS_SK + 512 * KiB, WS_WG = WS_WPLE + 512 * KiB, WS_SGUW = WS_WG + 2 * MiB,
                 WS_CK = 21 * MiB, WS_CVT = 25 * MiB, WS_PU = 29 * MiB, WS_PV = 61 * MiB, WS_PB = 93 * MiB,
                 WS_S1 = 110 * MiB, WS_S2 = 242 * MiB, WS_S3 = 308 * MiB, WS_S4 = 374 * MiB, WS_S5 = 440 * MiB, WS_END = 482 * MiB;
static_assert(WS_SGUW + 128 * KiB <= WS_CK, "ws map");
constexpr int LDS_BYTES = 143360 + 64;

struct KArgs { const float* in[26]; float* out; unsigned char* ws; };

DEV unsigned pk2(float lo, float hi) { unsigned r; asm("v_cvt_pk_bf16_f32 %0, %1, %2" : "=v"(r) : "v"(lo), "v"(hi)); return r; }
DEV unsigned f2bf(float f) { return pk2(f, f) & 0xffffu; }
DEV float bflo(unsigned w) { return __builtin_bit_cast(float, w << 16); }
DEV float bfhi(unsigned w) { return __builtin_bit_cast(float, w & 0xffff0000u); }
DEV float bf1(bf16_t h) { return __builtin_bit_cast(float, (unsigned)h << 16); }
DEV float gelu_t(float x) { const float u = 1.5957691216f * (x + 0.044715f * x * x * x); return x * __builtin_amdgcn_rcpf(1.f + __expf(-u)); }
DEV float sigm(float x) { return __builtin_amdgcn_rcpf(1.f + __expf(-x)); }
DEV void st8bf(bf16_t* p, const float (&v)[8]) { u32x4 w; w.x = pk2(v[0], v[1]); w.y = pk2(v[2], v[3]); w.z = pk2(v[4], v[5]); w.w = pk2(v[6], v[7]); *(u32x4*)p = w; }
DEV void ld8bf(const bf16_t* p, float (&v)[8]) { const u32x4 w = *(const u32x4*)p; v[0] = bflo(w.x); v[1] = bfhi(w.x); v[2] = bflo(w.y); v[3] = bfhi(w.y); v[4] = bflo(w.z); v[5] = bfhi(w.z); v[6] = bflo(w.w); v[7] = bfhi(w.w); }
DEV void st8f(float* p, const float (&v)[8]) { *(f32x4*)p = (f32x4){v[0], v[1], v[2], v[3]}; *(f32x4*)(p + 4) = (f32x4){v[4], v[5], v[6], v[7]}; }
DEV void st8bf_nt(bf16_t* p, const float (&v)[8]) { u32x4 w; w.x = pk2(v[0], v[1]); w.y = pk2(v[2], v[3]); w.z = pk2(v[4], v[5]); w.w = pk2(v[6], v[7]); __builtin_nontemporal_store(w, (u32x4*)p); }
DEV void ld8f_nt(const float* p, float (&v)[8]) { const f32x4 a = __builtin_nontemporal_load((const f32x4*)p), b = __builtin_nontemporal_load((const f32x4*)(p + 4)); v[0] = a.x; v[1] = a.y; v[2] = a.z; v[3] = a.w; v[4] = b.x; v[5] = b.y; v[6] = b.z; v[7] = b.w; }
DEV void st8f_nt(float* p, const float (&v)[8]) { __builtin_nontemporal_store((f32x4){v[0], v[1], v[2], v[3]}, (f32x4*)p); __builtin_nontemporal_store((f32x4){v[4], v[5], v[6], v[7]}, (f32x4*)(p + 4)); }
DEV void ld8f(const float* p, float (&v)[8]) { const f32x4 a = *(const f32x4*)p, b = *(const f32x4*)(p + 4); v[0] = a.x; v[1] = a.y; v[2] = a.z; v[3] = a.w; v[4] = b.x; v[5] = b.y; v[6] = b.z; v[7] = b.w; }
DEV float wave_sum(float v) {
#pragma unroll
    for (int o = 1; o < 64; o <<= 1) v += __shfl_xor(v, o);
    return v;
}
DEV float rowmax16(float v) { v = fmaxf(v, __shfl_xor(v, 1)); v = fmaxf(v, __shfl_xor(v, 2)); v = fmaxf(v, __shfl_xor(v, 4)); v = fmaxf(v, __shfl_xor(v, 8)); return v; }
DEV float rowsum16(float v) { v += __shfl_xor(v, 1); v += __shfl_xor(v, 2); v += __shfl_xor(v, 4); v += __shfl_xor(v, 8); return v; }
DEV int rowmax16i(int v) { v = max(v, __shfl_xor(v, 1)); v = max(v, __shfl_xor(v, 2)); v = max(v, __shfl_xor(v, 4)); v = max(v, __shfl_xor(v, 8)); return v; }
template <int CTRL> DEV float dppf(float v) { return __builtin_bit_cast(float, __builtin_amdgcn_update_dpp(0, __builtin_bit_cast(int, v), CTRL, 0xf, 0xf, false)); }
DEV float vmax(float a, float b) { float r; asm("v_max_f32_e32 %0, %1, %2" : "=v"(r) : "v"(a), "v"(b)); return r; }
DEV float vmin(float a, float b) { float r; asm("v_min_f32_e32 %0, %1, %2" : "=v"(r) : "v"(a), "v"(b)); return r; }
#define ROR_MAX(N) DEV float vmax_ror##N(float v) { float r; asm("s_nop 1\n\tv_max_f32_dpp %0, %1, %1 row_ror:" #N " row_mask:0xf bank_mask:0xf" : "=v"(r) : "v"(v)); return r; }
ROR_MAX(8) ROR_MAX(4) ROR_MAX(2) ROR_MAX(1)
DEV float rowmax16d(float v) { v = vmax_ror8(v); v = vmax_ror4(v); v = vmax_ror2(v); v = vmax_ror1(v); return v; }
DEV float rowsum16d(float v) { v += dppf<0x128>(v); v += dppf<0x124>(v); v += dppf<0x122>(v); v += dppf<0x121>(v); return v; }
DEV f32x4 mfma16(bf16x8 a, bf16x8 b, f32x4 c) { return __builtin_amdgcn_mfma_f32_16x16x32_bf16(a, b, c, 0, 0, 0); }
DEV const float* xrow(const KArgs& A, int row) { return row < TP ? A.in[0] + (size_t)row * 1024 : A.in[1] + (size_t)(row - TP) * 1024; }

template <int mode> struct Epi {
    static constexpr bool PERM = true, AFTER_DRAIN = false;
    const float* xp; const float* xs; float* out; unsigned char* ws;
    DEV void operator()(const f32x4 (&acc)[2][2][4][2], const pg8::Unit& u, int wr, int wc, int fr, int fq) const {
        rowop<0, 0>(acc, u, wr, wc, fr, fq); rowop<0, 1>(acc, u, wr, wc, fr, fq); rowop<0, 2>(acc, u, wr, wc, fr, fq); rowop<0, 3>(acc, u, wr, wc, fr, fq);
        rowop<1, 0>(acc, u, wr, wc, fr, fq); rowop<1, 1>(acc, u, wr, wc, fr, fq); rowop<1, 2>(acc, u, wr, wc, fr, fq); rowop<1, 3>(acc, u, wr, wc, fr, fq);
    }
    template <int ai, int m>
    DEV void rowop(const f32x4 (&acc)[2][2][4][2], const pg8::Unit& u, int wr, int wc, int fr, int fq) const {
        const int pn = u.pn;
            {
                const int row = u.pm * 256 + ai * 128 + wr * 64 + m * 16 + fr;
                float rs = 1.f, s1 = 0.f, s2 = 0.f;
                if (mode == 1) rs = ((const float*)(ws + WS_RSTD1))[row];
                else if (mode == 5) rs = rsqrtf(((const float*)(ws + WS_SSQ2))[row] * (1.f / 1024.f) + EPS);
                else if (mode == 7) rs = ((const float*)(ws + WS_RSTD3))[row];
#pragma unroll
                for (int bj = 0; bj < 2; ++bj) {
                    const int col0 = pn * 256 + bj * 128 + wc * 32 + 8 * fq;
                    float v[8];
#pragma unroll
                    for (int i = 0; i < 4; ++i) { v[i] = acc[ai][bj][m][0][i] * rs; v[4 + i] = acc[ai][bj][m][1][i] * rs; }
                    if (mode == 1) {
                        if (pn < 2 || (pn == 2 && bj == 0)) {
                            st8bf((bf16_t*)(ws + WS_S3) + (size_t)row * 640 + col0, v);
                        } else if (pn == 2) {
                            const int c = col0 - 640, chunk = row >> 7, tok = row & 127;
                            bf16_t* vt = (bf16_t*)(ws + WS_S3) + (size_t)T * 640 + (size_t)chunk * 16384 + c * 128 + tok;
#pragma unroll
                            for (int i = 0; i < 8; ++i) vt[i * 128] = (bf16_t)f2bf(v[i]);
                            if (row >= TP) st8f(out + O_NVS + (size_t)(row - TP) * 128 + c, v);
                            else if ((row & 4095) >= 3968) st8f(out + O_NVP + (size_t)((row >> 12) * 128 + (row & 4095) - 3968) * 128 + c, v);
                        } else if (pn < 5) {
#pragma unroll
                            for (int i = 0; i < 8; ++i) v[i] = gelu_t(v[i]);
                            st8bf((bf16_t*)(ws + WS_S4) + (size_t)row * 512 + (col0 - 768), v);
                        } else if (pn < 7) {
                            const int c = col0 - 1280, chunk = row >> 7, tok = row & 127;
                            bf16_t* gt = (bf16_t*)(ws + WS_S4) + (size_t)T * 512 + (size_t)chunk * 65536 + c * 128 + tok;
#pragma unroll
                            for (int i = 0; i < 8; ++i) { const unsigned hb = f2bf(gelu_t(v[i])); gt[i * 128] = (bf16_t)hb; const float gr = bf1((bf16_t)hb); s1 += gr; s2 += gr * gr; }
                        } else {
#pragma unroll
                            for (int i = 0; i < 8; ++i) v[i] = sigm(v[i]);
                            st8bf_nt((bf16_t*)(ws + WS_S1) + (size_t)row * 2048 + (col0 - 1792), v);
                        }
                    } else if (mode == 2) {
                        float g[8]; ld8bf((const bf16_t*)(ws + WS_S1) + (size_t)row * 2048 + col0, g);
#pragma unroll
                        for (int i = 0; i < 8; ++i) v[i] *= g[i];
                        st8bf((bf16_t*)(ws + WS_S3) + (size_t)row * 1024 + col0, v);
                    } else if (mode == 3) {
                        float g[8], t[8]; ld8bf((const bf16_t*)(ws + WS_S1) + (size_t)row * 2048 + 1024 + col0, g); ld8bf((const bf16_t*)(ws + WS_S3) + (size_t)row * 1024 + col0, t);
#pragma unroll
                        for (int i = 0; i < 8; ++i) v[i] = t[i] + g[i] * v[i];
                        st8bf((bf16_t*)(ws + WS_S4) + (size_t)row * 1024 + col0, v);
                    } else if (mode == 4) {
                        float xv[8]; ld8bf((const bf16_t*)out + (size_t)row * 1024 + col0, xv);
#pragma unroll
                        for (int i = 0; i < 8; ++i) { v[i] += xv[i]; s1 += v[i] * v[i]; }
                        st8bf((bf16_t*)(ws + WS_S3) + (size_t)row * 1024 + col0, v);
                    } else if (mode == 5) {
                        st8bf_nt((bf16_t*)(ws + WS_S1) + (size_t)row * 2048 + col0, v);
                    } else if (mode == 6) {
                        st8bf((bf16_t*)(ws + WS_S4) + (size_t)row * 1024 + col0, v);
                    } else {
                        float x2[8], pe[8]; ld8bf((const bf16_t*)(ws + WS_S2) + (size_t)row * 1024 + col0, x2); ld8bf((const bf16_t*)(ws + WS_S4) + (size_t)row * 1024 + col0, pe);
#pragma unroll
                        for (int i = 0; i < 8; ++i) v[i] = x2[i] + sigm(v[i]) * pe[i];
                        st8f_nt(out + (size_t)row * 1024 + col0, v);
                    }
                }
                if ((mode == 1 && (pn == 5 || pn == 6)) || mode == 4) {
                    s1 += __shfl_xor(s1, 16); s1 += __shfl_xor(s1, 32); s2 += __shfl_xor(s2, 16); s2 += __shfl_xor(s2, 32);
                    if (fq == 0) {
                        if (mode == 1) { float* ls = (float*)(ws + WS_LNSTAT) + (size_t)row * 2; atomicAdd(ls, s1); atomicAdd(ls + 1, s2); }
                        else atomicAdd((float*)(ws + WS_SSQ2) + row, s1);
                    }
                }
            }
    }
};

DEV void tr_item(const float* W, const float* ksc, int K, int N, bf16_t* WT, LAS float* scr, int item, int lane) {
    const int nblk = N / 32, kb = item / nblk, nb = item % nblk, k0 = 64 * kb, n0 = 32 * nb;
    const int r = lane >> 3, c4 = (lane & 7) * 4;
    f32x4 w[8];
#pragma unroll
    for (int i = 0; i < 8; ++i) w[i] = *(const f32x4*)(W + (size_t)(k0 + 8 * i + r) * N + n0 + c4);
#pragma unroll
    for (int i = 0; i < 8; ++i) { const int kk = 8 * i + r; const float sc = ksc ? ksc[k0 + kk] : 1.f; LAS float* d = scr + kk * 33 + c4;
        d[0] = w[i].x * sc; d[1] = w[i].y * sc; d[2] = w[i].z * sc; d[3] = w[i].w * sc; }
    asm volatile("s_waitcnt lgkmcnt(0)" ::: "memory");
    const int c = lane & 7;
#pragma unroll
    for (int j = 0; j < 4; ++j) { const int n = (lane >> 3) + 8 * j; const LAS float* s = scr + (8 * c) * 33 + n;
        u32x4 o; o.x = pk2(s[0 * 33], s[1 * 33]); o.y = pk2(s[2 * 33], s[3 * 33]); o.z = pk2(s[4 * 33], s[5 * 33]); o.w = pk2(s[6 * 33], s[7 * 33]);
        *(u32x4*)(WT + (size_t)(n0 + n) * K + k0 + 8 * c) = o; }
    asm volatile("s_waitcnt lgkmcnt(0)" ::: "memory");
}
DEV void cvt_flat(const float* src, bf16_t* dst, int ngroups, int gtid, int NT) {
    for (int i = gtid; i < ngroups / 4; i += NT) {
        float v[4][8];
#pragma unroll
        for (int u = 0; u < 4; ++u) ld8f_nt(src + ((size_t)u * (ngroups / 4) + i) * 8, v[u]);
#pragma unroll
        for (int u = 0; u < 4; ++u) st8bf(dst + ((size_t)u * (ngroups / 4) + i) * 8, v[u]);
    }
}
constexpr float PEER_SU = 64.f, PEER_SV = 24.f;
DEV unsigned pk8_fp4(const float (&v)[8], float sc) {
    unsigned p = 0;
    p = __builtin_amdgcn_cvt_scalef32_pk_fp4_f32(p, v[0] * sc, v[1] * sc, 1.0f, 0); p = __builtin_amdgcn_cvt_scalef32_pk_fp4_f32(p, v[2] * sc, v[3] * sc, 1.0f, 1);
    p = __builtin_amdgcn_cvt_scalef32_pk_fp4_f32(p, v[4] * sc, v[5] * sc, 1.0f, 2); p = __builtin_amdgcn_cvt_scalef32_pk_fp4_f32(p, v[6] * sc, v[7] * sc, 1.0f, 3);
    return p;
}
DEV void cvt_fp4(const float* src, unsigned char* dst, int ngroups  , float sc, int gtid, int NT) {
    for (int i = gtid; i < ngroups / 4; i += NT) {
        float v[4][8];
#pragma unroll
        for (int u = 0; u < 4; ++u) ld8f_nt(src + ((size_t)u * (ngroups / 4) + i) * 8, v[u]);
#pragma unroll
        for (int u = 0; u < 4; ++u) ((unsigned*)dst)[(size_t)u * (ngroups / 4) + i] = pk8_fp4(v[u], sc);
    }
}
DEV void p0_phase(const KArgs& A, LAS unsigned char* lds, int lane, int wave, int gw, int NGW, int gtid, int NT, const int part) {
    unsigned char* ws = A.ws;
    if (part == 0) { float* ls = (float*)(ws + WS_LNSTAT); for (int i = gtid; i < T * 2; i += NT) ls[i] = 0.f;
      float* sq = (float*)(ws + WS_SSQ2); for (int i = gtid; i < T; i += NT) sq[i] = 0.f; }
    LAS float* scr = (LAS float*)(lds + wave * 8704);
    constexpr int I_IN = 16 * 120, I_A = 8 * 32, I_B = 8 * 32, I_O = 16 * 32, I_Q = 16 * 64, I_P = 4 * 32, I_G = 16 * 32, NIT = I_IN + I_A + I_B + I_O + I_Q + I_P + I_G;
    constexpr int I_MID = I_IN + I_A + I_B + I_O;
    for (int it = (part == 0 ? gw : (part == 1 ? I_IN + gw : I_MID + gw)); it < (part == 0 ? I_IN : (part == 1 ? I_MID : (part == 3 ? NIT : 0))); it += NGW) {
        int r = it; const float* W; const float* sc = nullptr; int K, N; bf16_t* WT;
        if (r < I_IN) { W = A.in[7]; sc = A.in[6]; K = 1024; N = 3840; WT = (bf16_t*)(ws + WS_WIN); }
        else if ((r -= I_IN) < I_A) { W = A.in[15]; K = 512; N = 1024; WT = (bf16_t*)(ws + WS_WA); }
        else if ((r -= I_A) < I_B) { W = A.in[16]; K = 512; N = 1024; WT = (bf16_t*)(ws + WS_WB); }
        else if ((r -= I_B) < I_O) { W = A.in[17]; K = 1024; N = 1024; WT = (bf16_t*)(ws + WS_WOUT); }
        else if ((r -= I_O) < I_Q) { W = A.in[19]; sc = A.in[18]; K = 1024; N = 2048; WT = (bf16_t*)(ws + WS_WQ); }
        else if ((r -= I_Q) < I_P) { W = A.in[24]; K = 256; N = 1024; WT = (bf16_t*)(ws + WS_WPLE); }
        else { r -= I_P; W = A.in[25]; sc = A.in[23]; K = 1024; N = 1024; WT = (bf16_t*)(ws + WS_WG); }
        tr_item(W, sc, K, N, WT, scr, r, lane);
    }
    if (part == 2) {
    cvt_flat(A.in[4], (bf16_t*)(ws + WS_PB), 1048576, gtid, NT);
    cvt_flat(A.in[5], (bf16_t*)(ws + WS_PB) + (size_t)TP * 256, 32768, gtid, NT);
    }
    if (part == 1) {
    cvt_flat(A.in[20], (bf16_t*)(ws + WS_SK), 32768, gtid, NT);
    cvt_flat(A.in[2], (bf16_t*)(ws + WS_CK), 262144, gtid, NT);
    for (int i = gtid; i < 8192; i += NT) {
        const int t = (i >> 4) & 127, s0 = (i & 15) * 8; float v[8]; ld8f(A.in[13] + (size_t)i * 8, v);
#pragma unroll
        for (int e = 0; e < 8; ++e) if (s0 + e > t) v[e] = 0.f;
        st8bf((bf16_t*)(ws + WS_SGUW) + (size_t)i * 8, v);
    }
    for (int i = gtid; i < 262144; i += NT) {
        const int d = i & 63, kg = (i >> 6) & 15, kvh = (i >> 10) & 1, seq = i >> 11; float v[8];
#pragma unroll
        for (int e = 0; e < 8; ++e) v[e] = A.in[3][((size_t)(seq * 128 + kg * 8 + e) * 2 + kvh) * 64 + d];
        st8bf((bf16_t*)(ws + WS_CVT) + ((size_t)(seq * 2 + kvh) * 64 + d) * 128 + kg * 8, v);
    }
    }
    if (part == 0)
    for (int row0 = gw * 2; row0 < T; row0 += NGW * 2) {
        f32x4 v[2][4]; float s[2];
#pragma unroll
        for (int r = 0; r < 2; ++r) { const f32x4* xr = (const f32x4*)xrow(A, row0 + r) + lane;
#pragma unroll
            for (int j = 0; j < 4; ++j) v[r][j] = __builtin_nontemporal_load(xr + 64 * j); }
#pragma unroll
        for (int r = 0; r < 2; ++r) { s[r] = 0.f;
#pragma unroll
            for (int j = 0; j < 4; ++j) s[r] += (v[r][j].x * v[r][j].x + v[r][j].y * v[r][j].y) + (v[r][j].z * v[r][j].z + v[r][j].w * v[r][j].w);
            s[r] = wave_sum(s[r]);
            if (lane == 0) ((float*)(ws + WS_RSTD1))[row0 + r] = rsqrtf(s[r] * (1.f / 1024.f) + EPS);
            u32x2* o = (u32x2*)((bf16_t*)A.out + (size_t)(row0 + r) * 1024) + lane;
#pragma unroll
            for (int j = 0; j < 4; ++j) { u32x2 w; w.x = pk2(v[r][j].x, v[r][j].y); w.y = pk2(v[r][j].z, v[r][j].w); o[64 * j] = w; } }
    }
}

DEV void p2_item(const KArgs& A, const bf16_t* zqk, bf16_t* qn, bf16_t* kn, int i, float (&v)[8]) {
    const int row = i / 80, g = i - row * 80;
    float ss = 0.f;
#pragma unroll
    for (int e = 0; e < 8; ++e) ss += v[e] * v[e];
    ss += __shfl_xor(ss, 1); ss += __shfl_xor(ss, 2); ss += __shfl_xor(ss, 4);
    const float r = rsqrtf(ss * (1.f / 64.f) + EPS);
    const int d0 = (g & 7) * 8;
    if (g < 64) {
        float gg[8]; ld8f(A.in[8] + d0, gg);
#pragma unroll
        for (int e = 0; e < 8; ++e) v[e] = v[e] * r * gg[e] * 0.125f;
        st8bf(qn + (size_t)row * 512 + g * 8, v);
    } else {
        float gg[8]; ld8f(A.in[9] + d0, gg);
#pragma unroll
        for (int e = 0; e < 8; ++e) v[e] = v[e] * r * gg[e];
        const int c = (g - 64) * 8;
        st8bf(kn + (size_t)row * 128 + c, v);
        if (row >= TP) st8f(A.out + O_NKS + (size_t)(row - TP) * 128 + c, v);
        else if ((row & 4095) >= 3968) st8f(A.out + O_NKP + (size_t)((row >> 12) * 128 + (row & 4095) - 3968) * 128 + c, v);
    }
}
DEV void p2_phase(const KArgs& A, int gtid, int NT) {
    unsigned char* ws = A.ws;
    const bf16_t* zqk = (const bf16_t*)(ws + WS_S3);
    bf16_t* qn = (bf16_t*)(ws + WS_S5); bf16_t* kn = qn + (size_t)T * 512;
    constexpr int NI = T * 80, Q4 = NI / 4;
    static_assert(NI % 4 == 0 && Q4 % 64 == 0, "p2 split");
    for (int i = gtid; i < Q4; i += NT) {
        float v[4][8];
#pragma unroll
        for (int u = 0; u < 4; ++u) { const int ii = u * Q4 + i; const int row = ii / 80, g = ii - row * 80; ld8bf(zqk + (size_t)row * 640 + g * 8, v[u]); }
#pragma unroll
        for (int u = 0; u < 4; ++u) p2_item(A, zqk, qn, kn, u * Q4 + i, v[u]);
    }
}

template <bool SAMPLE>
DEV void attn_task(const KArgs& A, int task, LAS bf16_t* P, int lane) {
    unsigned char* ws = A.ws;
    const bf16_t* qn = (const bf16_t*)(ws + WS_S5);
    const bf16_t* kn = qn + (size_t)T * 512;
    const bf16_t* VT = (const bf16_t*)(ws + WS_S3) + (size_t)T * 640;
    const bf16_t* ck = (const bf16_t*)(ws + WS_CK);
    const bf16_t* cvT = (const bf16_t*)(ws + WS_CVT);
    bf16_t* ab = (bf16_t*)(ws + WS_S2);
    const int fr = lane & 15, quad = lane >> 4;
    int kvh, st = 0, cj = 0, j = 0, prevc = 0, seq = 0, i0 = 0, hq_u = 0, p2 = 0;
    if (!SAMPLE) { const int unit = task >> 5, sub = task & 31, w = sub >> 2, a = (w & 1) * 4 + (sub & 3); kvh = unit & 1; cj = unit >> 1; j = cj & 31; prevc = j > 0 ? cj - 1 : cj; i0 = 16 * a; st = a < 6 ? a : 6; hq_u = kvh * 4 + (w >> 1); }
    else { seq = task >> 2; kvh = (task >> 1) & 1; p2 = task & 1; }
    size_t qoff;
    if (!SAMPLE) qoff = (size_t)(cj * 128 + i0 + fr) * 512 + hq_u * 64;
    else qoff = (size_t)(TP + seq * 8 + (fr & 7)) * 512 + (kvh * 4 + 2 * p2 + (fr >> 3)) * 64;
    const bf16x8 qa0 = *(const bf16x8*)(qn + qoff + quad * 8), qa1 = *(const bf16x8*)(qn + qoff + 32 + quad * 8);
    f32x4 S[10];
#pragma unroll
    for (int t = 0; t < 10; ++t) {
        const int r = (st + t) * 16 + fr; const bf16_t* kp;
        if (!SAMPLE) { const int tk = (r < 128) ? prevc * 128 + r : cj * 128 + r - 128; kp = kn + (size_t)tk * 128 + kvh * 64; }
        else { if (r < 128) kp = ck + ((size_t)(seq * 128 + r) * 2 + kvh) * 64; else { int l2 = r - 128; l2 = l2 > 7 ? 7 : l2; kp = kn + (size_t)(TP + seq * 8 + l2) * 128 + kvh * 64; } }
        const bf16x8 kb0 = *(const bf16x8*)(kp + quad * 8), kb1 = *(const bf16x8*)(kp + 32 + quad * 8);
        f32x4 z = {0.f, 0.f, 0.f, 0.f}; z = mfma16(qa0, kb0, z); z = mfma16(qa1, kb1, z); S[t] = z;
    }
    bf16x8 vbf[5][4];
#pragma unroll
    for (int ks = 0; ks < 5; ++ks) {
        const int k0 = st * 16 + ks * 32 + quad * 8;
#pragma unroll
        for (int nt = 0; nt < 4; ++nt) {
            const int d = nt * 16 + fr; const bf16_t* vp;
            if (!SAMPLE) vp = (k0 < 128) ? VT + (size_t)prevc * 16384 + (kvh * 64 + d) * 128 + k0 : VT + (size_t)cj * 16384 + (kvh * 64 + d) * 128 + (k0 - 128);
            else vp = (k0 < 128) ? cvT + ((size_t)(seq * 2 + kvh) * 64 + d) * 128 + k0 : VT + (size_t)(256 + (seq >> 4)) * 16384 + (kvh * 64 + d) * 128 + (seq & 15) * 8;
            vbf[ks][nt] = *(const bf16x8*)vp;
        }
    }
    const int hq_c = SAMPLE ? (kvh * 4 + 2 * p2 + (quad >> 1)) : hq_u;
    const float slope = exp2f(-(float)(hq_c + 1)), sink = A.in[10][hq_c];
    float inv_l[4];
#pragma unroll
    for (int reg = 0; reg < 4; ++reg) {
        const int irow = SAMPLE ? ((quad & 1) * 4 + reg) : (i0 + quad * 4 + reg);
        float mx = sink, sv[10];
#pragma unroll
        for (int t = 0; t < 10; ++t) {
            const int r = (st + t) * 16 + fr, dist = irow - r + 128;
            const bool valid = dist >= 0 && dist < 128 && (SAMPLE ? (r < 136) : (j > 0 || r >= 128));
            const float s = valid ? S[t][reg] - slope * (float)dist : -1e30f; sv[t] = s; mx = vmax(mx, s);
        }
        mx = rowmax16d(mx);
        float l = 0.f;
#pragma unroll
        for (int t = 0; t < 10; ++t) { const float p = __expf(sv[t] - mx); l += p; P[(quad * 4 + reg) * 168 + t * 16 + fr] = (bf16_t)f2bf(p); }
        l = rowsum16d(l) + __expf(sink - mx);
        inv_l[reg] = __builtin_amdgcn_rcpf(l);
    }
    if (fr == 0) { LAS float* Li = (LAS float*)(P + 16 * 168);
#pragma unroll
        for (int reg = 0; reg < 4; ++reg) Li[quad * 4 + reg] = inv_l[reg]; }
    asm volatile("s_waitcnt lgkmcnt(0)" ::: "memory");
    f32x4 O[4];
#pragma unroll
    for (int nt = 0; nt < 4; ++nt) O[nt] = (f32x4){0.f, 0.f, 0.f, 0.f};
#pragma unroll
    for (int ks = 0; ks < 5; ++ks) {
        const bf16x8 pa = *(const LAS bf16x8*)(P + fr * 168 + ks * 32 + quad * 8);
#pragma unroll
        for (int nt = 0; nt < 4; ++nt) O[nt] = mfma16(vbf[ks][nt], pa, O[nt]);
    }
    {
        const float il = ((const LAS float*)(P + 16 * 168))[fr]; size_t ooff;
        if (!SAMPLE) ooff = (size_t)(cj * 128 + i0 + fr) * 512 + hq_u * 64;
        else ooff = (size_t)(TP + seq * 8 + (fr & 7)) * 512 + (kvh * 4 + 2 * p2 + (fr >> 3)) * 64;
#pragma unroll
        for (int nt = 0; nt < 4; ++nt) { const f32x4 ov = O[nt]; u32x2 w; w.x = pk2(ov[0] * il, ov[1] * il); w.y = pk2(ov[2] * il, ov[3] * il); *(u32x2*)(ab + ooff + nt * 16 + quad * 4) = w; }
    }
    asm volatile("s_waitcnt lgkmcnt(0)" ::: "memory");
}

DEV void ln_stats8(const float* st, float (&mean)[8], float (&rstd)[8]) {
#pragma unroll
    for (int e2 = 0; e2 < 4; ++e2) {
        const f32x4 q = ((const f32x4*)st)[e2];
        const float m0 = q.x * (1.f / 512.f), m1 = q.z * (1.f / 512.f);
        mean[2 * e2] = m0; mean[2 * e2 + 1] = m1;
        rstd[2 * e2] = rsqrtf(fmaxf(q.y * (1.f / 512.f) - m0 * m0, 0.f) + EPS); rstd[2 * e2 + 1] = rsqrtf(fmaxf(q.w * (1.f / 512.f) - m1 * m1, 0.f) + EPS);
    }
}

DEV void sgu_task(const KArgs& A, int task, int lane) {
    unsigned char* ws = A.ws;
    const int fr = lane & 15, quad = lane >> 4;
    const int cj = task >> 5, g = (task >> 3) & 3, rb = task & 7, kk = (task >> 11) & 3, rb4 = (rb + 4) & 7;
    const int rt = kk == 0 ? rb : (kk == 1 ? 7 - rb : (kk == 2 ? rb4 : 7 - rb4)), nks = (rt >> 1) + 1;
    const bf16_t* W = (const bf16_t*)(ws + WS_SGUW) + (size_t)(g * 128 + rt * 16 + fr) * 128;
    const bf16_t* gv = (const bf16_t*)(ws + WS_S4) + (size_t)T * 512 + (size_t)cj * 65536 + (size_t)(g * 128 + fr) * 128;
    const float* st = (const float*)(ws + WS_LNSTAT) + (size_t)cj * 256;
    const bf16_t* ub = (const bf16_t*)(ws + WS_S4);
    bf16_t* mb = (bf16_t*)(ws + WS_S2) + (size_t)T * 512;
    f32x4 acc[8];
#pragma unroll
    for (int nt = 0; nt < 8; ++nt) acc[nt] = (f32x4){0.f, 0.f, 0.f, 0.f};
    for (int ks = 0; ks < nks; ++ks) {
        const bf16x8 wa = *(const bf16x8*)(W + ks * 32 + quad * 8);
        float mean[8], rstd[8]; ln_stats8(st + (ks * 32 + quad * 8) * 2, mean, rstd);
#pragma unroll
        for (int nt = 0; nt < 8; ++nt) {
            const int c = g * 128 + nt * 16 + fr; float x[8]; ld8bf(gv + nt * 2048 + ks * 32 + quad * 8, x);
            const float lg = A.in[11][c], lb = A.in[12][c];
#pragma unroll
            for (int e = 0; e < 8; ++e) x[e] = (x[e] - mean[e]) * rstd[e] * lg + lb;
            u32x4 w; w.x = pk2(x[0], x[1]); w.y = pk2(x[2], x[3]); w.z = pk2(x[4], x[5]); w.w = pk2(x[6], x[7]);
            acc[nt] = mfma16(__builtin_bit_cast(bf16x8, w), wa, acc[nt]);
        }
    }
    {
        const int t = rt * 16 + fr; const size_t tok = (size_t)cj * 128 + t; const float bb = A.in[14][g * 128 + t];
#pragma unroll
        for (int nt = 0; nt < 8; ++nt) {
            const int c = g * 128 + nt * 16 + quad * 4;
            const u32x2 uu = *(const u32x2*)(ub + tok * 512 + c); const f32x4 av = acc[nt];
            u32x2 o; o.x = pk2(bflo(uu.x) * (av[0] + bb), bfhi(uu.x) * (av[1] + bb)); o.y = pk2(bflo(uu.y) * (av[2] + bb), bfhi(uu.y) * (av[3] + bb));
            *(u32x2*)(mb + tok * 512 + c) = o;
        }
    }
}

DEV void sgu_small(const KArgs& A, int gtid, int NT) {
    unsigned char* ws = A.ws;
    const bf16_t* gvT = (const bf16_t*)(ws + WS_S4) + (size_t)T * 512;
    const bf16_t* ub = (const bf16_t*)(ws + WS_S4);
    bf16_t* mb = (bf16_t*)(ws + WS_S2) + (size_t)T * 512;
    for (int i = gtid; i < 131072; i += NT) {
        const bool samp = i < 65536; const int ii = samp ? i : i - 65536, c = ii & 511, grp = ii >> 9;
        const int tokbase = samp ? TP + grp * 8 : ((grp >> 4) * 4096 + 3968 + (grp & 15) * 8);
        const int chunk = tokbase >> 7, tok0 = tokbase & 127;
        float x[8], mean[8], rstd[8]; ld8bf(gvT + (size_t)chunk * 65536 + c * 128 + tok0, x);
        ln_stats8((const float*)(ws + WS_LNSTAT) + (size_t)tokbase * 2, mean, rstd);
        const float lg = A.in[11][c], lb = A.in[12][c];
        float* o = samp ? A.out + O_SVS + (size_t)(grp * 8) * 512 + c : A.out + O_SVP + (size_t)((grp >> 4) * 128 + (grp & 15) * 8) * 512 + c;
#pragma unroll
        for (int e = 0; e < 8; ++e) { x[e] = (x[e] - mean[e]) * rstd[e] * lg + lb; o[e * 512] = x[e]; }
        if (samp) {
            const int g = c >> 7;
#pragma unroll
            for (int t = 0; t < 8; ++t) {
                float s = A.in[14][g * 128 + t];
#pragma unroll
                for (int e = 0; e <= t; ++e) s += A.in[13][(size_t)(g * 128 + t) * 128 + e] * x[e];
                const size_t tk = (size_t)tokbase + t; mb[tk * 512 + c] = (bf16_t)f2bf(bf1(ub[tk * 512 + c]) * s);
            }
        }
    }
}

DEV void topk_task(const KArgs& A, int task, LAS float* L  , int lane) {
    unsigned char* ws = A.ws;
    const int fr = lane & 15, quad = lane >> 4;
    const int tok0 = (task >> 3) * 16, h = task & 7;
    const bf16_t* pq = (const bf16_t*)(ws + WS_S1) + (size_t)(tok0 + fr) * 2048 + h * 256 + quad * 8;
    const bf16_t* SK = (const bf16_t*)(ws + WS_SK) + (size_t)(h * 2) * 16384 + (size_t)fr * 128 + quad * 8;
    int* pidx = (int*)(ws + WS_S5); float* pgate = (float*)(ws + WS_S5 + (size_t)T * 512);
    const float NINF = -__builtin_inff();
#pragma unroll
    for (int c = 0; c < 2; ++c) {
        bf16x8 qa[4];
#pragma unroll
        for (int ks = 0; ks < 4; ++ks) qa[ks] = *(const bf16x8*)(pq + c * 128 + ks * 32);
#pragma unroll
        for (int nt = 0; nt < 8; ++nt) {
            f32x4 z = {0.f, 0.f, 0.f, 0.f};
#pragma unroll
            for (int ks = 0; ks < 4; ++ks) z = mfma16(qa[ks], *(const bf16x8*)(SK + (size_t)c * 16384 + nt * 2048 + ks * 32), z);
#pragma unroll
            for (int reg = 0; reg < 4; ++reg)
            { const float zr = z[reg]; L[(c * 16 + quad * 4 + reg) * 128 + nt * 16 + fr] = __builtin_bit_cast(float, (__builtin_bit_cast(unsigned, zr) & ~0x7Fu) | (unsigned)(127 - (nt * 16 + fr))); }
        }
    }
    asm volatile("s_waitcnt lgkmcnt(0)" ::: "memory");
#pragma nounroll
    for (int it = 0; it < 4; ++it) {
        const int row = quad * 4 + it;
        float v[8], top0[16], t1 = 0.f;
#pragma unroll
        for (int nt = 0; nt < 8; ++nt) v[nt] = L[row * 128 + nt * 16 + fr];
#pragma unroll
        for (int rd = 0; rd < 16; ++rd) {
            float m = v[0];
#pragma unroll
            for (int nt = 1; nt < 8; ++nt) m = fmaxf(m, v[nt]);
            const float gm = rowmax16(m); top0[rd] = gm;
#pragma unroll
            for (int nt = 0; nt < 8; ++nt) if (v[nt] == gm) v[nt] = NINF;
        }
#pragma unroll
        for (int nt = 0; nt < 8; ++nt) v[nt] = L[(16 + row) * 128 + nt * 16 + fr];
#pragma unroll
        for (int rd = 0; rd < 16; ++rd) {
            float m = v[0];
#pragma unroll
            for (int nt = 1; nt < 8; ++nt) m = fmaxf(m, v[nt]);
            const float gm = rowmax16(m); if (fr == rd) t1 = gm;
#pragma unroll
            for (int nt = 0; nt < 8; ++nt) if (v[nt] == gm) v[nt] = NINF;
        }
        float cand[16];
#pragma unroll
        for (int i = 0; i < 16; ++i) cand[i] = __builtin_bit_cast(float, (__builtin_bit_cast(unsigned, top0[i] + t1) & ~0xFFu) | (unsigned)(255 - (i * 16 + fr)));
        const int i1 = 127 - (int)(__builtin_bit_cast(unsigned, t1) & 0x7Fu);
        float best = 0.f; int bidx = 0;
#pragma unroll
        for (int rd = 0; rd < 16; ++rd) {
            float m = cand[0];
#pragma unroll
            for (int i = 1; i < 16; ++i) m = fmaxf(m, cand[i]);
            const float gm = rowmax16(m);
            int mine = -1;
#pragma unroll
            for (int i = 0; i < 16; ++i) if (cand[i] == gm) { cand[i] = NINF; mine = (127 - (int)(__builtin_bit_cast(unsigned, top0[i]) & 0x7Fu)) * 128 + i1; }
            const int gi = rowmax16i(mine);
            if (fr == rd) { best = gm; bidx = gi; }
        }
        const float mx = rowmax16(best), e = __expf(best - mx), ssum = rowsum16(e);
        const size_t o = ((size_t)(tok0 + row) * 8 + h) * 16 + fr;
        pidx[o] = bidx; pgate[o] = e / ssum;
    }
    asm volatile("s_waitcnt lgkmcnt(0)" ::: "memory");
}

#define TK_CE(a, b) { const float hi_ = vmax(a, b), lo_ = vmin(a, b); a = hi_; b = lo_; }
DEV float select16(float (&s)[8], int fr) {
    TK_CE(s[0], s[1]) TK_CE(s[2], s[3]) TK_CE(s[4], s[5]) TK_CE(s[6], s[7])
    TK_CE(s[0], s[2]) TK_CE(s[1], s[3]) TK_CE(s[4], s[6]) TK_CE(s[5], s[7])
    TK_CE(s[1], s[2]) TK_CE(s[5], s[6])
    TK_CE(s[0], s[4]) TK_CE(s[1], s[5]) TK_CE(s[2], s[6]) TK_CE(s[3], s[7])
    TK_CE(s[2], s[4]) TK_CE(s[3], s[5])
    TK_CE(s[1], s[2]) TK_CE(s[3], s[4]) TK_CE(s[5], s[6])
    const float NINF = -__builtin_inff(); float mine = 0.f;
#pragma unroll
    for (int rd = 0; rd < 16; ++rd) {
        const float gm = rowmax16d(s[0]); const bool own = (s[0] == gm);
        mine = (fr == rd) ? gm : mine;
#pragma unroll
        for (int k = 0; k < 7; ++k) s[k] = own ? s[k + 1] : s[k];
        s[7] = own ? NINF : s[7];
    }
    return mine;
}
DEV void topk2_task(const KArgs& A, int task, LAS float* L  , int lane) {
    unsigned char* ws = A.ws;
    const int fr = lane & 15, quad = lane >> 4;
    const int tok0 = (task >> 3) * 16, h = task & 7;
    const bf16_t* pq = (const bf16_t*)(ws + WS_S1) + (size_t)(tok0 + fr) * 2048 + h * 256 + quad * 8;
    const bf16_t* SK = (const bf16_t*)(ws + WS_SK) + (size_t)(h * 2) * 16384 + (size_t)fr * 128 + quad * 8;
    int* pidx = (int*)(ws + WS_S5); float* pgate = (float*)(ws + WS_S5 + (size_t)T * 512);
    const float NINF = -__builtin_inff();
#pragma unroll
    for (int c = 0; c < 2; ++c) {
        bf16x8 qa[4];
#pragma unroll
        for (int ks = 0; ks < 4; ++ks) qa[ks] = *(const bf16x8*)(pq + c * 128 + ks * 32);
#pragma unroll
        for (int nt = 0; nt < 8; ++nt) {
            f32x4 z = {0.f, 0.f, 0.f, 0.f};
#pragma unroll
            for (int ks = 0; ks < 4; ++ks) z = mfma16(qa[ks], *(const bf16x8*)(SK + (size_t)c * 16384 + nt * 2048 + ks * 32), z);
#pragma unroll
            for (int reg = 0; reg < 4; ++reg)
            { const float zr = z[reg]; L[(c * 16 + quad * 4 + reg) * 128 + nt * 16 + fr] = __builtin_bit_cast(float, (__builtin_bit_cast(unsigned, zr) & ~0x7Fu) | (unsigned)(127 - (nt * 16 + fr))); }
        }
    }
    asm volatile("s_waitcnt lgkmcnt(0)" ::: "memory");
    const unsigned long long TI1 = 0xFEDCBA9811111111ull, TJ0 = 0xFEDCBA9876543210ull, TJ1 = 0x0000000076543210ull,
                             TI2 = 0x6655444333322222ull, TJ2 = 0x1010210321043210ull;
    const int sh = 4 * fr, rb = lane & 48;
    const int i_s[4] = {0, (int)(TI1 >> sh) & 15, (int)(TI2 >> sh) & 15, 7};
    const int j_s[4] = {(int)(TJ0 >> sh) & 15, (int)(TJ1 >> sh) & 15, (int)(TJ2 >> sh) & 15, fr & 1};
#pragma nounroll
    for (int it = 0; it < 4; ++it) {
        const int row = quad * 4 + it;
        float v[8];
#pragma unroll
        for (int nt = 0; nt < 8; ++nt) v[nt] = L[row * 128 + nt * 16 + fr];
        const float t0 = select16(v, fr);
#pragma unroll
        for (int nt = 0; nt < 8; ++nt) v[nt] = L[(16 + row) * 128 + nt * 16 + fr];
        const float t1 = select16(v, fr);
        float val[4], cur[4]; int idx[4], rec[4];
#pragma unroll
        for (int s4 = 0; s4 < 4; ++s4) {
            const float a = __builtin_bit_cast(float, __builtin_amdgcn_ds_bpermute((rb + i_s[s4]) * 4, __builtin_bit_cast(int, t0)));
            const float b = __builtin_bit_cast(float, __builtin_amdgcn_ds_bpermute((rb + j_s[s4]) * 4, __builtin_bit_cast(int, t1)));
            float sm = __builtin_bit_cast(float, (__builtin_bit_cast(unsigned, a + b) & ~0x3Fu) | (unsigned)(63 - (s4 * 16 + fr)));
            if (s4 == 3 && fr >= 2) sm = NINF;
            val[s4] = sm; cur[s4] = sm; rec[s4] = -1;
            idx[s4] = (127 - (int)(__builtin_bit_cast(unsigned, a) & 0x7Fu)) * 128 + (127 - (int)(__builtin_bit_cast(unsigned, b) & 0x7Fu));
        }
        float gmax = 0.f, ssum = 0.f;
#pragma unroll
        for (int rd = 0; rd < 16; ++rd) {
            const float gm = rowmax16d(vmax(vmax(cur[0], cur[1]), vmax(cur[2], cur[3])));
            if (rd == 0) gmax = gm;
            ssum += __expf(gm - gmax);
#pragma unroll
            for (int s4 = 0; s4 < 4; ++s4) { const bool own = (cur[s4] == gm); cur[s4] = own ? NINF : cur[s4]; rec[s4] = own ? rd : rec[s4]; }
        }
        const float inv = 1.f / ssum; const size_t ob = ((size_t)(tok0 + row) * 8 + h) * 16;
#pragma unroll
        for (int s4 = 0; s4 < 4; ++s4) if (rec[s4] >= 0) { pidx[ob + rec[s4]] = idx[s4]; pgate[ob + rec[s4]] = __expf(val[s4] - gmax) * inv; }
    }
    asm volatile("s_waitcnt lgkmcnt(0)" ::: "memory");
}

constexpr int TK_SKROW = 272, TK_SK_BYTES = 256 * TK_SKROW, TK_L_OFF = TK_SK_BYTES, TK_LT_OFF = TK_L_OFF + 8 * 8192, TK_LDS_END = TK_LT_OFF + 8 * 1024;
DEV void topk3_phase(const KArgs& A, LAS unsigned char* lds, int lane, int wave, int G) {
    unsigned char* ws = A.ws;
    const int fr = lane & 15, quad = lane >> 4, tid = wave * 64 + lane;
    const int h = blockIdx.x & 7, grp = blockIdx.x >> 3, ngrp = G >> 3;
    {
        const unsigned char* src = ws + WS_SK + (size_t)h * 65536;
#pragma unroll
        for (int i = 0; i < 8; ++i) { const int q = tid + 512 * i, row = q >> 4, c16 = q & 15; *(LAS u32x4*)(lds + row * TK_SKROW + c16 * 16) = *(const u32x4*)(src + (size_t)q * 16); }
        asm volatile("s_waitcnt vmcnt(0) lgkmcnt(0)" ::: "memory");
        __builtin_amdgcn_s_barrier();
        asm volatile("" ::: "memory");
    }
    LAS float* L = (LAS float*)(lds + TK_L_OFF + wave * 8192);
    LAS float* Lt = (LAS float*)(lds + TK_LT_OFF + wave * 1024);
    const LAS unsigned char* skb = lds + fr * TK_SKROW + quad * 16;
    int* pidx = (int*)(ws + WS_S5); float* pgate = (float*)(ws + WS_S5 + (size_t)T * 512);
    const float NINF = -__builtin_inff();
    const unsigned long long TI1 = 0xFEDCBA9811111111ull, TJ0 = 0xFEDCBA9876543210ull, TJ1 = 0x0000000076543210ull,
                             TI2 = 0x6655444333322222ull, TJ2 = 0x1010210321043210ull;
    const int sh = 4 * fr, rb = lane & 48;
    const int i_s[4] = {0, (int)(TI1 >> sh) & 15, (int)(TI2 >> sh) & 15, 7};
    const int j_s[4] = {(int)(TJ0 >> sh) & 15, (int)(TJ1 >> sh) & 15, (int)(TJ2 >> sh) & 15, fr & 1};
#pragma nounroll
    for (int tt = grp + ngrp * wave; tt < T / 16; tt += ngrp * 8) {
        const int tok0 = tt * 16;
        const bf16_t* pq = (const bf16_t*)(ws + WS_S1) + (size_t)(tok0 + fr) * 2048 + h * 256 + quad * 8;
        bf16x8 qa[2][4];
#pragma unroll
        for (int c = 0; c < 2; ++c)
#pragma unroll
            for (int ks = 0; ks < 4; ++ks) qa[c][ks] = *(const bf16x8*)(pq + c * 128 + ks * 32);
#pragma unroll
        for (int c = 0; c < 2; ++c) {
#pragma unroll
            for (int nt = 0; nt < 8; ++nt) {
                f32x4 z = {0.f, 0.f, 0.f, 0.f};
#pragma unroll
                for (int ks = 0; ks < 4; ++ks) z = mfma16(qa[c][ks], *(const LAS bf16x8*)(skb + (c * 128 + nt * 16) * TK_SKROW + ks * 64), z);
#pragma unroll
                for (int reg = 0; reg < 4; ++reg)
                { const float zr = z[reg]; L[(quad * 4 + reg) * 128 + nt * 16 + fr] = __builtin_bit_cast(float, (__builtin_bit_cast(unsigned, zr) & ~0x7Fu) | (unsigned)(127 - (nt * 16 + fr))); }
            }
            asm volatile("s_waitcnt lgkmcnt(0)" ::: "memory");
#pragma nounroll
            for (int it = 0; it < 4; ++it) {
                const int row = quad * 4 + it;
                float v[8];
#pragma unroll
                for (int nt = 0; nt < 8; ++nt) v[nt] = L[row * 128 + nt * 16 + fr];
                const float tc = select16(v, fr);
                if (c == 0) { Lt[row * 16 + fr] = tc; }
                else {
                    const float t1 = tc, t0 = Lt[row * 16 + fr];
                    float val[4], cur[4]; int idx[4], rec[4];
#pragma unroll
                    for (int s4 = 0; s4 < 4; ++s4) {
                        const float a = __builtin_bit_cast(float, __builtin_amdgcn_ds_bpermute((rb + i_s[s4]) * 4, __builtin_bit_cast(int, t0)));
                        const float b = __builtin_bit_cast(float, __builtin_amdgcn_ds_bpermute((rb + j_s[s4]) * 4, __builtin_bit_cast(int, t1)));
                        float sm = __builtin_bit_cast(float, (__builtin_bit_cast(unsigned, a + b) & ~0x3Fu) | (unsigned)(63 - (s4 * 16 + fr)));
                        if (s4 == 3 && fr >= 2) sm = NINF;
                        val[s4] = sm; cur[s4] = sm; rec[s4] = -1;
                        idx[s4] = (127 - (int)(__builtin_bit_cast(unsigned, a) & 0x7Fu)) * 128 + (127 - (int)(__builtin_bit_cast(unsigned, b) & 0x7Fu));
                    }
                    float gmax = 0.f, ssum = 0.f;
#pragma unroll
                    for (int rd = 0; rd < 16; ++rd) {
                        const float gm = rowmax16d(vmax(vmax(cur[0], cur[1]), vmax(cur[2], cur[3])));
                        if (rd == 0) gmax = gm;
                        ssum += __expf(gm - gmax);
#pragma unroll
                        for (int s4 = 0; s4 < 4; ++s4) { const bool own = (cur[s4] == gm); cur[s4] = own ? NINF : cur[s4]; rec[s4] = own ? rd : rec[s4]; }
                    }
                    const float inv = __builtin_amdgcn_rcpf(ssum); const size_t ob = ((size_t)(tok0 + row) * 8 + h) * 16;
#pragma unroll
                    for (int s4 = 0; s4 < 4; ++s4) if (rec[s4] >= 0) { pidx[ob + rec[s4]] = idx[s4]; pgate[ob + rec[s4]] = __expf(val[s4] - gmax) * inv; }
                }
            }
            asm volatile("s_waitcnt lgkmcnt(0)" ::: "memory");
        }
    }
}

DEV float wave_max(float v) {
#pragma unroll
    for (int o = 1; o < 64; o <<= 1) v = fmaxf(v, __shfl_xor(v, o));
    return v;
}
DEV void topk_ref_task(const KArgs& A, int task, LAS float* L  , int lane) {
    unsigned char* ws = A.ws;
    const int tok = task >> 3, h = task & 7;
    const bf16_t* pq = (const bf16_t*)(ws + WS_S1) + (size_t)tok * 2048 + h * 256;
    const bf16_t* SK = (const bf16_t*)(ws + WS_SK) + (size_t)(h * 2) * 16384;
    int* pidx = (int*)(ws + WS_S5); float* pgate = (float*)(ws + WS_S5 + (size_t)T * 512);
    const float NINF = -__builtin_inff();
    LAS float* qf = L;
    LAS float* tv = L + 256;
    LAS int* ti = (LAS int*)(L + 288);
    LAS float* bv = L + 320;
    LAS int* bi = (LAS int*)(L + 336);
    { const unsigned long long w = *(const unsigned long long*)(pq + lane * 4); const unsigned lo = (unsigned)w, hi = (unsigned)(w >> 32);
      qf[lane * 4] = bflo(lo); qf[lane * 4 + 1] = bfhi(lo); qf[lane * 4 + 2] = bflo(hi); qf[lane * 4 + 3] = bfhi(hi); }
    asm volatile("s_waitcnt lgkmcnt(0)" ::: "memory");
    float sc[4];
#pragma unroll
    for (int e = 0; e < 4; ++e) {
        const int p = lane + 64 * e, c = p >> 7, n = p & 127; const bf16_t* kr = SK + (size_t)(c * 128 + n) * 128; float s = 0.f;
#pragma nounroll
        for (int d = 0; d < 128; d += 8) { float kv[8]; ld8bf(kr + d, kv);
#pragma unroll
            for (int j = 0; j < 8; ++j) s += qf[c * 128 + d + j] * kv[j]; }
        sc[e] = s;
    }
#pragma unroll
    for (int c = 0; c < 2; ++c)
#pragma nounroll
        for (int rd = 0; rd < 16; ++rd) {
            const float m = wave_max(fmaxf(sc[2 * c], sc[2 * c + 1]));
            if (sc[2 * c] == m) { sc[2 * c] = NINF; tv[c * 16 + rd] = m; ti[c * 16 + rd] = (lane + 128 * c) & 127; }
            else if (sc[2 * c + 1] == m) { sc[2 * c + 1] = NINF; tv[c * 16 + rd] = m; ti[c * 16 + rd] = (lane + 64 + 128 * c) & 127; }
        }
    asm volatile("s_waitcnt lgkmcnt(0)" ::: "memory");
    float cd[4];
#pragma unroll
    for (int e = 0; e < 4; ++e) { const int p = lane * 4 + e; cd[e] = tv[p >> 4] + tv[16 + (p & 15)]; }
#pragma nounroll
    for (int rd = 0; rd < 16; ++rd) {
        const float m = wave_max(fmaxf(fmaxf(cd[0], cd[1]), fmaxf(cd[2], cd[3])));
        int pe = -1;
#pragma unroll
        for (int e = 3; e >= 0; --e) if (cd[e] == m) pe = e;
        if (pe >= 0) {
#pragma unroll
            for (int e = 0; e < 4; ++e) if (e == pe) cd[e] = NINF;
            const int p = lane * 4 + pe; bv[rd] = m; bi[rd] = ti[p >> 4] * 128 + ti[16 + (p & 15)];
        }
    }
    asm volatile("s_waitcnt lgkmcnt(0)" ::: "memory");
    if (lane < 16) {
        const float b = bv[lane], mx = bv[0]; const float e = __expf(b - mx); float ssum = rowsum16(e);
        const size_t o = ((size_t)tok * 8 + h) * 16 + lane; pidx[o] = bi[lane]; pgate[o] = e / ssum;
    }
    asm volatile("s_waitcnt lgkmcnt(0)" ::: "memory");
}

typedef float f32x2 __attribute__((ext_vector_type(2)));
DEV void cvt16(const u32x4 q, f32x2 (&f)[8]) {
    const int q0 = (int)q.x, q1 = (int)q.y, q2 = (int)q.z, q3 = (int)q.w;
    f[0] = __builtin_amdgcn_cvt_pk_f32_fp8(q0, false); f[1] = __builtin_amdgcn_cvt_pk_f32_fp8(q0, true);
    f[2] = __builtin_amdgcn_cvt_pk_f32_fp8(q1, false); f[3] = __builtin_amdgcn_cvt_pk_f32_fp8(q1, true);
    f[4] = __builtin_amdgcn_cvt_pk_f32_fp8(q2, false); f[5] = __builtin_amdgcn_cvt_pk_f32_fp8(q2, true);
    f[6] = __builtin_amdgcn_cvt_pk_f32_fp8(q3, false); f[7] = __builtin_amdgcn_cvt_pk_f32_fp8(q3, true);
}
DEV void peer_token(const KArgs& A, int tok, int lane) {
    unsigned char* ws = A.ws;
    float* x1 = A.out + (size_t)tok * 1024 + lane * 16;
    const unsigned char* PU = ws + WS_PU + lane * 16; const unsigned char* PV = ws + WS_PV + lane * 16;
    const int* pidx = (const int*)(ws + WS_S5); const float* pgate = (const float*)(ws + WS_S5 + (size_t)T * 512);
    const float rs = rsqrtf(((const float*)(ws + WS_SSQ2))[tok] * (1.f / 1024.f) + EPS);
    f32x2 xs[8];
    { float a[8], b[8], ga[8], gb[8]; ld8f(x1, a); ld8f(x1 + 8, b); ld8f(A.in[18] + lane * 16, ga); ld8f(A.in[18] + lane * 16 + 8, gb);
#pragma unroll
      for (int i = 0; i < 4; ++i) { xs[i] = (f32x2){a[2 * i] * rs * ga[2 * i], a[2 * i + 1] * rs * ga[2 * i + 1]}; xs[4 + i] = (f32x2){b[2 * i] * rs * gb[2 * i], b[2 * i + 1] * rs * gb[2 * i + 1]}; } }
    f32x2 o[8];
#pragma unroll
    for (int i = 0; i < 8; ++i) o[i] = (f32x2){0.f, 0.f};
    const int* pi = pidx + (size_t)tok * 128 + (lane >> 2); const float* pg = pgate + (size_t)tok * 128 + (lane >> 2);
    int eidx = pi[0];
    u32x4 uq[16];
#pragma unroll
    for (int k = 0; k < 16; ++k) { const int row = __builtin_amdgcn_readlane(eidx, 4 * k); uq[k] = *(const u32x4*)(PU + (size_t)row * 1024); }
#pragma nounroll
    for (int h = 0; h < 8; ++h) {
        const float gt = pg[h * 16];
        const int enext = pi[(h < 7 ? h + 1 : 7) * 16];
        u32x4 vq[16];
#pragma unroll
        for (int k = 0; k < 16; ++k) { const int row = __builtin_amdgcn_readlane(eidx, 4 * k); vq[k] = *(const u32x4*)(PV + (size_t)row * 1024); }
        float part[16];
#pragma unroll
        for (int k = 0; k < 16; ++k) { f32x2 f[8]; cvt16(uq[k], f); f32x2 acc = f[0] * xs[0];
#pragma unroll
            for (int i = 1; i < 8; ++i) acc += f[i] * xs[i];
            part[k] = acc.x + acc.y; }
        eidx = enext;
#pragma unroll
        for (int k = 0; k < 16; ++k) { const int row = __builtin_amdgcn_readlane(eidx, 4 * k); uq[k] = *(const u32x4*)(PU + (size_t)row * 1024); }
        float r8[8], r4[4], r2[2];
        const bool b5 = lane & 32, b4 = lane & 16, b3 = lane & 8, b2 = lane & 4;
#pragma unroll
        for (int i = 0; i < 8; ++i) { const float keep = b5 ? part[i + 8] : part[i], send = b5 ? part[i] : part[i + 8]; r8[i] = keep + __shfl_xor(send, 32); }
#pragma unroll
        for (int i = 0; i < 4; ++i) { const float keep = b4 ? r8[i + 4] : r8[i], send = b4 ? r8[i] : r8[i + 4]; r4[i] = keep + __shfl_xor(send, 16); }
#pragma unroll
        for (int i = 0; i < 2; ++i) { const float keep = b3 ? r4[i + 2] : r4[i], send = b3 ? r4[i] : r4[i + 2]; r2[i] = keep + __shfl_xor(send, 8); }
        float act = (b2 ? r2[1] : r2[0]) + __shfl_xor(b2 ? r2[0] : r2[1], 4);
        act += __shfl_xor(act, 2); act += __shfl_xor(act, 1);
        const float w = gt * gelu_t(act * (1.f / 256.f)) * (1.f / 64.f);
#pragma unroll
        for (int k = 0; k < 16; ++k) { const float wk = __builtin_bit_cast(float, __builtin_amdgcn_readlane(__builtin_bit_cast(int, w), 4 * k)); const f32x2 w2 = {wk, wk}; f32x2 f[8]; cvt16(vq[k], f);
#pragma unroll
            for (int i = 0; i < 8; ++i) o[i] += w2 * f[i]; }
    }
    float a[8], b[8]; ld8f(x1, a); ld8f(x1 + 8, b);
    float ss = 0.f;
#pragma unroll
    for (int i = 0; i < 4; ++i) { a[2 * i] += o[i].x; a[2 * i + 1] += o[i].y; b[2 * i] += o[4 + i].x; b[2 * i + 1] += o[4 + i].y; }
#pragma unroll
    for (int i = 0; i < 8; ++i) ss += a[i] * a[i] + b[i] * b[i];
    st8f(x1, a); st8f(x1 + 8, b);
    bf16_t* x2b = (bf16_t*)(ws + WS_S2) + (size_t)tok * 1024 + lane * 16;
    st8bf(x2b, a); st8bf(x2b + 8, b);
    ss = wave_sum(ss);
    if (lane == 0) ((float*)(ws + WS_RSTD3))[tok] = rsqrtf(ss * (1.f / 1024.f) + EPS);
}

DEV void cvt32(const u32x4 q, f32x2 (&f)[16]) {
    const unsigned q0 = q.x, q1 = q.y, q2 = q.z, q3 = q.w;
    f[0] = __builtin_amdgcn_cvt_scalef32_pk_f32_fp4(q0, 1.0f, 0); f[1] = __builtin_amdgcn_cvt_scalef32_pk_f32_fp4(q0, 1.0f, 1); f[2] = __builtin_amdgcn_cvt_scalef32_pk_f32_fp4(q0, 1.0f, 2); f[3] = __builtin_amdgcn_cvt_scalef32_pk_f32_fp4(q0, 1.0f, 3);
    f[4] = __builtin_amdgcn_cvt_scalef32_pk_f32_fp4(q1, 1.0f, 0); f[5] = __builtin_amdgcn_cvt_scalef32_pk_f32_fp4(q1, 1.0f, 1); f[6] = __builtin_amdgcn_cvt_scalef32_pk_f32_fp4(q1, 1.0f, 2); f[7] = __builtin_amdgcn_cvt_scalef32_pk_f32_fp4(q1, 1.0f, 3);
    f[8] = __builtin_amdgcn_cvt_scalef32_pk_f32_fp4(q2, 1.0f, 0); f[9] = __builtin_amdgcn_cvt_scalef32_pk_f32_fp4(q2, 1.0f, 1); f[10] = __builtin_amdgcn_cvt_scalef32_pk_f32_fp4(q2, 1.0f, 2); f[11] = __builtin_amdgcn_cvt_scalef32_pk_f32_fp4(q2, 1.0f, 3);
    f[12] = __builtin_amdgcn_cvt_scalef32_pk_f32_fp4(q3, 1.0f, 0); f[13] = __builtin_amdgcn_cvt_scalef32_pk_f32_fp4(q3, 1.0f, 1); f[14] = __builtin_amdgcn_cvt_scalef32_pk_f32_fp4(q3, 1.0f, 2); f[15] = __builtin_amdgcn_cvt_scalef32_pk_f32_fp4(q3, 1.0f, 3);
}
DEV void peer_token4(const KArgs& A, int tok, int lane) {
    unsigned char* ws = A.ws;
    const int half = lane >> 5, sub = lane & 31;
    const bf16_t* x1 = (const bf16_t*)(ws + WS_S3) + (size_t)tok * 1024 + sub * 32;
    const unsigned char* PU = ws + WS_PU + sub * 16; const unsigned char* PV = ws + WS_PV + sub * 16;
    const int e_l = (half << 3) | ((lane >> 2) & 7);
    const int* pi = (const int*)(ws + WS_S5) + (size_t)tok * 128 + e_l; const float* pg = (const float*)(ws + WS_S5 + (size_t)T * 512) + (size_t)tok * 128 + e_l;
    const float rs = rsqrtf(((const float*)(ws + WS_SSQ2))[tok] * (1.f / 1024.f) + EPS);
    f32x2 xs[16];
#pragma unroll
    for (int j = 0; j < 4; ++j) { float a[8], g[8]; ld8bf(x1 + 8 * j, a); ld8f(A.in[18] + sub * 32 + 8 * j, g);
#pragma unroll
        for (int i = 0; i < 4; ++i) xs[4 * j + i] = (f32x2){a[2 * i] * rs * g[2 * i], a[2 * i + 1] * rs * g[2 * i + 1]}; }
    f32x2 o[16];
#pragma unroll
    for (int i = 0; i < 16; ++i) o[i] = (f32x2){0.f, 0.f};
    const bool b4 = lane & 16, b3 = lane & 8, b2 = lane & 4;
#pragma nounroll
    for (int h = 0; h < 8; ++h) {
        const int eidx = pi[h * 16]; const float gt = pg[h * 16];
        float part[8];
        {
            u32x4 uq[8];
#pragma unroll
            for (int k = 0; k < 8; ++k) { const int r0 = __builtin_amdgcn_readlane(eidx, 4 * k), r1 = __builtin_amdgcn_readlane(eidx, 32 + 4 * k); uq[k] = *(const u32x4*)(PU + (size_t)(half ? r1 : r0) * 512); }
#pragma unroll
            for (int k = 0; k < 8; ++k) { f32x2 f[16]; cvt32(uq[k], f); f32x2 acc = f[0] * xs[0];
#pragma unroll
                for (int i = 1; i < 16; ++i) acc += f[i] * xs[i];
                part[k] = acc.x + acc.y; }
        }
        float r4[4], r2[2];
#pragma unroll
        for (int i = 0; i < 4; ++i) { const float keep = b4 ? part[i + 4] : part[i], send = b4 ? part[i] : part[i + 4]; r4[i] = keep + __shfl_xor(send, 16); }
#pragma unroll
        for (int i = 0; i < 2; ++i) { const float keep = b3 ? r4[i + 2] : r4[i], send = b3 ? r4[i] : r4[i + 2]; r2[i] = keep + __shfl_xor(send, 8); }
        float act = (b2 ? r2[1] : r2[0]) + __shfl_xor(b2 ? r2[0] : r2[1], 4);
        act += __shfl_xor(act, 2); act += __shfl_xor(act, 1);
        const float w = gt * gelu_t(act * (1.f / PEER_SU)) * (1.f / PEER_SV);
        {
            u32x4 vq[8];
#pragma unroll
            for (int k = 0; k < 8; ++k) { const int r0 = __builtin_amdgcn_readlane(eidx, 4 * k), r1 = __builtin_amdgcn_readlane(eidx, 32 + 4 * k); vq[k] = *(const u32x4*)(PV + (size_t)(half ? r1 : r0) * 512); }
#pragma unroll
            for (int k = 0; k < 8; ++k) {
                const float w0 = __builtin_bit_cast(float, __builtin_amdgcn_readlane(__builtin_bit_cast(int, w), 4 * k)), w1 = __builtin_bit_cast(float, __builtin_amdgcn_readlane(__builtin_bit_cast(int, w), 32 + 4 * k));
                const float wk = half ? w1 : w0; const f32x2 w2 = {wk, wk}; f32x2 f[16]; cvt32(vq[k], f);
#pragma unroll
                for (int i = 0; i < 16; ++i) o[i] += w2 * f[i]; }
        }
    }
    float a[8], b[8];
#pragma unroll
    for (int i = 0; i < 8; ++i) {
        const float lo0 = o[i].x + __shfl_xor(o[i].x, 32), lo1 = o[i].y + __shfl_xor(o[i].y, 32), hi0 = o[8 + i].x + __shfl_xor(o[8 + i].x, 32), hi1 = o[8 + i].y + __shfl_xor(o[8 + i].y, 32);
        const float e0 = half ? hi0 : lo0, e1 = half ? hi1 : lo1;
        if (i < 4) { a[2 * i] = e0; a[2 * i + 1] = e1; } else { b[2 * (i - 4)] = e0; b[2 * (i - 4) + 1] = e1; }
    }
    float xa[8], xb[8]; ld8bf(x1 + half * 16, xa); ld8bf(x1 + half * 16 + 8, xb);
    float ss = 0.f;
#pragma unroll
    for (int i = 0; i < 8; ++i) { a[i] += xa[i]; b[i] += xb[i]; ss += a[i] * a[i] + b[i] * b[i]; }
    bf16_t* x2b = (bf16_t*)(ws + WS_S2) + (size_t)tok * 1024 + sub * 32 + half * 16;
    st8bf(x2b, a); st8bf(x2b + 8, b);
    ss = wave_sum(ss);
    if (lane == 0) ((float*)(ws + WS_RSTD3))[tok] = rsqrtf(ss * (1.f / 1024.f) + EPS);
}

typedef int v8i_t __attribute__((ext_vector_type(8)));
DEV unsigned pk4_e4m3(float a, float b, float c, float d) { int p = __builtin_amdgcn_cvt_pk_fp8_f32(a, b, 0, false); p = __builtin_amdgcn_cvt_pk_fp8_f32(c, d, p, true); return (unsigned)p; }
DEV void peer_token5(const KArgs& A, int tok, int lane, LAS unsigned char* xq  , const int h0, const int h1, LAS float* xsend, const LAS float* xrecv, const bool do_bar) {
    unsigned char* ws = A.ws;
    const int fr = lane & 15, quad = lane >> 4, half = lane >> 5, sub = lane & 31;
    const bf16_t* x1 = (const bf16_t*)(ws + WS_S3) + (size_t)tok * 1024;
    const unsigned char* PU = ws + WS_PU + quad * 16; const unsigned char* PV = ws + WS_PV + sub * 16;
    const int* pi = (const int*)(ws + WS_S5) + (size_t)tok * 128 + fr; const float* pg = (const float*)(ws + WS_S5 + (size_t)T * 512) + (size_t)tok * 128 + quad * 4;
    const float rs = rsqrtf(((const float*)(ws + WS_SSQ2))[tok] * (1.f / 1024.f) + EPS);
    {
        float a[8], b[8], ga[8], gb[8]; ld8bf(x1 + lane * 16, a); ld8bf(x1 + lane * 16 + 8, b); ld8f(A.in[18] + lane * 16, ga); ld8f(A.in[18] + lane * 16 + 8, gb);
#pragma unroll
        for (int i = 0; i < 8; ++i) { a[i] *= rs * ga[i]; b[i] *= rs * gb[i]; }
        const unsigned h0 = pk8_fp4(a, 1.f), h1 = pk8_fp4(b, 1.f);
        float ra[8], rb[8];
#define XRES(i) { const f32x2 d0 = __builtin_amdgcn_cvt_scalef32_pk_f32_fp4(h0, 1.0f, i), d1 = __builtin_amdgcn_cvt_scalef32_pk_f32_fp4(h1, 1.0f, i); \
            ra[2 * i] = a[2 * i] - d0.x; ra[2 * i + 1] = a[2 * i + 1] - d0.y; rb[2 * i] = b[2 * i] - d1.x; rb[2 * i + 1] = b[2 * i + 1] - d1.y; }
        XRES(0) XRES(1) XRES(2) XRES(3)
#undef XRES
        const unsigned l0 = pk8_fp4(ra, 8.f), l1 = pk8_fp4(rb, 8.f);
        *(LAS u32x2*)(xq + lane * 8) = (u32x2){h0, h1};
        *(LAS u32x2*)(xq + 512 + lane * 8) = (u32x2){l0, l1};
    }
    asm volatile("s_waitcnt lgkmcnt(0)" ::: "memory");
    u32x4 xh[8], xl[8];
#pragma unroll
    for (int ks = 0; ks < 8; ++ks) { xh[ks] = *(const LAS u32x4*)(xq + ks * 64 + quad * 16); xl[ks] = *(const LAS u32x4*)(xq + 512 + ks * 64 + quad * 16); }
    f32x2 o[16];
#pragma unroll
    for (int i = 0; i < 16; ++i) o[i] = (f32x2){0.f, 0.f};
    int idx_l = pi[h0 * 16]; f32x4 gt4 = *(const f32x4*)(pg + h0 * 16);
    u32x4 ua[8];
#pragma unroll
    for (int ks = 0; ks < 8; ++ks) ua[ks] = *(const u32x4*)(PU + (size_t)idx_l * 512 + ks * 64);
#pragma nounroll
    for (int h = h0; h < h1; ++h) {
        const int hn = h < h1 - 1 ? h + 1 : h1 - 1;
        const int idx_n = pi[hn * 16]; const f32x4 gt_n = *(const f32x4*)(pg + hn * 16);
        u32x4 vq[8];
#pragma unroll
        for (int k = 0; k < 8; ++k) { const int r0 = __builtin_amdgcn_readlane(idx_l, k), r1 = __builtin_amdgcn_readlane(idx_l, k + 8); vq[k] = *(const u32x4*)(PV + (size_t)(half ? r1 : r0) * 512); }
        f32x4 c = {0.f, 0.f, 0.f, 0.f};
#pragma unroll
        for (int ks = 0; ks < 8; ++ks) { const u32x4 u = ua[ks], bh = xh[ks], bl = xl[ks];
            const v8i_t av = {(int)u.x, (int)u.y, (int)u.z, (int)u.w, 0, 0, 0, 0}, bhv = {(int)bh.x, (int)bh.y, (int)bh.z, (int)bh.w, 0, 0, 0, 0}, blv = {(int)bl.x, (int)bl.y, (int)bl.z, (int)bl.w, 0, 0, 0, 0};
            c = __builtin_amdgcn_mfma_scale_f32_16x16x128_f8f6f4(av, bhv, c, 4, 4, 0, 0x7F7F7F7F, 0, 0x7F7F7F7F);
            c = __builtin_amdgcn_mfma_scale_f32_16x16x128_f8f6f4(av, blv, c, 4, 4, 0, 0x7F7F7F7F, 0, 0x7C7C7C7C); }
#pragma unroll
        for (int ks = 0; ks < 8; ++ks) ua[ks] = *(const u32x4*)(PU + (size_t)idx_n * 512 + ks * 64);
        float w[4];
        { const float c0 = c[0], c1 = c[1], c2 = c[2], c3 = c[3], g0 = gt4[0], g1 = gt4[1], g2 = gt4[2], g3 = gt4[3];
          w[0] = g0 * gelu_t(c0 * (1.f / PEER_SU)) * (1.f / PEER_SV); w[1] = g1 * gelu_t(c1 * (1.f / PEER_SU)) * (1.f / PEER_SV);
          w[2] = g2 * gelu_t(c2 * (1.f / PEER_SU)) * (1.f / PEER_SV); w[3] = g3 * gelu_t(c3 * (1.f / PEER_SU)) * (1.f / PEER_SV); }
#pragma unroll
        for (int k = 0; k < 8; ++k) {
            const float w0 = __builtin_bit_cast(float, __builtin_amdgcn_readlane(__builtin_bit_cast(int, w[k & 3]), 16 * (k >> 2))), w1 = __builtin_bit_cast(float, __builtin_amdgcn_readlane(__builtin_bit_cast(int, w[k & 3]), 16 * ((k + 8) >> 2)));
            const float wk = half ? w1 : w0; const f32x2 w2 = {wk, wk}; f32x2 f[16]; cvt32(vq[k], f);
#pragma unroll
            for (int i = 0; i < 16; ++i) o[i] += w2 * f[i]; }
        idx_l = idx_n; gt4 = gt_n;
    }
    float a[8], b[8];
#pragma unroll
    for (int i = 0; i < 8; ++i) {
        const float lo0 = o[i].x + __shfl_xor(o[i].x, 32), lo1 = o[i].y + __shfl_xor(o[i].y, 32), hi0 = o[8 + i].x + __shfl_xor(o[8 + i].x, 32), hi1 = o[8 + i].y + __shfl_xor(o[8 + i].y, 32);
        const float e0 = half ? hi0 : lo0, e1 = half ? hi1 : lo1;
        if (i < 4) { a[2 * i] = e0; a[2 * i + 1] = e1; } else { b[2 * (i - 4)] = e0; b[2 * (i - 4) + 1] = e1; }
    }
    if (xsend) { *(LAS f32x4*)(xsend + lane * 16) = (f32x4){a[0], a[1], a[2], a[3]}; *(LAS f32x4*)(xsend + lane * 16 + 4) = (f32x4){a[4], a[5], a[6], a[7]};
                 *(LAS f32x4*)(xsend + lane * 16 + 8) = (f32x4){b[0], b[1], b[2], b[3]}; *(LAS f32x4*)(xsend + lane * 16 + 12) = (f32x4){b[4], b[5], b[6], b[7]}; }
    if (do_bar) { asm volatile("s_waitcnt lgkmcnt(0)" ::: "memory"); __builtin_amdgcn_s_barrier(); asm volatile("" ::: "memory"); }
    if (xsend) return;
    if (xrecv) { const f32x4 r0 = *(const LAS f32x4*)(xrecv + lane * 16), r1 = *(const LAS f32x4*)(xrecv + lane * 16 + 4), r2 = *(const LAS f32x4*)(xrecv + lane * 16 + 8), r3 = *(const LAS f32x4*)(xrecv + lane * 16 + 12);
        a[0] += r0.x; a[1] += r0.y; a[2] += r0.z; a[3] += r0.w; a[4] += r1.x; a[5] += r1.y; a[6] += r1.z; a[7] += r1.w;
        b[0] += r2.x; b[1] += r2.y; b[2] += r2.z; b[3] += r2.w; b[4] += r3.x; b[5] += r3.y; b[6] += r3.z; b[7] += r3.w; }
    float xa[8], xb[8]; ld8bf(x1 + sub * 32 + half * 16, xa); ld8bf(x1 + sub * 32 + half * 16 + 8, xb);
    float ss = 0.f;
#pragma unroll
    for (int i = 0; i < 8; ++i) { a[i] += xa[i]; b[i] += xb[i]; ss += a[i] * a[i] + b[i] * b[i]; }
    bf16_t* x2b = (bf16_t*)(ws + WS_S2) + (size_t)tok * 1024 + sub * 32 + half * 16;
    st8bf(x2b, a); st8bf(x2b + 8, b);
    ss = wave_sum(ss);
    if (lane == 0) ((float*)(ws + WS_RSTD3))[tok] = rsqrtf(ss * (1.f / 1024.f) + EPS);
}

DEV int lane_id_asm() { int l; asm volatile("v_mbcnt_lo_u32_b32 %0, -1, 0\n\tv_mbcnt_hi_u32_b32 %0, -1, %0" : "=v"(l)); return l; }
DEV void grid_bar(unsigned* ctr, unsigned target, bool leader) {
    asm volatile("s_waitcnt vmcnt(0) lgkmcnt(0)" ::: "memory");
    __builtin_amdgcn_s_barrier();
    if (leader) {
        __builtin_amdgcn_fence(__ATOMIC_RELEASE, "agent");
        asm volatile("s_waitcnt vmcnt(0)" ::: "memory");
        (void)__hip_atomic_fetch_add(ctr, 1u, __ATOMIC_RELAXED, __HIP_MEMORY_SCOPE_AGENT);
        while (__hip_atomic_load(ctr, __ATOMIC_RELAXED, __HIP_MEMORY_SCOPE_AGENT) < target) __builtin_amdgcn_s_sleep(2);
        __builtin_amdgcn_fence(__ATOMIC_ACQUIRE, "agent");
        asm volatile("s_waitcnt vmcnt(0)" ::: "memory");
    }
    __builtin_amdgcn_s_barrier();
}
#define XB_TMO      128
#define XB_XCNT(j)  (256  + 64 * (j))
#define XB_XSUB(j)  (1280 + 64 * (j))
#define XB_XGEN(j)  (2304 + 64 * (j))
#define XB_TOP      3328
#define XB_TOPGEN   3392
#define XCD_BAR_WORDS 3456
#define XB_SPIN_CAP (1u << 20)
DEV unsigned xb_ld(unsigned* p)              { return __hip_atomic_load(p, __ATOMIC_RELAXED, __HIP_MEMORY_SCOPE_AGENT); }
DEV unsigned xb_add(unsigned* p, unsigned v) { return __hip_atomic_fetch_add(p, v, __ATOMIC_RELAXED, __HIP_MEMORY_SCOPE_AGENT); }
DEV unsigned xb_xcc_id() { return (unsigned)__builtin_amdgcn_s_getreg((3 << 11) | 20) & 0xFu; }
#define XB_SPIN(cond, bar) do { unsigned _sp = 0; while (cond) { __builtin_amdgcn_s_sleep(1); \
    if ((++_sp & 255u) == 0u) { if (xb_ld(&(bar)[XB_TMO])) break; if (_sp > XB_SPIN_CAP) { (void)xb_add(&(bar)[XB_TMO], 1u); break; } } } } while (0)
DEV void xcd_bar(unsigned* bar, volatile LAS unsigned* st, bool leader, unsigned G) {
    asm volatile("s_waitcnt vmcnt(0) lgkmcnt(0)" ::: "memory");
    __builtin_amdgcn_s_barrier();
    if (leader) {
        const unsigned x = xb_xcc_id();
        unsigned nloc = st[0], nx = st[1];
        if (nloc == 0u) {
            unsigned sum = 0u, cnt = 0u, mine = 0u, sp = 0u;
            for (;;) { sum = 0u; cnt = 0u; mine = 0u;
#pragma unroll
                for (unsigned j = 0; j < 16; ++j) { const unsigned c = xb_ld(&bar[XB_XCNT(j)]); sum += c; cnt += (c > 0u) ? 1u : 0u; mine = (j == x) ? c : mine; }
                if (sum == G) break;
                __builtin_amdgcn_s_sleep(1);
                if ((++sp & 255u) == 0u) { if (xb_ld(&bar[XB_TMO])) break; if (sp > XB_SPIN_CAP) { (void)xb_add(&bar[XB_TMO], 1u); break; } } }
            nloc = mine > 0u ? mine : 1u; nx = cnt > 0u ? cnt : 1u; st[0] = nloc; st[1] = nx;
        }
        const unsigned old = xb_add(&bar[XB_XSUB(x)], 1u), gen = old / nloc;
        if (old + 1u == (gen + 1u) * nloc) {
            __builtin_amdgcn_fence(__ATOMIC_RELEASE, "agent");
            asm volatile("s_waitcnt vmcnt(0)" ::: "memory");
            const unsigned og = xb_add(&bar[XB_TOP], 1u), tg = og / nx;
            if (og + 1u == (tg + 1u) * nx) (void)xb_add(&bar[XB_TOPGEN], 1u);
            else XB_SPIN(xb_ld(&bar[XB_TOPGEN]) == tg, bar);
            __builtin_amdgcn_fence(__ATOMIC_ACQUIRE, "agent");
            (void)xb_add(&bar[XB_XGEN(x)], 1u);
            asm volatile("s_waitcnt vmcnt(0)" ::: "memory");
        } else {
            XB_SPIN(xb_ld(&bar[XB_XGEN(x)]) == gen, bar);
            __builtin_amdgcn_fence(__ATOMIC_ACQUIRE, "agent");
            asm volatile("s_waitcnt vmcnt(0)" ::: "memory");
        }
    }
    __builtin_amdgcn_s_barrier();
    asm volatile("" ::: "memory");
}
typedef const KArgs __attribute__((address_space(4))) CKArgs;
DEV KArgs fresh_args() {
#if defined(__HIP_DEVICE_COMPILE__)
    CKArgs* p = (CKArgs*)__builtin_amdgcn_kernarg_segment_ptr(); asm volatile("" : "+s"(p)); KArgs r;
#pragma unroll
    for (int i = 0; i < 26; ++i) r.in[i] = p->in[i];
    r.out = p->out; r.ws = p->ws; return r;
#else
    return KArgs{};
#endif
}
__global__ void __launch_bounds__(512, 2) mega(KArgs Akern) {
    extern __shared__ __attribute__((aligned(16))) unsigned char lds_raw[];
    LAS unsigned char* lds = (LAS unsigned char*)lds_raw;
    cg::grid_group grid = cg::this_grid();
    (void)Akern;
    const int G = gridDim.x;
    const int wave_s = __builtin_amdgcn_readfirstlane((int)threadIdx.x >> 6);
    unsigned* bar_ctr;
    volatile LAS unsigned* bar_st = (volatile LAS unsigned*)(lds + LDS_BYTES - 64);
    { const KArgs A0 = fresh_args(); bar_ctr = (unsigned*)(A0.ws + WS_BAR);
      if (blockIdx.x == 0) for (int i = threadIdx.x; i < XCD_BAR_WORDS; i += 512) __hip_atomic_store(bar_ctr + i, 0u, __ATOMIC_RELAXED, __HIP_MEMORY_SCOPE_AGENT);
      if (threadIdx.x == 0) { bar_st[0] = 0u; bar_st[1] = 0u; } }
    grid.sync();
    if (threadIdx.x == 0) (void)xb_add(&bar_ctr[XB_XCNT(xb_xcc_id())], 1u);
#define GRID_SYNC() xcd_bar(bar_ctr, bar_st, wave_s == 0 && lane_id_asm() == 0, (unsigned)G)
#define FRESH_IDS const int lane = lane_id_asm(), wave = wave_s, tid_ = wave * 64 + lane, \
        gw = blockIdx.x * 8 + wave, NGW = G * 8, gtid = blockIdx.x * 512 + tid_, NT = G * 512; const KArgs A = fresh_args(); (void)lane; (void)wave; (void)gw; (void)NGW; (void)gtid; (void)NT
#ifndef GEMM_STAGGER_N
#define GEMM_STAGGER_N 0
#endif
#define GEMM_STAGGER() do { if (GEMM_STAGGER_N > 0 && (blockIdx.x & 1)) { for (int s_ = 0; s_ < GEMM_STAGGER_N; ++s_) __builtin_amdgcn_s_sleep(127); } } while (0)
#ifndef GEMM_ALIGN_EPI
#define GEMM_ALIGN_EPI true
#endif
#define RUN_GEMM(MODE, APTR, BPTR, NN, KK) RUN_GEMM_ON(MODE, APTR, BPTR, NN, KK, G, (int)blockIdx.x)
#define RUN_GEMM_ON(MODE, APTR, BPTR, NN, KK, SG, SC) do { const KArgs A = fresh_args(); unsigned char* ws = A.ws; pg8::Gemm g; g.A = (const bf16_t*)(APTR); g.Bt = (const bf16_t*)(BPTR); g.M = T; g.N = NN; { int kk_ = KK; asm volatile("" : "+s"(kk_)); g.K = kk_; } \
        Epi<MODE> E; E.xp = A.in[0]; E.xs = A.in[1]; E.out = A.out; E.ws = ws; pg8::StaticOrder S; S.init(T, NN, SG, SC); \
        GEMM_STAGGER(); pg8::gemm_phase<Epi<MODE>, pg8::StaticOrder, GEMM_ALIGN_EPI, true>(lds, g, S, E, wave_s); } while (0)
#ifndef SKIP_P0
#ifndef REP_P0
#define REP_P0 1
#endif
#pragma nounroll
    for (int rep = 0; rep < REP_P0; ++rep) { FRESH_IDS; p0_phase(A, lds, lane, wave, gw, NGW, gtid, NT, 0); }
#endif
#ifdef XBAR
    for (int xb = 0; xb < XBAR; ++xb) GRID_SYNC();
#endif
    GRID_SYNC();
#ifndef SKIP_G1
    RUN_GEMM(1, A.out, ws + WS_WIN, 3840, 1024);
#endif
    if (G > 188 && (int)blockIdx.x >= 188) { FRESH_IDS; p0_phase(A, lds, lane, wave, gw - 188 * 8, NGW - 188 * 8, gtid - 188 * 512, NT - 188 * 512, 1); }
    else if (G <= 188) { FRESH_IDS; p0_phase(A, lds, lane, wave, gw, NGW, gtid, NT, 1); }
    GRID_SYNC();
#ifndef SKIP_P2
#ifndef REP_P2
#define REP_P2 1
#endif
#pragma nounroll
    for (int rep = 0; rep < REP_P2; ++rep) { FRESH_IDS; p2_phase(A, gtid, NT); }
#endif
    GRID_SYNC();
#ifndef REP_P3
#define REP_P3 1
#endif
#pragma nounroll
    for (int rep = 0; rep < REP_P3; ++rep) {
        FRESH_IDS;
        LAS bf16_t* P = (LAS bf16_t*)(lds + wave * 5440);
#ifndef SKIP_ATT
        for (int t = gw; t < 16384; t += NGW) attn_task<false>(A, t, P, lane);
        for (int t = gw; t < 512; t += NGW) attn_task<true>(A, t, P, lane);
#endif
#ifndef SKIP_SGU
        for (int t = gw; t < 8192; t += NGW) sgu_task(A, t, lane);
        sgu_small(A, gtid, NT);
#endif
    }
    GRID_SYNC();
#ifndef REP_G4
#define REP_G4 1
#endif
#pragma nounroll
    for (int rep4 = 0; rep4 < REP_G4; ++rep4) {
#ifndef SKIP_G2
    RUN_GEMM(2, ws + WS_S2, ws + WS_WA, 1024, 512);
#endif
#ifndef SKIP_G3
    RUN_GEMM(3, ws + WS_S2 + (size_t)T * 1024, ws + WS_WB, 1024, 512);
#endif
    }
    if (G > 16 && (int)blockIdx.x >= 16) { FRESH_IDS; cvt_fp4(A.in[21], A.ws + WS_PU, 2097152, PEER_SU, gtid - 16 * 512, NT - 16 * 512); p0_phase(A, lds, lane, wave, gw - 16 * 8, NGW - 16 * 8, gtid - 16 * 512, NT - 16 * 512, 2); }
    else if (G <= 16) { FRESH_IDS; cvt_fp4(A.in[21], A.ws + WS_PU, 2097152, PEER_SU, gtid, NT); p0_phase(A, lds, lane, wave, gw, NGW, gtid, NT, 2); }
    GRID_SYNC();
#ifndef SKIP_G4
    RUN_GEMM(4, ws + WS_S4, ws + WS_WOUT, 1024, 1024);
#endif
    if (G > 16 && (int)blockIdx.x >= 16) { FRESH_IDS; cvt_fp4(A.in[22], A.ws + WS_PV, 2097152, PEER_SV, gtid - 16 * 512, NT - 16 * 512); p0_phase(A, lds, lane, wave, gw - 16 * 8, NGW - 16 * 8, gtid - 16 * 512, NT - 16 * 512, 3); }
    else if (G <= 16) { FRESH_IDS; cvt_fp4(A.in[22], A.ws + WS_PV, 2097152, PEER_SV, gtid, NT); p0_phase(A, lds, lane, wave, gw, NGW, gtid, NT, 3); }
    GRID_SYNC();
#ifndef SKIP_G5
#ifndef REP_G6
#define REP_G6 1
#endif
#pragma nounroll
    for (int rep = 0; rep < REP_G6; ++rep) {
    RUN_GEMM(5, ws + WS_S3, ws + WS_WQ, 2048, 1024);
    }
    if (G > 64 && (int)blockIdx.x >= 32) { RUN_GEMM_ON(6, ws + WS_PB, ws + WS_WPLE, 1024, 256, G - 32, (int)blockIdx.x - 32); }
    else if (G <= 64) { RUN_GEMM(6, ws + WS_PB, ws + WS_WPLE, 1024, 256); }
#endif
    GRID_SYNC();
#ifndef SKIP_TOPK
#ifndef REP_P7
#define REP_P7 1
#endif
#pragma nounroll
    for (int rep = 0; rep < REP_P7; ++rep) { FRESH_IDS; LAS float* L = (LAS float*)(lds + wave * 16384);
#ifdef TOPK_REF
      for (int t = gw; t < T * 8; t += NGW) topk_ref_task(A, t, L, lane);
#else
#ifdef TOPK_V1
      for (int t = gw; t < (T / 16) * 8; t += NGW) topk_task(A, t, L, lane);
#else
      if ((G & 7) == 0) topk3_phase(A, lds, lane, wave, G);
      else for (int t = gw; t < (T / 16) * 8; t += NGW) topk2_task(A, t, L, lane);
#endif
#endif
    }
#endif
    GRID_SYNC();
#ifndef SKIP_PEER
#ifndef REP_P8
#define REP_P8 1
#endif
#pragma nounroll
    for (int rep = 0; rep < REP_P8; ++rep) { FRESH_IDS;
#ifdef PEER_V4
      for (int t = gw; t < T; t += NGW) peer_token4(A, t, lane);
#else
      if (NGW == 2048) {
          for (int k = 0; k < 16; ++k) peer_token5(A, gw + k * 2048, lane, lds + wave * 1024, 0, 8, nullptr, nullptr, false);
          const int tl = 32768 + (int)blockIdx.x * 4 + (wave & 3); LAS float* xch = (LAS float*)(lds + 8192 + (wave & 3) * 4096);
          if (wave < 4) peer_token5(A, tl, lane, lds + wave * 1024, 0, 4, nullptr, xch, true);
          else          peer_token5(A, tl, lane, lds + wave * 1024, 4, 8, xch, nullptr, true);
      } else
      for (int t = gw; t < T; t += NGW) peer_token5(A, t, lane, lds + wave * 1024, 0, 8, nullptr, nullptr, false);
#endif
    }
#endif
    GRID_SYNC();
#ifndef REP_G9
#define REP_G9 1
#endif
#pragma nounroll
    for (int rep9 = 0; rep9 < REP_G9; ++rep9) {
#ifndef SKIP_G7
    RUN_GEMM(7, ws + WS_S2, ws + WS_WG, 1024, 1024);
#endif
    }
}

extern "C" void kernel_launch(void* const* d_in, const int* in_sizes, int n_in, void* d_out, int out_size, void* d_ws, size_t ws_size, hipStream_t stream) {
    static int grid = 0;
    if (grid == 0) {
        if (n_in != 26 || (size_t)out_size != O_END || ws_size < WS_END) { fprintf(stderr, "kernel_launch: unexpected shapes: n_in %d out %d ws %zu (need %zu)\n", n_in, out_size, ws_size, (size_t)WS_END); grid = -1; return; }
        int dev = 0, cus = 0, per_cu = 0;
        if (hipGetDevice(&dev) != hipSuccess || hipDeviceGetAttribute(&cus, hipDeviceAttributeMultiprocessorCount, dev) != hipSuccess) { grid = -1; return; }
        if (hipFuncSetAttribute((const void*)mega, hipFuncAttributeMaxDynamicSharedMemorySize, LDS_BYTES) != hipSuccess) { fprintf(stderr, "kernel_launch: hipFuncSetAttribute failed\n"); grid = -1; return; }
        if (hipOccupancyMaxActiveBlocksPerMultiprocessor(&per_cu, (const void*)mega, 512, LDS_BYTES) != hipSuccess || per_cu < 1) { fprintf(stderr, "kernel_launch: occupancy query says %d blocks/CU\n", per_cu); grid = -1; return; }
        grid = cus;
    }
    if (grid < 0) return;
    KArgs a{};
    for (int i = 0; i < 26; ++i) a.in[i] = (const float*)d_in[i];
    a.out = (float*)d_out; a.ws = (unsigned char*)d_ws;
    void* args[] = {&a};
    const hipError_t e = hipLaunchCooperativeKernel((const void*)mega, dim3(grid), dim3(512), args, LDS_BYTES, stream);
    if (e != hipSuccess) fprintf(stderr, "kernel_launch: cooperative launch failed: %s (grid %d)\n", hipGetErrorString(e), grid);
}
```
